# Optimizing an MI355X kernel written in HIP

```python
import math
import jax, jax.numpy as jnp
from jax import lax
import numpy as np

D_MODEL = 1024
BATCH = 16
SEQ = 2048
DEPTH = 4

N_A_LAYERS = DEPTH // 2
N_B_LAYERS = DEPTH - N_A_LAYERS
HEAD_DIM = 64
A_HEADS = D_MODEL // (2 * HEAD_DIM)
B_KV_HEADS = D_MODEL // HEAD_DIM
B_WINDOWS = (128, 512, 2048)
B_DILATIONS = (1, 4, 16)
N_B_GROUPS = len(B_WINDOWS)
ROPE_THETA = 500000.0
ROPE_DIM = HEAD_DIM // 4
N_EXPERTS = 32
TOP_K = 4
D_FF = D_MODEL
SWIGLU_LIMIT = 7.0
SWIGLU_ALPHA = 1.702
Q_BLOCK = 128
EXPERT_BLOCK = 256
NORM_EPS = 1e-5

kernel_name = 'yoco_diffattn_dilated_moe_adaln'


def rms_norm(x, gain):
    x32 = x.astype(jnp.float32)
    y = x32 * lax.rsqrt(jnp.mean(x32 * x32, axis=-1, keepdims=True) + NORM_EPS)
    return y.astype(x.dtype) * gain


def modulate(x, gain, shift, scale):
    return rms_norm(x, gain) * (1 + scale[:, None, :]) + shift[:, None, :]


def rope_tables(seq, dtype):
    inv = ROPE_THETA ** (-jnp.arange(0, ROPE_DIM, 2, dtype=jnp.float32) / ROPE_DIM)
    ang = jnp.arange(seq, dtype=jnp.float32)[:, None] * inv[None, :]
    return jnp.cos(ang).astype(dtype), jnp.sin(ang).astype(dtype)


def partial_rope(x, cos, sin):
    shape = (cos.shape[0],) + (1,) * (x.ndim - 3) + (cos.shape[1],)
    cos = cos.reshape(shape)
    sin = sin.reshape(shape)
    half = ROPE_DIM // 2
    x1 = x[..., :half]
    x2 = x[..., half:ROPE_DIM]
    return jnp.concatenate([x1 * cos - x2 * sin, x2 * cos + x1 * sin, x[..., ROPE_DIM:]], axis=-1)


def differential_attention(h, wqkv, wo, lam_vecs, subln, cos, sin, lambda_init):
    B, S, D = h.shape
    q, k, v = jnp.split(h @ wqkv, 3, axis=-1)
    q = partial_rope(q.reshape(B, S, A_HEADS, 2, HEAD_DIM), cos, sin) * (HEAD_DIM ** -0.5)
    k = partial_rope(k.reshape(B, S, A_HEADS, 2, HEAD_DIM), cos, sin)
    v = v.reshape(B, S, A_HEADS, 2 * HEAD_DIM)
    lf = lam_vecs.astype(jnp.float32)
    lam = jnp.exp(jnp.sum(lf[0] * lf[1])) - jnp.exp(jnp.sum(lf[2] * lf[3])) + lambda_init
    n_blk = S // Q_BLOCK
    qb = q.reshape(B, n_blk, Q_BLOCK, A_HEADS, 2, HEAD_DIM).transpose(1, 0, 2, 3, 4, 5)
    key_pos = jnp.arange(S)

    def block(args):
        i, qi = args
        q_pos = i * Q_BLOCK + jnp.arange(Q_BLOCK)
        causal = q_pos[:, None] >= key_pos[None, :]
        s = jnp.einsum('bqhmd,bkhmd->bhmqk', qi, k).astype(jnp.float32)
        p = jax.nn.softmax(jnp.where(causal, s, -jnp.inf), axis=-1)
        a = p[:, :, 0] - lam * p[:, :, 1]
        return jnp.einsum('bhqk,bkhd->bqhd', a.astype(v.dtype), v)

    o = lax.map(block, (jnp.arange(n_blk), qb))
    o = o.transpose(1, 0, 2, 3, 4).reshape(B, S, A_HEADS, 2 * HEAD_DIM)
    o = rms_norm(o, subln) * (1.0 - lambda_init)
    return o.reshape(B, S, D) @ wo


def dilated_group(q, k, v, window, dilation):
    B, S, H, Dh = q.shape
    steps = window // dilation
    L = S // dilation
    n_blk = -(-L // steps)
    Lp = n_blk * steps

    def strided(t):
        t = t.reshape(B, L, dilation, H, Dh).transpose(0, 2, 1, 3, 4)
        t = jnp.pad(t, ((0, 0), (0, 0), (0, Lp - L), (0, 0), (0, 0)))
        return t.reshape(B, dilation, n_blk, steps, H, Dh)

    def band(t):
        prev = jnp.pad(t, ((0, 0), (0, 0), (1, 0), (0, 0), (0, 0), (0, 0)))[:, :, :-1]
        return jnp.concatenate([prev, t], axis=3)

    qs = strided(q)
    ks = band(strided(k))
    vs = band(strided(v))
    s = jnp.einsum('brnqhd,brnkhd->brnhqk', qs, ks).astype(jnp.float32)
    dist = (jnp.arange(steps)[:, None] + steps) - jnp.arange(2 * steps)[None, :]
    blk = jnp.arange(n_blk)[:, None, None]
    key_idx = blk * steps - steps + jnp.arange(2 * steps)[None, None, :]
    valid = (dist >= 0) & (dist <= steps) & (key_idx >= 0)
    s = jnp.where(valid[None, None, :, None], s, -jnp.inf)
    m = jnp.max(s, axis=-1, keepdims=True)
    p = jnp.exp(s - m)
    l = jnp.sum(p, axis=-1)
    o = jnp.einsum('brnhqk,brnkhd->brnqhd', p.astype(v.dtype), vs).astype(jnp.float32)
    o = o / jnp.swapaxes(l, -1, -2)[..., None]
    lse = jnp.swapaxes(m[..., 0] + jnp.log(l), -1, -2)

    def unstrided(t):
        t = t.reshape((B, dilation, Lp) + t.shape[4:])[:, :, :L]
        t = jnp.swapaxes(t, 1, 2)
        return t.reshape((B, S) + t.shape[3:])

    return unstrided(o), unstrided(lse)


def dilated_attention(h, wq, wo, k_sh, v_sh, cos, sin):
    B, S, D = h.shape
    q = (h @ wq).reshape(B, S, N_B_GROUPS, B_KV_HEADS, HEAD_DIM)
    q = partial_rope(q, cos, sin) * (HEAD_DIM ** -0.5)
    outs = []
    lses = []
    for g in range(N_B_GROUPS):
        o_g, lse_g = dilated_group(q[:, :, g], k_sh, v_sh, B_WINDOWS[g], B_DILATIONS[g])
        outs.append(o_g)
        lses.append(lse_g)
    alpha = jax.nn.softmax(jnp.stack(lses, axis=0), axis=0)
    o = jnp.sum(alpha[..., None] * jnp.stack(outs, axis=0), axis=0)
    return o.astype(h.dtype).reshape(B, S, D) @ wo


def shared_kv(x, gain, shift, scale, w_kv, cos, sin):
    B, S, D = x.shape
    h = modulate(x, gain, shift, scale)
    k, v = jnp.split(h @ w_kv, 2, axis=-1)
    k = partial_rope(k.reshape(B, S, B_KV_HEADS, HEAD_DIM), cos, sin)
    return k, v.reshape(B, S, B_KV_HEADS, HEAD_DIM)


def moe_ffn(h, w_router, b_router, w_gate_up, b_gate_up, w_down, b_down):
    T, D = h.shape
    logits = (h @ w_router + b_router).astype(jnp.float32)
    top_logits, top_idx = lax.top_k(logits, TOP_K)
    top_w = jax.nn.softmax(top_logits, axis=-1).astype(h.dtype)
    n = T * TOP_K
    flat_e = top_idx.reshape(n)
    order = jnp.argsort(flat_e, stable=True)
    sorted_e = flat_e[order]
    counts = jnp.bincount(flat_e, length=N_EXPERTS)
    starts = jnp.cumsum(counts) - counts
    padded = (counts + EXPERT_BLOCK - 1) // EXPERT_BLOCK * EXPERT_BLOCK
    pad_ends = jnp.cumsum(padded)
    dest = pad_ends[sorted_e] - padded[sorted_e] + jnp.arange(n) - starts[sorted_e]
    n_rows = -(-n // EXPERT_BLOCK) * EXPERT_BLOCK + N_EXPERTS * EXPERT_BLOCK
    n_blocks = n_rows // EXPERT_BLOCK
    row_token = jnp.zeros((n_rows,), jnp.int32).at[dest].set((order // TOP_K).astype(jnp.int32))
    row_gate = jnp.zeros((n_rows,), h.dtype).at[dest].set(top_w.reshape(n)[order])
    block_expert = jnp.minimum(
        jnp.searchsorted(pad_ends, jnp.arange(n_blocks) * EXPERT_BLOCK, side='right'), N_EXPERTS - 1)

    def expert_block(args):
        tok, g, e = args
        gu = h[tok] @ w_gate_up[e] + b_gate_up[e]
        gate = jnp.minimum(gu[:, :D_FF], SWIGLU_LIMIT)
        up = jnp.clip(gu[:, D_FF:], -SWIGLU_LIMIT, SWIGLU_LIMIT)
        glu = gate * jax.nn.sigmoid(SWIGLU_ALPHA * gate)
        y = ((up + 1) * glu) @ w_down[e] + b_down[e]
        return y * g[:, None]

    ys = lax.map(expert_block, (row_token.reshape(n_blocks, EXPERT_BLOCK),
                                row_gate.reshape(n_blocks, EXPERT_BLOCK), block_expert))
    return jnp.zeros_like(h).at[row_token].add(ys.reshape(n_rows, D))


def setup_inputs(seed: int = 0) -> dict:
    key = jax.random.key(seed)
    ks = jax.random.split(key, 26)
    D = D_MODEL

    def nrm(k, shape, scale):
        return jax.random.normal(k, shape, jnp.float32) * scale

    return {
        'x': nrm(ks[0], (BATCH, SEQ, D), 1.0),
        'c': nrm(ks[1], (BATCH, D), 1.0),
        'mod_w': nrm(ks[2], (DEPTH, D, 6 * D), 0.5 * D ** -0.5),
        'mod_b': nrm(ks[3], (DEPTH, 6 * D), 0.02),
        'mix_norm': 1.0 + nrm(ks[4], (DEPTH, D), 0.02),
        'ffn_norm': 1.0 + nrm(ks[5], (DEPTH, D), 0.02),
        'a_wqkv': nrm(ks[6], (N_A_LAYERS, D, 3 * A_HEADS * 2 * HEAD_DIM), D ** -0.5),
        'a_wo': nrm(ks[7], (N_A_LAYERS, A_HEADS * 2 * HEAD_DIM, D), D ** -0.5),
        'a_lambda': nrm(ks[8], (N_A_LAYERS, 4, HEAD_DIM), 0.1),
        'a_subln': 1.0 + nrm(ks[9], (N_A_LAYERS, 2 * HEAD_DIM), 0.02),
        'kv_norm': 1.0 + nrm(ks[10], (D,), 0.02),
        'kv_mod_w': nrm(ks[11], (D, 2 * D), 0.5 * D ** -0.5),
        'kv_mod_b': nrm(ks[12], (2 * D,), 0.02),
        'kv_w': nrm(ks[13], (D, 2 * B_KV_HEADS * HEAD_DIM), D ** -0.5),
        'b_wq': nrm(ks[14], (N_B_LAYERS, D, N_B_GROUPS * B_KV_HEADS * HEAD_DIM), D ** -0.5),
        'b_wo': nrm(ks[15], (N_B_LAYERS, B_KV_HEADS * HEAD_DIM, D), D ** -0.5),
        'router_w': nrm(ks[16], (DEPTH, D, N_EXPERTS), D ** -0.5),
        'router_b': nrm(ks[17], (DEPTH, N_EXPERTS), 0.01),
        'exp_w_gate_up': nrm(ks[18], (DEPTH, N_EXPERTS, D, 2 * D_FF), D ** -0.5),
        'exp_b_gate_up': nrm(ks[19], (DEPTH, N_EXPERTS, 2 * D_FF), 0.01),
        'exp_w_down': nrm(ks[20], (DEPTH, N_EXPERTS, D_FF, D), D_FF ** -0.5),
        'exp_b_down': nrm(ks[21], (DEPTH, N_EXPERTS, D), 0.01),
        'final_norm': 1.0 + nrm(ks[22], (D,), 0.02),
        'final_mod_w': nrm(ks[23], (D, 2 * D), 0.5 * D ** -0.5),
        'final_mod_b': nrm(ks[24], (2 * D,), 0.02),
    }


def reference(x, c, mod_w, mod_b, mix_norm, ffn_norm, a_wqkv, a_wo, a_lambda, a_subln,
              kv_norm, kv_mod_w, kv_mod_b, kv_w, b_wq, b_wo, router_w, router_b,
              exp_w_gate_up, exp_b_gate_up, exp_w_down, exp_b_down,
              final_norm, final_mod_w, final_mod_b):
    B, S, D = x.shape
    cos, sin = rope_tables(S, x.dtype)
    c_act = jax.nn.silu(c)
    k_sh = None
    v_sh = None
    for layer in range(DEPTH):
        mod = c_act @ mod_w[layer] + mod_b[layer]
        sh1, sc1, g1, sh2, sc2, g2 = jnp.split(mod, 6, axis=-1)
        h = modulate(x, mix_norm[layer], sh1, sc1)
        if layer < N_A_LAYERS:
            lambda_init = 0.8 - 0.6 * math.exp(-0.3 * layer)
            y = differential_attention(h, a_wqkv[layer], a_wo[layer], a_lambda[layer],
                                       a_subln[layer], cos, sin, lambda_init)
        else:
            j = layer - N_A_LAYERS
            y = dilated_attention(h, b_wq[j], b_wo[j], k_sh, v_sh, cos, sin)
        x = x + g1[:, None, :] * y
        h = modulate(x, ffn_norm[layer], sh2, sc2)
        f = moe_ffn(h.reshape(B * S, D), router_w[layer], router_b[layer], exp_w_gate_up[layer],
                    exp_b_gate_up[layer], exp_w_down[layer], exp_b_down[layer])
        x = x + g2[:, None, :] * f.reshape(B, S, D)
        if layer == N_A_LAYERS - 1:
            kv_sh, kv_sc = jnp.split(c_act @ kv_mod_w + kv_mod_b, 2, axis=-1)
            k_sh, v_sh = shared_kv(x, kv_norm, kv_sh, kv_sc, kv_w, cos, sin)
    f_sh, f_sc = jnp.split(c_act @ final_mod_w + final_mod_b, 2, axis=-1)
    return modulate(x, final_norm, f_sh, f_sc)
```

```cpp
#include <hip/hip_runtime.h>
#include <hip/hip_bf16.h>
#include <cstdio>
#include <cstdint>
#include <cmath>
namespace pg8 {
#define PG8_LAS __attribute__((address_space(3)))
typedef unsigned short bf16_t;
typedef short bf16x8 __attribute__((ext_vector_type(8)));
typedef float f32x4 __attribute__((ext_vector_type(4)));
typedef unsigned u32x4 __attribute__((ext_vector_type(4)));
constexpr int BM = 256, BK = 64, HALF = 128, HTB = HALF * BK * 2  , STAGE_BYTES = 8 * HTB, NXCD = 8, WGM = 8;

__host__ __device__ __forceinline__ int lds_byte(int r, int c) { const int st = (r >> 4) * 2 + (c >> 5), rr = r & 15, cc = c & 31, ob = rr * 64 + cc * 2; return st * 1024 + (ob ^ (((ob >> 9) & 1) << 5)); }
__host__ __device__ __forceinline__ void stage_rc(int b, int& R, int& C) { const int st = b / 1024, sb = b % 1024, swz = sb ^ (((sb >> 9) & 1) << 5); R = (st >> 1) * 16 + swz / 64; C = (st & 1) * 32 + (swz % 64) / 2; }
__host__ __device__ __forceinline__ int perm32(int rho) { const int n = rho >> 4, i = rho & 15; return 8 * (i >> 2) + 4 * n + (i & 3); }

struct Unit { int pm, pn, e; };
struct Gemm { const bf16_t* A; const bf16_t* Bt; int M, N, K; size_t estride; };

struct Order {
    int nM, nN, nwg, G, c; const PG8_LAS int* texp;
    __device__ __forceinline__ void init(int nM_, int nN_, int G_, int c_, const PG8_LAS int* texp_) { nM = nM_; nN = nN_; nwg = nM * nN; G = G_; c = c_; texp = texp_; }
    __device__ __forceinline__ bool next(int i, Unit& u) const {
        const long L = (long)i * G + c; if (L >= nwg) return false;
        int wgid = (int)L; { const int q = nwg / NXCD, r = nwg % NXCD, xcd = wgid % NXCD, off = wgid / NXCD; wgid = (xcd < r ? xcd * (q + 1) : r * (q + 1) + (xcd - r) * q) + off; }
        const int nig = WGM * nN, gid = wgid / nig, fm = gid * WGM, gsz = (nM - fm) < WGM ? (nM - fm) : WGM;
        u.pm = fm + ((wgid % nig) % gsz); u.pn = (wgid % nig) / gsz; u.e = texp ? texp[u.pm] : 0; return true;
    }
    __device__ __forceinline__ void a_ready(const Unit&) const {}
    __device__ __forceinline__ void done(const Unit&) const {}
};

__device__ __forceinline__ unsigned cvt_pk_bf16(float lo, float hi) { unsigned r; asm volatile("v_cvt_pk_bf16_f32 %0, %1, %2" : "=v"(r) : "v"(lo), "v"(hi)); return r; }
__device__ __forceinline__ f32x4 shfl16(f32x4 v) { f32x4 o; o[0] = __shfl_xor(v[0], 16); o[1] = __shfl_xor(v[1], 16); o[2] = __shfl_xor(v[2], 16); o[3] = __shfl_xor(v[3], 16); return o; }

struct EpiRope {
    static constexpr bool PERM = true, AFTER_DRAIN = false;
    bf16_t* O; int ldc; int split_cols; size_t split_stride; int rope_cols, scale_cols; float qscale; const float* cosT; const float* sinT;
    __device__ __forceinline__ void operator()(const f32x4 (&acc)[2][2][4][2], const Unit& u, int wr, int wc, int fr, int fq) const {
        const int row0 = u.pm * BM + wr * 64 + fr; int colt = u.pn * BM; bf16_t* base = O;
        const bool do_rope = (colt < rope_cols) && ((wc & 1) == 0); const float sc = (colt < scale_cols) ? qscale : 1.f;
        if (split_cols) { const int t = colt / split_cols; base += (size_t)t * split_stride; colt -= t * split_cols; }
        const int col0 = colt + wc * 32 + 8 * fq;
#pragma unroll
        for (int ai = 0; ai < 2; ++ai)
#pragma unroll
            for (int m = 0; m < 4; ++m) { const int row = row0 + ai * HALF + m * 16; bf16_t* rowp = base + (size_t)row * ldc + col0;
                f32x4 c0 = (f32x4){1.f, 1.f, 1.f, 1.f}, c1 = c0, s0 = (f32x4){0.f, 0.f, 0.f, 0.f}, s1 = s0;
                if (do_rope) { const int t = row & 2047; c0 = *(const f32x4*)(cosT + t * 8); c1 = *(const f32x4*)(cosT + t * 8 + 4); s0 = *(const f32x4*)(sinT + t * 8); s1 = *(const f32x4*)(sinT + t * 8 + 4);
                    if (fq == 0) { s0 = -s0; s1 = -s1; } else if (fq >= 2) { c0 = (f32x4){1.f, 1.f, 1.f, 1.f}; c1 = c0; s0 = (f32x4){0.f, 0.f, 0.f, 0.f}; s1 = s0; } }
#pragma unroll
                for (int bj = 0; bj < 2; ++bj) { f32x4 v0 = acc[ai][bj][m][0], v1 = acc[ai][bj][m][1];
                    if (do_rope) { const f32x4 o0 = shfl16(v0), o1 = shfl16(v1); v0 = v0 * c0 + o0 * s0; v1 = v1 * c1 + o1 * s1; }
                    v0 = v0 * sc; v1 = v1 * sc; u32x4 w; w.x = cvt_pk_bf16(v0[0], v0[1]); w.y = cvt_pk_bf16(v0[2], v0[3]); w.z = cvt_pk_bf16(v1[0], v1[1]); w.w = cvt_pk_bf16(v1[2], v1[3]);
                    *(u32x4*)(rowp + bj * HALF) = w; } }
    }
};
struct EpiResid {
    static constexpr bool PERM = false, AFTER_DRAIN = false;
    const float* xin; float* xout; const float* gate; int gstride;
    __device__ __forceinline__ void operator()(const f32x4 (&acc)[2][2][4][2], const Unit& u, int wr, int wc, int fr, int fq) const {
        const int row0 = u.pm * BM + wr * 64 + fr, col0 = u.pn * BM + wc * 32 + 4 * fq; const float* gp = gate + (size_t)(u.pm >> 3) * gstride + col0;
        f32x4 gv[2][2];
#pragma unroll
        for (int bj = 0; bj < 2; ++bj)
#pragma unroll
            for (int n = 0; n < 2; ++n) gv[bj][n] = *(const f32x4*)(gp + bj * HALF + n * 16);
#pragma unroll
        for (int ai = 0; ai < 2; ++ai)
#pragma unroll
            for (int m = 0; m < 4; ++m) { const size_t off = (size_t)(row0 + ai * HALF + m * 16) * 1024 + col0;
#pragma unroll
                for (int bj = 0; bj < 2; ++bj)
#pragma unroll
                    for (int n = 0; n < 2; ++n) { const f32x4 xi = *(const f32x4*)(xin + off + bj * HALF + n * 16); *(f32x4*)(xout + off + bj * HALF + n * 16) = xi + gv[bj][n] * acc[ai][bj][m][n]; }
                if (m & 1) asm volatile("" ::: "memory"); }
    }
};
struct EpiSwiglu {
    static constexpr bool PERM = true, AFTER_DRAIN = false;
    bf16_t* act; const float* bgu;
    __device__ __forceinline__ void operator()(const f32x4 (&acc)[2][2][4][2], const Unit& u, int wr, int wc, int fr, int fq) const {
        const int row0 = u.pm * BM + wr * 64 + fr, acol0 = u.pn * HALF + wc * 32 + 8 * fq; const float* bp = bgu + (size_t)u.e * 2048 + acol0;
        const f32x4 bg0 = *(const f32x4*)(bp), bg1 = *(const f32x4*)(bp + 4), bu0 = *(const f32x4*)(bp + 1024), bu1 = *(const f32x4*)(bp + 1028);
#pragma unroll
        for (int ai = 0; ai < 2; ++ai)
#pragma unroll
            for (int m = 0; m < 4; ++m) { bf16_t* rowp = act + (size_t)(row0 + ai * HALF + m * 16) * 1024 + acol0;
                f32x4 g0 = acc[ai][0][m][0] + bg0, g1 = acc[ai][0][m][1] + bg1, u0 = acc[ai][1][m][0] + bu0, u1 = acc[ai][1][m][1] + bu1; f32x4 r0, r1;
#pragma unroll
                for (int j = 0; j < 4; ++j) { const float ga = fminf(g0[j], 7.0f), gb = fminf(g1[j], 7.0f), ua = fminf(fmaxf(u0[j], -7.0f), 7.0f), ub = fminf(fmaxf(u1[j], -7.0f), 7.0f);
                    const float sa = __builtin_amdgcn_rcpf(1.0f + __builtin_amdgcn_exp2f(ga * (-1.702f * 1.4426950408889634f))), sb = __builtin_amdgcn_rcpf(1.0f + __builtin_amdgcn_exp2f(gb * (-1.702f * 1.4426950408889634f)));
                    r0[j] = (ua + 1.0f) * (ga * sa); r1[j] = (ub + 1.0f) * (gb * sb); }
                u32x4 w; w.x = cvt_pk_bf16(r0[0], r0[1]); w.y = cvt_pk_bf16(r0[2], r0[3]); w.z = cvt_pk_bf16(r1[0], r1[1]); w.w = cvt_pk_bf16(r1[2], r1[3]);
                *(u32x4*)rowp = w; }
    }
};
struct EpiDown {
    static constexpr bool PERM = true, AFTER_DRAIN = false;
    bf16_t* Y; const float* bd;
    __device__ __forceinline__ void operator()(const f32x4 (&acc)[2][2][4][2], const Unit& u, int wr, int wc, int fr, int fq) const {
        const int row0 = u.pm * BM + wr * 64 + fr, col0 = u.pn * BM + wc * 32 + 8 * fq; const float* bp = bd + (size_t)u.e * 1024 + col0;
        f32x4 bv[2][2];
#pragma unroll
        for (int bj = 0; bj < 2; ++bj)
#pragma unroll
            for (int n = 0; n < 2; ++n) bv[bj][n] = *(const f32x4*)(bp + bj * HALF + 4 * n);
#pragma unroll
        for (int ai = 0; ai < 2; ++ai)
#pragma unroll
            for (int m = 0; m < 4; ++m) { bf16_t* rowp = Y + (size_t)(row0 + ai * HALF + m * 16) * 1024 + col0;
#pragma unroll
                for (int bj = 0; bj < 2; ++bj) { const f32x4 v0 = acc[ai][bj][m][0] + bv[bj][0], v1 = acc[ai][bj][m][1] + bv[bj][1];
                    u32x4 w; w.x = cvt_pk_bf16(v0[0], v0[1]); w.y = cvt_pk_bf16(v0[2], v0[3]); w.z = cvt_pk_bf16(v1[0], v1[1]); w.w = cvt_pk_bf16(v1[2], v1[3]);
                    *(u32x4*)(rowp + bj * HALF) = w; } }
    }
};

template <class Epi, class Sched, bool ALIGN_EPI = false, bool SP2 = false>
__device__ __forceinline__ void gemm_phase(PG8_LAS unsigned char* lds, const Gemm g, const Sched& S, const Epi& E) {
    int tid_ = threadIdx.x; asm volatile("" : "+v"(tid_));
    const int tid = tid_, wid = __builtin_amdgcn_readfirstlane(tid >> 6), lane = tid & 63, wr = wid >> 2, wc = wid & 3, fr = lane & 15, fq = lane >> 4;
    constexpr int K = 1024, nt = K / BK;
    unsigned voffA[2], voffB[2];
#pragma unroll
    for (int i = 0; i < 2; ++i) { int R, C; stage_rc(tid * 16 + i * 8192, R, C); const int Rb = Epi::PERM ? ((R & ~31) + perm32(R & 31)) : R;
        voffA[i] = (unsigned)(R * K + C) * 2u; voffB[i] = (unsigned)(Rb * K + C) * 2u; }
    const size_t kstep = (size_t)(BK * 2);
    const size_t hstep = (size_t)HALF * K * 2;
    const size_t tstep = 2 * hstep;
    const unsigned ldsw = (unsigned)wid * 1024u;
    const int aoff = lds_byte(wr * 64 + fr, fq * 8), boff = lds_byte(wc * 32 + fr, fq * 8);
#define PG8_SA(b, h) (((b) * 2 + (h)) * HTB)
#define PG8_SB(b, h) ((4 + (b) * 2 + (h)) * HTB)
#define PG8_STAGE(bufoff, gbase, voff) do { _Pragma("unroll") for (int _i = 0; _i < 2; ++_i) \
        __builtin_amdgcn_global_load_lds((const unsigned*)((const char*)(gbase) + (voff)[_i]), (PG8_LAS unsigned*)(lds + (bufoff) + ldsw + _i * 8192), 16, 0, 0); } while (0)
#define PG8_LDA(dst, b, h) do { _Pragma("unroll") for (int m = 0; m < 4; ++m) _Pragma("unroll") for (int k = 0; k < 2; ++k) dst[m][k] = *(const PG8_LAS bf16x8*)(lds + PG8_SA(b, h) + aoff + m * 2048 + k * 1024); } while (0)
#define PG8_LDB(dst, b, h) do { _Pragma("unroll") for (int n = 0; n < 2; ++n) _Pragma("unroll") for (int k = 0; k < 2; ++k) dst[n][k] = *(const PG8_LAS bf16x8*)(lds + PG8_SB(b, h) + boff + n * 2048 + k * 1024); } while (0)
#define PG8_MMA(ai, bj, At, Bt) do { __builtin_amdgcn_s_setprio(1); _Pragma("unroll") for (int m = 0; m < 4; ++m) _Pragma("unroll") for (int n = 0; n < 2; ++n) _Pragma("unroll") for (int k = 0; k < 2; ++k) \
        acc[ai][bj][m][n] = __builtin_amdgcn_mfma_f32_16x16x32_bf16(Bt[n][k], At[m][k], acc[ai][bj][m][n], 0, 0, 0); __builtin_amdgcn_s_setprio(0); } while (0)
#define PG8_WAIT_V(n) asm volatile("s_waitcnt vmcnt(" #n ")" ::: "memory")
#define PG8_WAIT_L(n) asm volatile("s_waitcnt lgkmcnt(" #n ")" ::: "memory")
#define PG8_BAR __builtin_amdgcn_s_barrier()
#define PG8_SCHED __builtin_amdgcn_sched_barrier(0)
    Unit cur, nxt; int ui = 0;
    if (!S.next(0, cur)) return;
    f32x4 acc[2][2][4][2];
#pragma unroll
    for (int a = 0; a < 2; ++a)
#pragma unroll
        for (int b = 0; b < 2; ++b)
#pragma unroll
            for (int m = 0; m < 4; ++m)
#pragma unroll
                for (int n = 0; n < 2; ++n) acc[a][b][m][n] = (f32x4){0.f, 0.f, 0.f, 0.f};
    bf16x8 At[4][2], B0[2][2], B1[2][2];
    const char* cA = (const char*)g.A + (size_t)cur.pm * tstep; const char* cB = (const char*)g.Bt + (size_t)cur.pn * tstep + (size_t)cur.e * g.estride;
    S.a_ready(cur);
    if constexpr (SP2) {
        PG8_STAGE(PG8_SB(0, 0), cB, voffB); PG8_STAGE(PG8_SB(0, 1), cB + hstep, voffB); PG8_STAGE(PG8_SA(0, 0), cA, voffA); PG8_STAGE(PG8_SA(0, 1), cA + hstep, voffA);
        if (wr == 1) PG8_BAR;
        PG8_WAIT_V(2); PG8_BAR;
        PG8_STAGE(PG8_SB(1, 0), cB + kstep, voffB); PG8_STAGE(PG8_SA(1, 0), cA + kstep, voffA); PG8_STAGE(PG8_SB(1, 1), cB + hstep + kstep, voffB);
        PG8_WAIT_V(6); PG8_BAR;
    } else {
        PG8_STAGE(PG8_SB(0, 0), cB, voffB); PG8_STAGE(PG8_SA(0, 0), cA, voffA); PG8_STAGE(PG8_SB(0, 1), cB + hstep, voffB); PG8_STAGE(PG8_SA(0, 1), cA + hstep, voffA);
        if (wr == 1) PG8_BAR;
        PG8_WAIT_V(4); PG8_BAR;
        PG8_STAGE(PG8_SB(1, 0), cB + kstep, voffB); PG8_STAGE(PG8_SA(1, 0), cA + kstep, voffA); PG8_STAGE(PG8_SB(1, 1), cB + hstep + kstep, voffB);
        PG8_WAIT_V(6); PG8_BAR;
    }
    for (;;) {
        const bool has_next = S.next(ui + 1, nxt);
        const char* nA = has_next ? (const char*)g.A + (size_t)nxt.pm * tstep : cA; const char* nB = has_next ? (const char*)g.Bt + (size_t)nxt.pn * tstep + (size_t)nxt.e * g.estride : cB;
        for (int t = 0; t < nt; t += 2) {
            const bool last = (t == nt - 2);
            const char* a1 = cA + (size_t)(t + 1) * kstep;
            const char* a2 = last ? nA : cA + (size_t)(t + 2) * kstep; const char* b2 = last ? nB : cB + (size_t)(t + 2) * kstep;
            const char* a3 = a2 + kstep; const char* b3 = b2 + kstep;
            if (last && has_next) S.a_ready(nxt);
            if constexpr (SP2) {
            PG8_LDB(B0, 0, 0); PG8_LDB(B1, 0, 1); PG8_SCHED; PG8_LDA(At, 0, 0); PG8_STAGE(PG8_SA(1, 1), a1 + hstep, voffA);
            PG8_WAIT_V(8); PG8_WAIT_L(0); PG8_BAR; PG8_MMA(0, 0, At, B0); PG8_MMA(0, 1, At, B1); PG8_BAR; PG8_SCHED;
            PG8_LDA(At, 0, 1); PG8_STAGE(PG8_SB(0, 0), b2, voffB); PG8_STAGE(PG8_SB(0, 1), b2 + hstep, voffB); PG8_STAGE(PG8_SA(0, 0), a2, voffA);
            PG8_WAIT_V(8); PG8_WAIT_L(0); PG8_BAR; PG8_MMA(1, 0, At, B0); PG8_MMA(1, 1, At, B1); PG8_BAR; PG8_SCHED;
            PG8_LDB(B0, 1, 0); PG8_LDB(B1, 1, 1); PG8_SCHED; PG8_LDA(At, 1, 0); PG8_STAGE(PG8_SA(0, 1), a2 + hstep, voffA);
            PG8_WAIT_V(8); PG8_WAIT_L(0); PG8_BAR; PG8_MMA(0, 0, At, B0); PG8_MMA(0, 1, At, B1); PG8_BAR; PG8_SCHED;
            PG8_LDA(At, 1, 1); PG8_STAGE(PG8_SB(1, 0), b3, voffB); PG8_STAGE(PG8_SB(1, 1), b3 + hstep, voffB); PG8_STAGE(PG8_SA(1, 0), a3, voffA);
            PG8_WAIT_V(8); PG8_WAIT_L(0); PG8_BAR; PG8_MMA(1, 0, At, B0); PG8_MMA(1, 1, At, B1); PG8_BAR; PG8_SCHED;
            } else {
            PG8_LDB(B0, 0, 0); PG8_SCHED; PG8_LDA(At, 0, 0); PG8_STAGE(PG8_SA(1, 1), a1 + hstep, voffA);
            PG8_WAIT_L(8); PG8_BAR; PG8_WAIT_L(0); PG8_MMA(0, 0, At, B0); PG8_BAR; PG8_SCHED;
            PG8_LDB(B1, 0, 1); PG8_STAGE(PG8_SB(0, 0), b2, voffB);
            PG8_BAR; PG8_WAIT_L(0); PG8_MMA(0, 1, At, B1); PG8_BAR;
            PG8_LDA(At, 0, 1); PG8_STAGE(PG8_SA(0, 0), a2, voffA);
            PG8_BAR; PG8_WAIT_L(0); PG8_MMA(1, 0, At, B0); PG8_BAR; PG8_SCHED;
            PG8_STAGE(PG8_SB(0, 1), b2 + hstep, voffB);
            PG8_WAIT_V(6); PG8_BAR; PG8_MMA(1, 1, At, B1); PG8_BAR;
            PG8_LDB(B0, 1, 0); PG8_SCHED; PG8_LDA(At, 1, 0); PG8_STAGE(PG8_SA(0, 1), a2 + hstep, voffA);
            PG8_WAIT_L(8); PG8_BAR; PG8_WAIT_L(0); PG8_MMA(0, 0, At, B0); PG8_BAR; PG8_SCHED;
            PG8_LDB(B1, 1, 1); PG8_STAGE(PG8_SB(1, 0), b3, voffB);
            PG8_BAR; PG8_WAIT_L(0); PG8_MMA(0, 1, At, B1); PG8_BAR;
            PG8_LDA(At, 1, 1); PG8_STAGE(PG8_SA(1, 0), a3, voffA);
            PG8_BAR; PG8_WAIT_L(0); PG8_MMA(1, 0, At, B0); PG8_BAR; PG8_SCHED;
            PG8_STAGE(PG8_SB(1, 1), b3 + hstep, voffB);
            PG8_WAIT_V(6); PG8_BAR; PG8_MMA(1, 1, At, B1); PG8_BAR;
            }
        }
        if constexpr (ALIGN_EPI) { if (wr == 0) PG8_BAR; }
        if constexpr (!Epi::AFTER_DRAIN) { E(acc, cur, wr, wc, fr, fq); S.done(cur); }
        if (!has_next) break;
#pragma unroll
        for (int a = 0; a < 2; ++a)
#pragma unroll
            for (int b = 0; b < 2; ++b)
#pragma unroll
                for (int m = 0; m < 4; ++m)
#pragma unroll
                    for (int n = 0; n < 2; ++n) acc[a][b][m][n] = (f32x4){0.f, 0.f, 0.f, 0.f};
        cur = nxt; cA = nA; cB = nB; ++ui;
        if constexpr (ALIGN_EPI) { if (wr == 1) PG8_BAR; }
    }
    PG8_WAIT_V(0);
    if constexpr (!ALIGN_EPI) { if (wr == 0) PG8_BAR; }
    PG8_BAR;
    if constexpr (Epi::AFTER_DRAIN) { E.fused(acc, cur, wr, wc, fr, fq, lds, wid, lane); S.done(cur); }
#undef PG8_SA
#undef PG8_SB
#undef PG8_STAGE
#undef PG8_LDA
#undef PG8_LDB
#undef PG8_MMA
#undef PG8_WAIT_V
#undef PG8_WAIT_L
#undef PG8_BAR
#undef PG8_SCHED
}
}
namespace attn_body {
using bf16=__hip_bfloat16;
using bf16x8=__attribute__((ext_vector_type(8)))short;
using s16x4=__attribute__((ext_vector_type(4)))short;
using f32x16=__attribute__((ext_vector_type(16)))float;
using u32x4=__attribute__((ext_vector_type(4)))unsigned;
constexpr int BATCH=16,NHEAD=16,SEQ=2048,D=64,DM=NHEAD*D;
constexpr int NW=8,QBLK=32,QB=QBLK*NW,KVBLK=64,NQB=SEQ/QB;
constexpr int ATTN_PITCH=DM, ATTN_UNIT_ROWS=QB;
__device__ __forceinline__ int crow(int r,int hi){return (r&3)+8*(r>>2)+4*hi;}
#define SBAR() __builtin_amdgcn_sched_barrier(0)
__device__ __forceinline__ void cmask(f32x16&p0,f32x16&p1,int jb,int qrel,int hi){
  const float NEG=-INFINITY; int kb=64*jb+4*hi;
  #pragma unroll
  for(int r=0;r<16;++r){int kv=kb+(r&3)+8*(r>>2); if(kv>qrel)p0[r]=NEG; if(kv+32>qrel)p1[r]=NEG;}
}

constexpr int NSLOT=3, SLOTB=8192;
constexpr int LDS_K=0, LDS_V=NSLOT*SLOTB, LDS_WS=2*NSLOT*SLOTB, LDS_OST=LDS_WS+NW*64*4, LDS_BYTES=LDS_OST+NW*4096;
constexpr float C2=0.125f*1.4426950408889634f;
__device__ __forceinline__ void glds16(const void*gsrc,unsigned lds_dst){unsigned keep;
  asm volatile("s_mov_b32 %0, m0\n\ts_mov_b32 m0, %2\n\ts_nop 0\n\tglobal_load_lds_dwordx4 %1, off\n\ts_mov_b32 m0, %0":"=&s"(keep):"v"(gsrc),"s"(lds_dst):"memory");}
__device__ __forceinline__ float max3f(float a,float b,float c){float r;asm("v_max3_f32 %0, %1, %2, %3":"=v"(r):"v"(a),"v"(b),"v"(c));return r;}
__device__ __forceinline__ float max2f(float a,float b){float r;asm("v_max_f32_e32 %0, %1, %2":"=v"(r):"v"(a),"v"(b));return r;}
__device__ __forceinline__ float fadd_s(float a,float b){float r;asm("v_add_f32_e32 %0, %1, %2":"=v"(r):"v"(a),"v"(b));return r;}
__device__ __forceinline__ float fsub_s(float a,float b){float r;asm("v_sub_f32_e32 %0, %1, %2":"=v"(r):"v"(a),"v"(b));return r;}
typedef float f32x2_t __attribute__((ext_vector_type(2))); typedef __bf16 bf16x2_t __attribute__((ext_vector_type(2)));
__device__ __forceinline__ unsigned cvtpk_s(float lo,float hi){f32x2_t v={lo,hi};bf16x2_t b=__builtin_convertvector(v,bf16x2_t);return __builtin_bit_cast(unsigned,b);}
#define WAIT_BAR(N) asm volatile("s_waitcnt vmcnt(" #N ") lgkmcnt(0)\n\ts_barrier":::"memory")

__device__ __forceinline__ void qkt(f32x16&p0,f32x16&p1,const char*Kslot,const bf16x8*qr,const f32x16&negm,int r32,int hi){
  const char*kb=Kslot+hi*1024+r32*16;
  #pragma unroll
  for(int d0=0;d0<4;++d0){
    const bf16x8 b0=*reinterpret_cast<const bf16x8*>(kb+d0*2048);
    const bf16x8 b1=*reinterpret_cast<const bf16x8*>(kb+d0*2048+512);
    if(d0==0){p0=__builtin_amdgcn_mfma_f32_32x32x16_bf16(b0,qr[0],negm,0,0,0);p1=__builtin_amdgcn_mfma_f32_32x32x16_bf16(b1,qr[0],negm,0,0,0);}
    else{p0=__builtin_amdgcn_mfma_f32_32x32x16_bf16(b0,qr[d0],p0,0,0,0);p1=__builtin_amdgcn_mfma_f32_32x32x16_bf16(b1,qr[d0],p1,0,0,0);}}
}
typedef __attribute__((address_space(3))) const char* lds_cptr;
typedef short v4i16_t __attribute__((ext_vector_type(4)));
__device__ __forceinline__ void kload8(bf16x8*kf,lds_cptr kp){
  kf[0]=*(const __attribute__((address_space(3))) bf16x8*)(kp);      kf[1]=*(const __attribute__((address_space(3))) bf16x8*)(kp+512);
  kf[2]=*(const __attribute__((address_space(3))) bf16x8*)(kp+2048); kf[3]=*(const __attribute__((address_space(3))) bf16x8*)(kp+2560);
  kf[4]=*(const __attribute__((address_space(3))) bf16x8*)(kp+4096); kf[5]=*(const __attribute__((address_space(3))) bf16x8*)(kp+4608);
  kf[6]=*(const __attribute__((address_space(3))) bf16x8*)(kp+6144); kf[7]=*(const __attribute__((address_space(3))) bf16x8*)(kp+6656);
}
__device__ __forceinline__ void kload2(bf16x8*kf,lds_cptr kp,int j){ kf[2*j]=*(const __attribute__((address_space(3))) bf16x8*)(kp+j*2048); kf[2*j+1]=*(const __attribute__((address_space(3))) bf16x8*)(kp+j*2048+512); }
__device__ __forceinline__ s16x4 vtr(lds_cptr p){ return __builtin_bit_cast(s16x4,__builtin_amdgcn_ds_read_tr16_b64_v4i16((__attribute__((address_space(3))) v4i16_t*)p)); }
__device__ __forceinline__ float rowmax(const f32x16&p0,const f32x16&p1){
  float a=max3f(p0[0],p0[1],p1[0]),b=max3f(p0[2],p0[3],p1[1]);a=max3f(a,p1[2],p1[3]);
  #pragma unroll
  for(int r=4;r<16;r+=4){a=max3f(a,p0[r],p0[r+1]);b=max3f(b,p0[r+2],p0[r+3]);a=max3f(a,p1[r],p1[r+1]);b=max3f(b,p1[r+2],p1[r+3]);}
  const float m=max2f(a,b);
  auto rr=__builtin_amdgcn_permlane32_swap(__float_as_uint(m),__float_as_uint(m),false,false);
  return max2f(__uint_as_float(rr[0]),__uint_as_float(rr[1]));
}
__device__ __forceinline__ void pv(f32x16*o,int vb,bf16x8 pa0,bf16x8 pa1,bf16x8 pa2,bf16x8 pa3){
  #pragma unroll
  for(int d0=0;d0<2;++d0){s16x4 lo[4],hi[4];
    #pragma unroll
    for(int ks=0;ks<4;++ks){
      asm volatile("ds_read_b64_tr_b16 %0,%1 offset:%c2":"=&v"(lo[ks]):"v"(vb),"i"(d0*4096+ks*1024):"memory");
      asm volatile("ds_read_b64_tr_b16 %0,%1 offset:%c2":"=&v"(hi[ks]):"v"(vb),"i"(d0*4096+ks*1024+512):"memory");}
    asm volatile("s_waitcnt lgkmcnt(0)":::"memory");SBAR();
    #define PK(k) (bf16x8){lo[k][0],lo[k][1],lo[k][2],lo[k][3],hi[k][0],hi[k][1],hi[k][2],hi[k][3]}
    o[d0]=__builtin_amdgcn_mfma_f32_32x32x16_bf16(pa0,PK(0),o[d0],0,0,0);
    o[d0]=__builtin_amdgcn_mfma_f32_32x32x16_bf16(pa1,PK(1),o[d0],0,0,0);
    o[d0]=__builtin_amdgcn_mfma_f32_32x32x16_bf16(pa2,PK(2),o[d0],0,0,0);
    o[d0]=__builtin_amdgcn_mfma_f32_32x32x16_bf16(pa3,PK(3),o[d0],0,0,0);
    #undef PK
  }
}

#ifndef ATTN_STORE16
#define ATTN_STORE16(p,v) (*(u32x4*)(p)=(v))
#endif
template<int THRL> __device__ __forceinline__ void attn_unit(int b,int qb,const bf16*Q,const bf16*__restrict__ K,const bf16*__restrict__ V,bf16*O,char*shm){
  int tid_=threadIdx.x; asm volatile("":"+v"(tid_)); const int tid=tid_,lane=tid&63,r32=lane&31,hi=lane>>5; const int wid=__builtin_amdgcn_readfirstlane(tid>>6);
  const long rowbase=(long)b*SEQ; const int q0=qb*QB;
  const bf16*Qw=Q+(rowbase+q0+wid*QBLK)*DM;
  const bf16*Kh=K+rowbase*DM,*Vh=V+rowbase*DM;
  const unsigned lds0=(unsigned)(uintptr_t)shm;
  float*wsf=(float*)(shm+LDS_WS)+wid*64;
  const bf16*ksrc=Kh+(long)lane*DM+wid*8;
  const bf16*vsrc=Vh+(long)(16*(wid&3)+(lane>>2))*DM+(wid>>2)*32+(lane&3)*8;
  const unsigned kdst=lds0+LDS_K+wid*1024, vdst=lds0+LDS_V+wid*1024;
  #define DMA_K(t,slot) glds16(ksrc+(long)(t)*KVBLK*DM,(unsigned)__builtin_amdgcn_readfirstlane(kdst+(slot)))
  #define DMA_V(t,slot) glds16(vsrc+(long)(t)*KVBLK*DM,(unsigned)__builtin_amdgcn_readfirstlane(vdst+(slot)))
  const int vb0=(int)(lds0+LDS_V)+((lane>>4)&1)*32+(lane&3)*8+(4*hi+((lane&15)>>2))*64;
  const char*Kbase=shm+LDS_K; bf16x8 kf[8];
  const lds_cptr shm3=(lds_cptr)shm; const lds_cptr kp0=shm3+LDS_K+hi*1024+r32*16; const lds_cptr vp0=shm3+LDS_V+((lane>>4)&1)*32+(lane&3)*8+(4*hi+((lane&15)>>2))*64;
  const int NT=(q0+QB)/KVBLK;
  DMA_K(0,0);DMA_V(0,0);DMA_K(1,SLOTB);
  bf16x8 qr[4];
  #pragma unroll
  for(int d0=0;d0<4;++d0)qr[d0]=*reinterpret_cast<const bf16x8*>(&Qw[(long)r32*DM+d0*16+hi*8]);
  float mhat=0.f,l_reg=0.f;f32x16 o[2];o[0]=f32x16{};o[1]=f32x16{};f32x16 negm=f32x16{};asm volatile("":"+v"(negm));
  const int qrel=wid*QBLK+r32;
  #define CMASK(P0,P1,t) do{int jb_=(t)-(NT-4); if(jb_>=0)cmask(P0,P1,jb_,qrel,hi);}while(0)
  bool resc=false;
  #define START(P0,P1) do{ const float rm=rowmax(P0,P1); resc=false; \
    { const float dl=rm; mhat=fadd_s(mhat,dl); \
      _Pragma("unroll") for(int r=0;r<16;++r){P0[r]=fsub_s(P0[r],dl);P1[r]=fsub_s(P1[r],dl);} \
      _Pragma("unroll") for(int r=0;r<16;++r)negm[r]=-mhat; asm volatile("":"+v"(negm)); } \
    _Pragma("unroll") for(int r=0;r<16;++r)P0[r]=__builtin_amdgcn_exp2f(P0[r]); }while(0)
  #define RESC() do{ if(resc){ asm volatile("s_waitcnt lgkmcnt(0)":::"memory"); \
      _Pragma("unroll") for(int d_=0;d_<2;++d_) _Pragma("unroll") for(int r=0;r<16;++r)o[d_][r]*=wsf[crow(r,hi)]; } }while(0)
  f32x16 pA0,pA1,pB0,pB1;
  int sl_prev=0,sl_cur=0,sl_next=SLOTB;
  #define ROT() do{sl_prev=sl_cur;sl_cur=sl_next;sl_next=(sl_next==(NSLOT-1)*SLOTB)?0:sl_next+SLOTB;}while(0)
  DMA_K(2,2*SLOTB);
  WAIT_BAR(3);
  qkt(pA0,pA1,Kbase,qr,negm,r32,hi);asm volatile("s_nop 15\n\ts_nop 7":"+v"(pA0),"+v"(pA1));CMASK(pA0,pA1,0);
  START(pA0,pA1);
  _Pragma("unroll") for(int r=0;r<16;++r)pA1[r]=__builtin_amdgcn_exp2f(pA1[r]);
  WAIT_BAR(0);
  DMA_K(3,0);DMA_V(1,SLOTB);
  ROT();
  kload8(kf,kp0+sl_cur);
  WAIT_BAR(2);
  s16x4 vlo[8],vhi[8]; u32x4 pw0,pw1,pw2,pw3;
  #define PKW(P,B) cvtpk_s(P[B],P[B+1])
  #define PAF(k) __builtin_bit_cast(bf16x8,pw##k)
  #define VFR(i) (bf16x8){vlo[i][0],vlo[i][1],vlo[i][2],vlo[i][3],vhi[i][0],vhi[i][1],vhi[i][2],vhi[i][3]}
  #define PIN(x) asm volatile("":"+v"(x))
  #define MX3(a,b,c) __builtin_fmaxf(__builtin_fmaxf((a),(b)),(c))
  #define GAPA(MF,A0,A1,A2,A3,W0,W1,PW) do{ MF; sacc+=A0; sacc+=A1; sacc+=A2; sacc+=A3; PIN(sacc); W0; W1; PIN(PW); SBAR(); }while(0)
  #define EX(v) __builtin_amdgcn_exp2f(v)
  #define GAPB(MF,X,B) do{ MF; X[B]=EX(X[B]); X[B+1]=EX(X[B+1]); X[B+2]=EX(X[B+2]); X[B+3]=EX(X[B+3]); PIN(X); SBAR(); }while(0)
  #define VRD(i) do{ vlo[i]=vtr(vp_+(((i)>>2)*4096+((i)&3)*1024)); vhi[i]=vtr(vp_+(((i)>>2)*4096+((i)&3)*1024+512)); }while(0)
  #define KRD(G,j) do{ if(G){ kload2(kf,kp0+sl_next,j); SBAR(); } }while(0)
  #define STEP(C0,C1,P0,P1,t,GK,GV,GL) do{ SBAR(); \
    const lds_cptr vp_=vp0+sl_prev; \
    VRD(0); SBAR(); float sacc=(P0[0]+P0[1]); \
    GAPA(C0=__builtin_amdgcn_mfma_f32_32x32x16_bf16(kf[0],qr[0],negm,0,0,0), P0[2],P0[3],P0[4],P0[5],     pw0[0]=PKW(P0,0), pw0[1]=PKW(P0,2), pw0); \
    VRD(4); SBAR(); GAPA(C1=__builtin_amdgcn_mfma_f32_32x32x16_bf16(kf[1],qr[0],negm,0,0,0), P0[6],P0[7],P0[8],P0[9],     pw0[2]=PKW(P0,4), pw0[3]=PKW(P0,6), pw0); \
    VRD(1); SBAR(); GAPA(C0=__builtin_amdgcn_mfma_f32_32x32x16_bf16(kf[2],qr[1],C0,0,0,0),   P0[10],P0[11],P0[12],P0[13], pw1[0]=PKW(P0,8), pw1[1]=PKW(P0,10), pw1); \
    VRD(5); SBAR(); GAPA(C1=__builtin_amdgcn_mfma_f32_32x32x16_bf16(kf[3],qr[1],C1,0,0,0),   P0[14],P0[15],P1[0],P1[1],   pw1[2]=PKW(P0,12),pw1[3]=PKW(P0,14), pw1); \
    VRD(2); SBAR(); GAPA(C0=__builtin_amdgcn_mfma_f32_32x32x16_bf16(kf[4],qr[2],C0,0,0,0),   P1[2],P1[3],P1[4],P1[5],     pw2[0]=PKW(P1,0), pw2[1]=PKW(P1,2), pw2); \
    VRD(6); SBAR(); GAPA(C1=__builtin_amdgcn_mfma_f32_32x32x16_bf16(kf[5],qr[2],C1,0,0,0),   P1[6],P1[7],P1[8],P1[9],     pw2[2]=PKW(P1,4), pw2[3]=PKW(P1,6), pw2); \
    VRD(3); SBAR(); GAPA(C0=__builtin_amdgcn_mfma_f32_32x32x16_bf16(kf[6],qr[3],C0,0,0,0),   P1[10],P1[11],P1[12],P1[13], pw3[0]=PKW(P1,8), pw3[1]=PKW(P1,10), pw3); \
    VRD(7); SBAR(); GAPA(C1=__builtin_amdgcn_mfma_f32_32x32x16_bf16(kf[7],qr[3],C1,0,0,0),   P1[14],P1[15],0.f,0.f,       pw3[2]=PKW(P1,12),pw3[3]=PKW(P1,14), pw3); \
    l_reg+=sacc; \
    if(GK){DMA_K((t)+3,sl_cur);} if(GV){DMA_V((t)+1,sl_next);} \
    CMASK(C0,C1,t); \
    { float a=MX3(C0[0],C0[1],C1[0]),b=MX3(C0[2],C0[3],C1[1]); a=MX3(a,C1[2],C1[3]); \
      _Pragma("unroll") for(int r=4;r<16;r+=4){a=MX3(a,C0[r],C0[r+1]);b=MX3(b,C0[r+2],C0[r+3]);a=MX3(a,C1[r],C1[r+1]);b=MX3(b,C1[r+2],C1[r+3]);} \
      float rm=__builtin_fmaxf(a,b); { auto rr=__builtin_amdgcn_permlane32_swap(__float_as_uint(rm),__float_as_uint(rm),false,false); rm=__builtin_fmaxf(__uint_as_float(rr[0]),__uint_as_float(rr[1])); } \
      resc=false; \
      if(__builtin_expect(__any(rm>(float)THRL),0)){ const float dl=__builtin_fmaxf(rm,0.f); mhat+=dl; \
        _Pragma("unroll") for(int r=0;r<16;++r){C0[r]-=dl;C1[r]-=dl;} \
        _Pragma("unroll") for(int r=0;r<16;++r)negm[r]=-mhat; asm volatile("":"+v"(negm)); \
        const float f=__builtin_amdgcn_exp2f(-dl); l_reg*=f; if(hi==0)wsf[r32]=f; resc=true; } } \
    SBAR(); \
    GAPB(o[0]=__builtin_amdgcn_mfma_f32_32x32x16_bf16(PAF(0),VFR(0),o[0],0,0,0), C0,0); \
    GAPB(o[1]=__builtin_amdgcn_mfma_f32_32x32x16_bf16(PAF(0),VFR(4),o[1],0,0,0), C0,4); \
    KRD(GL,0); GAPB(o[0]=__builtin_amdgcn_mfma_f32_32x32x16_bf16(PAF(1),VFR(1),o[0],0,0,0), C0,8); \
    KRD(GL,1); GAPB(o[1]=__builtin_amdgcn_mfma_f32_32x32x16_bf16(PAF(1),VFR(5),o[1],0,0,0), C0,12); \
    KRD(GL,2); GAPB(o[0]=__builtin_amdgcn_mfma_f32_32x32x16_bf16(PAF(2),VFR(2),o[0],0,0,0), C1,0); \
    KRD(GL,3); GAPB(o[1]=__builtin_amdgcn_mfma_f32_32x32x16_bf16(PAF(2),VFR(6),o[1],0,0,0), C1,4); \
    GAPB(o[0]=__builtin_amdgcn_mfma_f32_32x32x16_bf16(PAF(3),VFR(3),o[0],0,0,0), C1,8); \
    GAPB(o[1]=__builtin_amdgcn_mfma_f32_32x32x16_bf16(PAF(3),VFR(7),o[1],0,0,0), C1,12); \
    }while(0)
  int t=1;
  #undef CMASK
  #define CMASK(P0,P1,t) do{}while(0)
  for(;t+5<NT;t+=2){
    STEP(pB0,pB1,pA0,pA1,t,true,true,true);     WAIT_BAR(2); RESC(); ROT();
    STEP(pA0,pA1,pB0,pB1,t+1,true,true,true);   WAIT_BAR(2); RESC(); ROT();
  }
  #undef CMASK
  #define CMASK(P0,P1,t) do{int jb_=(t)-(NT-4); if(jb_>=0)cmask(P0,P1,jb_,qrel,hi);}while(0)
  #define ENDW(tt) do{ if((tt)+3<NT){WAIT_BAR(2);} else if((tt)+2<NT){WAIT_BAR(1);} else {WAIT_BAR(0);} }while(0)
  for(;t+1<NT;t+=2){
    STEP(pB0,pB1,pA0,pA1,t,(t+3<NT),(t+1<NT),(t+1<NT));       ENDW(t);   RESC(); ROT();
    STEP(pA0,pA1,pB0,pB1,t+1,(t+4<NT),(t+2<NT),(t+2<NT));     ENDW(t+1); RESC(); ROT();
  }
  STEP(pB0,pB1,pA0,pA1,NT-1,false,false,false); RESC();
  { float sacc=pB0[0]+pB0[1]; _Pragma("unroll") for(int r=2;r<16;++r)sacc+=pB0[r]; _Pragma("unroll") for(int r=0;r<16;++r)sacc+=pB1[r]; l_reg+=sacc;
    pw0=(u32x4){PKW(pB0,0),PKW(pB0,2),PKW(pB0,4),PKW(pB0,6)};pw1=(u32x4){PKW(pB0,8),PKW(pB0,10),PKW(pB0,12),PKW(pB0,14)};pw2=(u32x4){PKW(pB1,0),PKW(pB1,2),PKW(pB1,4),PKW(pB1,6)};pw3=(u32x4){PKW(pB1,8),PKW(pB1,10),PKW(pB1,12),PKW(pB1,14)};
    SBAR(); pv(o,vb0+sl_cur,PAF(0),PAF(1),PAF(2),PAF(3)); }
  #undef PKW
  #undef PAF
  #undef VFR
  #undef PIN
  #undef MX3
  #undef GAPA
  #undef GAPB
  #undef EX
  #undef VRD
  #undef KRD
  #undef STEP
  #undef ENDW
  {auto rr=__builtin_amdgcn_permlane32_swap(__float_as_uint(l_reg),__float_as_uint(l_reg),false,false);l_reg=__uint_as_float(rr[0])+__uint_as_float(rr[1]);}
  if(hi==0)wsf[32+r32]=l_reg;asm volatile("s_waitcnt lgkmcnt(0)":::"memory");
  float rli[16];
  #pragma unroll
  for(int r=0;r<16;++r)rli[r]=__builtin_amdgcn_rcpf(wsf[32+crow(r,hi)]);
  bf16*Ow=O+(rowbase+q0+wid*QBLK)*DM;
  { bf16*stg=(bf16*)(shm+LDS_OST)+wid*2048;
    #pragma unroll
    for(int r=0;r<16;++r){const int orow=crow(r,hi);
      #pragma unroll
      for(int d0=0;d0<2;++d0)stg[orow*64+d0*32+r32]=__float2bfloat16(o[d0][r]*rli[r]);}
    asm volatile("s_waitcnt lgkmcnt(0)":::"memory");
    #pragma unroll
    for(int i=0;i<4;++i){const int row=i*8+(lane>>3),ch=lane&7; const u32x4 v=*(const u32x4*)(stg+row*64+ch*8); ATTN_STORE16(Ow+(long)row*DM+ch*8,v);} }
  asm volatile("s_waitcnt lgkmcnt(0)\n\ts_barrier":::"memory");
  #undef DMA_K
  #undef DMA_V
  #undef CMASK
  #undef START
  #undef RESC
  #undef ROT
}
constexpr int ATTN_LDS_BYTES=LDS_BYTES;
#undef SBAR
#undef WAIT_BAR
}


constexpr int NWAVES = 8;
constexpr int NB = 16, S = 2048, D = 1024, T = NB * S;
constexpr int NL = 4, NE = 32, TOPK = 4;
constexpr int SLOT_ROWS = T * TOPK + NE * 256;
constexpr int MODC = 6 * D * NL + 2 * D + 2 * D;
constexpr int MOD_KV = 6 * D * NL, MOD_FIN = MOD_KV + 2 * D;
constexpr float EPS = 1e-5f;
constexpr float QSCALE = 0.125f * 1.4426950408889634f;
constexpr size_t MiB = 1u << 20;
constexpr size_t WS_CTL = 0, CTL_ZERO_BYTES = 1 * MiB;
constexpr size_t WS_MOD = 4 * MiB;
constexpr size_t WS_ROPE = 6 * MiB;
constexpr size_t WS_RFRAG = 7 * MiB;
constexpr size_t WS_TKE = 8 * MiB, WS_TKW = WS_TKE + 512 * 1024, WS_TKL = WS_TKW + 512 * 1024, WS_SLOT = WS_TKL + 512 * 1024;
constexpr size_t WS_WGCNT = 10 * MiB, WS_TEXP = WS_WGCNT + 64 * 1024, WS_NT = WS_TEXP + 64 * 1024;
constexpr size_t WS_ROWTOK = 11 * MiB;
constexpr size_t WS_WQKV = 16 * MiB, WS_AWO = 28 * MiB, WS_KVW = 32 * MiB, WS_BWQ = 36 * MiB, WS_BWO = 48 * MiB;
constexpr size_t WS_WGU = 64 * MiB, WS_WDN = 576 * MiB;
constexpr size_t WS_X = 832 * MiB, WS_H = 960 * MiB, WS_Q = 1024 * MiB, WS_KVSH = 1216 * MiB, WS_O = 1344 * MiB, WS_OP = 1408 * MiB, WS_LSE = 1600 * MiB, WS_HKV = 1608 * MiB;
constexpr size_t WS_HS = 1672 * MiB, WS_ACT = 1944 * MiB, WS_Y = 2216 * MiB, WS_END = 2488 * MiB;
constexpr int CW_BAR = 4096;
constexpr int RING_BYTES = 131072;
constexpr int MISC_OFF = RING_BYTES;
constexpr int HIST_OFF = MISC_OFF + 256, TEXP_OFF = MISC_OFF + 1024;
constexpr int LDS_BYTES = 147456;

#define GAS __attribute__((address_space(1)))
#define LAS __attribute__((address_space(3)))
typedef unsigned short bf16;
typedef unsigned v4u __attribute__((ext_vector_type(4)));
typedef unsigned v2u __attribute__((ext_vector_type(2)));
typedef float f32x4 __attribute__((ext_vector_type(4)));
typedef float f32x16 __attribute__((ext_vector_type(16)));
typedef short bf16x8 __attribute__((ext_vector_type(8)));
typedef short s16x4 __attribute__((ext_vector_type(4)));
#define RLX_AGENT __ATOMIC_RELAXED, __HIP_MEMORY_SCOPE_AGENT
#define LDS_WAIT() asm volatile("s_waitcnt lgkmcnt(0)" ::: "memory")
#define VM_WAIT() asm volatile("s_waitcnt vmcnt(0)" ::: "memory")
__device__ __forceinline__ unsigned f2bf(float f) { unsigned u = __builtin_bit_cast(unsigned, f); return (u + 0x7fffu + ((u >> 16) & 1u)) >> 16; }
__device__ __forceinline__ float bf2f(unsigned b) { return __builtin_bit_cast(float, b << 16); }
__device__ __forceinline__ unsigned pk2(float lo, float hi) { return f2bf(lo) | (f2bf(hi) << 16); }
__device__ __forceinline__ f32x4 unpack4(v2u r) { return (f32x4){bf2f(r.x & 0xffffu), bf2f(r.x >> 16), bf2f(r.y & 0xffffu), bf2f(r.y >> 16)}; }
__device__ __forceinline__ float wave_sum(float v) {
#pragma unroll
    for (int o = 1; o < 64; o <<= 1) v += __shfl_xor(v, o);
    return v;
}
__device__ __forceinline__ float dot4(f32x4 a) { return (a.x * a.x + a.y * a.y) + (a.z * a.z + a.w * a.w); }
#define XB_TMO      128
#define XB_XCNT(j)  (256  + 64 * (j))
#define XB_XSUB(j)  (1280 + 64 * (j))
#define XB_XGEN(j)  (2304 + 64 * (j))
#define XB_TOP      3328
#define XB_TOPGEN   3392
#define XCD_BAR_WORDS 3456
#define XB_SPIN_CAP (1u << 22)

__device__ __forceinline__ unsigned xb_ld(unsigned* p)              { return __hip_atomic_load(p, __ATOMIC_RELAXED, __HIP_MEMORY_SCOPE_AGENT); }
__device__ __forceinline__ unsigned xb_add(unsigned* p, unsigned v) { return __hip_atomic_fetch_add(p, v, __ATOMIC_RELAXED, __HIP_MEMORY_SCOPE_AGENT); }
__device__ __forceinline__ unsigned xb_xcc_id() { return (unsigned)__builtin_amdgcn_s_getreg((3 << 11) | 20) & 0xFu; }
#define XB_SPIN(cond, bar) do { unsigned _sp = 0; while (cond) { __builtin_amdgcn_s_sleep(1); \
    if ((++_sp & 255u) == 0u) { if (xb_ld(&(bar)[XB_TMO])) break; if (_sp > XB_SPIN_CAP) { atomicAdd(&(bar)[XB_TMO], 1u); break; } } } } while (0)

struct XcdBarrier {
    unsigned* bar; unsigned x;
    volatile LAS unsigned* st;
};

__device__ __forceinline__ XcdBarrier xcd_barrier_post(unsigned* bar, volatile LAS unsigned* st) {
    XcdBarrier b; b.bar = bar; b.x = xb_xcc_id(); b.st = st;
    if (threadIdx.x == 0) (void)xb_add(&bar[XB_XCNT(b.x)], 1u);
    return b;
}
__device__ __forceinline__ void xcd_barrier_complete(unsigned* bar, unsigned x, unsigned& nloc, unsigned& nx) {
    const unsigned G = gridDim.x * gridDim.y * gridDim.z;
    unsigned sum, cnt, mine, sp = 0u;
    for (;;) {
        sum = 0u; cnt = 0u; mine = 0u;
#pragma unroll
        for (unsigned j = 0; j < 16; ++j) { const unsigned c = xb_ld(&bar[XB_XCNT(j)]); sum += c; cnt += (c > 0u) ? 1u : 0u; mine = (j == x) ? c : mine; }
        if (sum == G) break;
        __builtin_amdgcn_s_sleep(1);
        if ((++sp & 255u) == 0u) { if (xb_ld(&bar[XB_TMO])) break; if (sp > XB_SPIN_CAP) { atomicAdd(&bar[XB_TMO], 1u); break; } }
    }
    nloc = mine > 0u ? mine : 1u; nx = cnt > 0u ? cnt : 1u;
}

__device__ __forceinline__ void xcd_barrier(const XcdBarrier& b) {
    asm volatile("s_waitcnt vmcnt(0)" ::: "memory");
    __syncthreads();
    if (threadIdx.x == 0) {
        unsigned* bar = b.bar;
        __builtin_amdgcn_s_waitcnt(0);
        unsigned nloc = b.st[0], nx = b.st[1];
        if (nloc == 0u) { xcd_barrier_complete(bar, b.x, nloc, nx); b.st[0] = nloc; b.st[1] = nx; }
        const unsigned old = xb_add(&bar[XB_XSUB(b.x)], 1u);
        const unsigned gen = old / nloc;
        if (old + 1u == (gen + 1u) * nloc) {
            __builtin_amdgcn_fence(__ATOMIC_RELEASE, "agent");
            asm volatile("s_waitcnt vmcnt(0)" ::: "memory");
            const unsigned og = xb_add(&bar[XB_TOP], 1u);
            const unsigned tg = og / nx;
            if (og + 1u == (tg + 1u) * nx) xb_add(&bar[XB_TOPGEN], 1u);
            else XB_SPIN(xb_ld(&bar[XB_TOPGEN]) == tg, bar);
            __builtin_amdgcn_fence(__ATOMIC_ACQUIRE, "agent");
            xb_add(&bar[XB_XGEN(b.x)], 1u);
            asm volatile("s_waitcnt vmcnt(0)" ::: "memory");
        } else {
            XB_SPIN(xb_ld(&bar[XB_XGEN(b.x)]) == gen, bar);
            __builtin_amdgcn_fence(__ATOMIC_ACQUIRE, "agent");
            asm volatile("s_waitcnt vmcnt(0)" ::: "memory");
        }
    }
    __syncthreads();
}

struct Args { const float* in[25]; float* out; unsigned char* ws; float invf[8]; float lam_init[2]; int ph_lo, ph_hi, use_bar, pad; };
enum { I_X = 0, I_C, I_MODW, I_MODB, I_MIXN, I_FFNN, I_AWQKV, I_AWO, I_ALAM, I_ASUBLN, I_KVN, I_KVMODW, I_KVMODB, I_KVW, I_BWQ, I_BWO, I_RW, I_RB, I_WGU, I_BGU, I_WDN, I_BDN, I_FINN, I_FINMODW, I_FINMODB };
struct Frame { LAS unsigned char* lds; int tid, lane, wave, G, gw, NGW, bid; };
typedef const __attribute__((address_space(4))) Args* ArgsP;

__device__ __forceinline__ void p0_transpose_item(const float* W, int N, int K, bf16* WT, int dst_row0, LAS float* scr, int k0, int n0, int lane) {
#pragma unroll 8
    for (int i = 0; i < 32; ++i) { const int kk = 2 * i + (lane >> 5); scr[kk * 33 + (lane & 31)] = W[(size_t)(k0 + kk) * N + n0 + (lane & 31)]; }
    LDS_WAIT(); asm volatile("" ::: "memory");
    const int c = lane & 7;
#pragma unroll
    for (int j = 0; j < 4; ++j) { const int n = (lane >> 3) + 8 * j; const LAS float* s = scr + (8 * c) * 33 + n;
        v4u o; o.x = pk2(s[0 * 33], s[1 * 33]); o.y = pk2(s[2 * 33], s[3 * 33]); o.z = pk2(s[4 * 33], s[5 * 33]); o.w = pk2(s[6 * 33], s[7 * 33]);
        *(GAS v4u*)(WT + (size_t)(dst_row0 + n) * K + k0 + 8 * c) = o; }
    LDS_WAIT(); asm volatile("" ::: "memory");
}
__device__ __forceinline__ void p0_prologue(const Frame& F, ArgsP ap) {
    unsigned char* ws = ap->ws;
    {
        LAS float* cT = (LAS float*)F.lds;
        LAS float* red = (LAS float*)(F.lds + 65536);
        const float* c = ap->in[I_C];
        for (int idx = F.tid; idx < NB * D; idx += NWAVES * 64) { const int b = idx >> 10, k = idx & 1023; const float v = c[idx]; cT[k * 16 + b] = v / (1.0f + __expf(-v)); }
        __syncthreads();
        float* modall = (float*)(ws + WS_MOD);
        for (int g = F.bid; g < MODC / 64; g += F.G) {
            const int cg0 = g * 64; const float* W; const float* bias; int N, col0;
            if (cg0 < MOD_KV) { const int l = cg0 / (6 * D); col0 = cg0 % (6 * D); W = ap->in[I_MODW] + (size_t)l * D * 6 * D; N = 6 * D; bias = ap->in[I_MODB] + l * 6 * D + col0; }
            else if (cg0 < MOD_FIN) { col0 = cg0 - MOD_KV; W = ap->in[I_KVMODW]; N = 2 * D; bias = ap->in[I_KVMODB] + col0; }
            else { col0 = cg0 - MOD_FIN; W = ap->in[I_FINMODW]; N = 2 * D; bias = ap->in[I_FINMODB] + col0; }
            float acc[16];
#pragma unroll
            for (int b = 0; b < 16; ++b) acc[b] = 0.f;
            const float* wp = W + (size_t)(F.wave * 128) * N + col0 + F.lane;
#pragma unroll 8
            for (int kk = 0; kk < 128; ++kk) { const float w = wp[(size_t)kk * N]; const LAS f32x4* cv = (const LAS f32x4*)(cT + (F.wave * 128 + kk) * 16);
                const f32x4 c0 = cv[0], c1 = cv[1], c2 = cv[2], c3 = cv[3];
                acc[0] += w * c0.x; acc[1] += w * c0.y; acc[2] += w * c0.z; acc[3] += w * c0.w; acc[4] += w * c1.x; acc[5] += w * c1.y; acc[6] += w * c1.z; acc[7] += w * c1.w;
                acc[8] += w * c2.x; acc[9] += w * c2.y; acc[10] += w * c2.z; acc[11] += w * c2.w; acc[12] += w * c3.x; acc[13] += w * c3.y; acc[14] += w * c3.z; acc[15] += w * c3.w; }
#pragma unroll
            for (int b = 0; b < 16; ++b) red[(F.wave * 16 + b) * 64 + F.lane] = acc[b];
            __syncthreads();
            for (int o = F.tid; o < 1024; o += NWAVES * 64) { const int b = o >> 6, ln = o & 63; float s = bias[ln];
#pragma unroll
                for (int w = 0; w < 8; ++w) s += red[(w * 16 + b) * 64 + ln];
                modall[(size_t)b * MODC + cg0 + ln] = s; }
            __syncthreads();
        }
        __syncthreads();
    }
    {
        const int gt = F.bid * (NWAVES * 64) + F.tid, NT_ = F.G * NWAVES * 64;
        float* cosT = (float*)(ws + WS_ROPE); float* sinT = cosT + S * 8;
        for (int idx = gt; idx < S * 8; idx += NT_) { const int pos = idx >> 3, i = idx & 7; float inv = ap->invf[0];
#pragma unroll
            for (int q = 1; q < 8; ++q) inv = (i == q) ? ap->invf[q] : inv;
            const float angf = (float)pos * inv; const double x = (double)angf; const double n = __builtin_rint(x * 0.15915494309189533577); const double r = x - n * 6.283185307179586476925; const double r2 = r * r;
            double sn = 1.0, cs = 1.0;
#pragma unroll
            for (int q = 14; q >= 1; --q) { sn = 1.0 - sn * r2 / (double)((2 * q) * (2 * q + 1)); cs = 1.0 - cs * r2 / (double)((2 * q - 1) * (2 * q)); }
            sn *= r; cosT[idx] = (float)cs; sinT[idx] = (float)sn; }
        bf16* rfrag = (bf16*)(ws + WS_RFRAG); const float* rw = ap->in[I_RW];
        for (int idx = gt; idx < NL * 32 * 2 * 64 * 8; idx += NT_) { const int j = idx & 7, lane = (idx >> 3) & 63, nb = (idx >> 9) & 1, s = (idx >> 10) & 31, l = idx >> 15;
            const float w = rw[((size_t)l * D + 32 * s + 8 * (lane >> 4) + j) * NE + 16 * nb + (lane & 15)]; const unsigned hi = f2bf(w), lo = f2bf(w - bf2f(hi));
            const size_t base = ((((size_t)l * 32 + s) * 2 + nb) * 2) * 512 + lane * 8 + j; rfrag[base] = (bf16)hi; rfrag[base + 512] = (bf16)lo; }
    }
    {
        LAS float* scr = (LAS float*)(F.lds + F.wave * 16384);
        constexpr int I_QKV = 16 * 96, I_SQ = 16 * 32, I_KV = 16 * 64, I_GU = 16 * 64, I_DN = 16 * 32;
        constexpr int E0 = 2 * I_QKV, E1 = E0 + 2 * I_SQ, E2 = E1 + I_KV, E3 = E2 + 2 * I_QKV, E4 = E3 + 2 * I_SQ, E5 = E4 + NL * NE * I_GU, E6 = E5 + NL * NE * I_DN;
        for (int it = F.gw; it < E6; it += F.NGW) {
            const float* W; bf16* WT; int N, r, per; bool gu = false;
            if (it < E0) { r = it; per = I_QKV; N = 3 * D; W = ap->in[I_AWQKV]; WT = (bf16*)(ws + WS_WQKV); }
            else if (it < E1) { r = it - E0; per = I_SQ; N = D; W = ap->in[I_AWO]; WT = (bf16*)(ws + WS_AWO); }
            else if (it < E2) { r = it - E1; per = I_KV; N = 2 * D; W = ap->in[I_KVW]; WT = (bf16*)(ws + WS_KVW); }
            else if (it < E3) { r = it - E2; per = I_QKV; N = 3 * D; W = ap->in[I_BWQ]; WT = (bf16*)(ws + WS_BWQ); }
            else if (it < E4) { r = it - E3; per = I_SQ; N = D; W = ap->in[I_BWO]; WT = (bf16*)(ws + WS_BWO); }
            else if (it < E5) { r = it - E4; per = I_GU; N = 2 * D; W = ap->in[I_WGU]; WT = (bf16*)(ws + WS_WGU); gu = true; }
            else { r = it - E5; per = I_DN; N = D; W = ap->in[I_WDN]; WT = (bf16*)(ws + WS_WDN); }
            const int mat = r / per, item = r % per, nblk = N / 32, kb = item / nblk, nb = item % nblk, n0 = 32 * nb;
            int drow = n0; if (gu) { const int half = n0 >> 10, rem = n0 & 1023; drow = (rem >> 7) * 256 + half * 128 + (rem & 127); }
            p0_transpose_item(W + (size_t)mat * D * N, N, D, WT + (size_t)mat * N * D, drow, scr, 64 * kb, n0, F.lane);
        }
    }
}

struct ModVec { f32x4 a[4], b[4]; };
__device__ __forceinline__ void load_modvec(ModVec& mv, const float* gain, const float* scale, const float* shift, int lane) {
#pragma unroll
    for (int j = 0; j < 4; ++j) { const int c = 4 * lane + 256 * j; const f32x4 g = *(const f32x4*)(gain + c), sc = *(const f32x4*)(scale + c); mv.a[j] = g * (sc + 1.0f); mv.b[j] = *(const f32x4*)(shift + c); }
}
__device__ __forceinline__ void store_bf16_row(bf16* orow, const f32x4 (&v)[4], int lane) {
#pragma unroll
    for (int j = 0; j < 4; ++j) { v2u w; w.x = pk2(v[j].x, v[j].y); w.y = pk2(v[j].z, v[j].w); *(v2u*)(orow + 4 * lane + 256 * j) = w; }
}
__device__ __forceinline__ void phase_modulate0(const Frame& F, const float* x, const float* gain, const float* modall, int sh_col, int sc_col, bf16* h) {
    for (int task = F.gw; task < T / 16; task += F.NGW) {
        const int r0 = task * 16, b = r0 >> 11; ModVec mv; load_modvec(mv, gain, modall + (size_t)b * MODC + sc_col, modall + (size_t)b * MODC + sh_col, F.lane);
        for (int i = 0; i < 16; ++i) { const float* xr = x + (size_t)(r0 + i) * D; f32x4 v[4]; float ss = 0.f;
#pragma unroll
            for (int j = 0; j < 4; ++j) { v[j] = *(const f32x4*)(xr + 4 * F.lane + 256 * j); ss += dot4(v[j]); }
            const float rstd = 1.0f / sqrtf(wave_sum(ss) * (1.0f / D) + EPS);
#pragma unroll
            for (int j = 0; j < 4; ++j) v[j] = v[j] * rstd * mv.a[j] + mv.b[j];
            store_bf16_row(h + (size_t)(r0 + i) * D, v, F.lane); }
    }
}
__device__ __forceinline__ void phase_subln(const Frame& F, const bf16* OP, const float* lamv  , const float* subln  , float lam_init, bf16* O) {
    float lam; { const float p1 = wave_sum(lamv[F.lane] * lamv[64 + F.lane]), p2 = wave_sum(lamv[128 + F.lane] * lamv[192 + F.lane]); lam = __expf(p1) - __expf(p2) + lam_init; }
    const f32x4 gsub = *(const f32x4*)(subln + ((4 * F.lane) & 127)) * (1.0f - lam_init);
    for (int task = F.gw; task < T / 16; task += F.NGW) {
        for (int i = 0; i < 16; ++i) { const size_t ro = (size_t)(task * 16 + i) * D; f32x4 v[4];
#pragma unroll
            for (int j = 0; j < 4; ++j) { const int c = 4 * F.lane + 256 * j; const f32x4 o0 = unpack4(*(const v2u*)(OP + ro + c)), o1 = unpack4(*(const v2u*)(OP + (size_t)T * D + ro + c));
                v[j] = o0 - o1 * lam; float ss = dot4(v[j]);
#pragma unroll
                for (int o = 1; o < 32; o <<= 1) ss += __shfl_xor(ss, o);
                v[j] = v[j] * (1.0f / sqrtf(ss * (1.0f / 128.0f) + EPS)) * gsub; }
            store_bf16_row(O + ro, v, F.lane); }
    }
}
__device__ __forceinline__ void phase_merge(const Frame& F, const bf16* OG, const float* LSE, bf16* O) {
    for (int task = F.gw; task < T / 16; task += F.NGW) {
        for (int i = 0; i < 16; ++i) { const int row = task * 16 + i; const size_t ro = (size_t)row * D; f32x4 v[4];
#pragma unroll
            for (int j = 0; j < 4; ++j) { const int c = 4 * F.lane + 256 * j, head = c >> 6;
                const float l0 = LSE[(size_t)row * 16 + head], l1 = LSE[(size_t)T * 16 + (size_t)row * 16 + head], l2 = LSE[(size_t)2 * T * 16 + (size_t)row * 16 + head];
                const float mx = fmaxf(l0, fmaxf(l1, l2)); const float a0 = __builtin_amdgcn_exp2f(l0 - mx), a1 = __builtin_amdgcn_exp2f(l1 - mx), a2 = __builtin_amdgcn_exp2f(l2 - mx); const float inv = 1.0f / (a0 + a1 + a2);
                const f32x4 o0 = unpack4(*(const v2u*)(OG + ro + c)), o1 = unpack4(*(const v2u*)(OG + (size_t)T * D + ro + c)), o2 = unpack4(*(const v2u*)(OG + (size_t)2 * T * D + ro + c));
                v[j] = (o0 * a0 + o1 * a1 + o2 * a2) * inv; }
            store_bf16_row(O + ro, v, F.lane); }
    }
}
__device__ __forceinline__ void phase_mod2_router(const Frame& F, const float* x, const float* gain, const float* modall, int sh_col, int sc_col, const bf16* rfrag, const float* rb,
                                                  bf16* h2, int* tk_e, float* tk_w, int* tk_l, int* wgcnt) {
    LAS int* hist = (LAS int*)(F.lds + HIST_OFF);
    if (F.tid < NE) hist[F.tid] = 0;
    __syncthreads();
    const int r = F.lane & 15, kq = F.lane >> 4;
    for (int task = F.gw; task < T / 16; task += F.NGW) {
        const int r0 = task * 16, b = r0 >> 11; const float* xr = x + (size_t)(r0 + r) * D + 8 * kq;
        float ss = 0.f;
#pragma unroll 8
        for (int s = 0; s < 32; ++s) ss += dot4(*(const f32x4*)(xr + 32 * s)) + dot4(*(const f32x4*)(xr + 32 * s + 4));
        ss += __shfl_xor(ss, 16); ss += __shfl_xor(ss, 32);
        const float rstd = 1.0f / sqrtf(ss * (1.0f / D) + EPS);
        const float* gp = gain + 8 * kq; const float* scp = modall + (size_t)b * MODC + sc_col + 8 * kq; const float* shp = modall + (size_t)b * MODC + sh_col + 8 * kq;
        bf16* hr = h2 + (size_t)(r0 + r) * D + 8 * kq;
        f32x4 acc0 = (f32x4){0.f, 0.f, 0.f, 0.f}, acc1 = acc0;
#pragma unroll 4
        for (int s = 0; s < 32; ++s) {
            const f32x4 xa = *(const f32x4*)(xr + 32 * s), xb = *(const f32x4*)(xr + 32 * s + 4);
            const f32x4 ga = *(const f32x4*)(gp + 32 * s), gb = *(const f32x4*)(gp + 32 * s + 4), sa = *(const f32x4*)(scp + 32 * s), sb = *(const f32x4*)(scp + 32 * s + 4), ha = *(const f32x4*)(shp + 32 * s), hb = *(const f32x4*)(shp + 32 * s + 4);
            const f32x4 va = xa * rstd * ga * (sa + 1.0f) + ha, vb = xb * rstd * gb * (sb + 1.0f) + hb;
            bf16x8 Ahi, Alo;
#pragma unroll
            for (int j = 0; j < 4; ++j) { const unsigned h0 = f2bf(va[j]), h1 = f2bf(vb[j]); Ahi[j] = (short)h0; Ahi[4 + j] = (short)h1; Alo[j] = (short)f2bf(va[j] - bf2f(h0)); Alo[4 + j] = (short)f2bf(vb[j] - bf2f(h1)); }
            *(bf16x8*)(hr + 32 * s) = Ahi;
            const bf16* fp = rfrag + (size_t)s * 2048 + F.lane * 8;
            const bf16x8 Bh0 = *(const bf16x8*)(fp), Bl0 = *(const bf16x8*)(fp + 512), Bh1 = *(const bf16x8*)(fp + 1024), Bl1 = *(const bf16x8*)(fp + 1536);
            acc0 = __builtin_amdgcn_mfma_f32_16x16x32_bf16(Ahi, Bh0, acc0, 0, 0, 0); acc0 = __builtin_amdgcn_mfma_f32_16x16x32_bf16(Alo, Bh0, acc0, 0, 0, 0); acc0 = __builtin_amdgcn_mfma_f32_16x16x32_bf16(Ahi, Bl0, acc0, 0, 0, 0);
            acc1 = __builtin_amdgcn_mfma_f32_16x16x32_bf16(Ahi, Bh1, acc1, 0, 0, 0); acc1 = __builtin_amdgcn_mfma_f32_16x16x32_bf16(Alo, Bh1, acc1, 0, 0, 0); acc1 = __builtin_amdgcn_mfma_f32_16x16x32_bf16(Ahi, Bl1, acc1, 0, 0, 0);
        }
        const float b0 = rb[r], b1 = rb[16 + r];
#pragma unroll
        for (int reg = 0; reg < 4; ++reg) {
            float v0 = acc0[reg] + b0, v1 = acc1[reg] + b1; float tv[4]; int te[4];
#pragma unroll
            for (int k = 0; k < 4; ++k) {
                float bv = (v0 >= v1) ? v0 : v1; int be = (v0 >= v1) ? r : 16 + r;
#pragma unroll
                for (int o = 1; o < 16; o <<= 1) { const float ov = __shfl_xor(bv, o); const int oe = __shfl_xor(be, o); if (ov > bv || (ov == bv && oe < be)) { bv = ov; be = oe; } }
                tv[k] = bv; te[k] = be; if (be == r) v0 = -INFINITY; if (be == 16 + r) v1 = -INFINITY;
            }
            const float p1 = __expf(tv[1] - tv[0]), p2 = __expf(tv[2] - tv[0]), p3 = __expf(tv[3] - tv[0]); const float inv = 1.0f / (1.0f + p1 + p2 + p3);
            if (r == 0) { const int row = r0 + 4 * kq + reg; const float pw[4] = {inv, p1 * inv, p2 * inv, p3 * inv};
#pragma unroll
                for (int k = 0; k < 4; ++k) { tk_e[row * 4 + k] = te[k]; tk_w[row * 4 + k] = pw[k]; tk_l[row * 4 + k] = __hip_atomic_fetch_add(hist + te[k], 1, __ATOMIC_RELAXED, __HIP_MEMORY_SCOPE_WORKGROUP); } }
        }
    }
    __syncthreads();
    if (F.tid < NE) wgcnt[F.bid * NE + F.tid] = hist[F.tid];
}
__device__ __forceinline__ void phase_scatter(const Frame& F, const int* wgcnt, const int* tk_e, const int* tk_l, int* slot_of, int* rowtok, int* texp, unsigned* ntiles, const bf16* h2, bf16* Hs) {
    LAS int* cnt = (LAS int*)F.lds; LAS int* tot = (LAS int*)(F.lds + 65536); LAS int* bas = tot + 32; LAS int* eoff = tot + 64;
    for (int i = F.tid; i < F.G * NE; i += NWAVES * 64) cnt[i] = wgcnt[i];
    __syncthreads();
    if (F.tid < NE) { int t = 0, bs = 0; for (int w = 0; w < F.G; ++w) { const int c = cnt[w * NE + F.tid]; bs += (w < F.bid) ? c : 0; t += c; } tot[F.tid] = t; bas[F.tid] = bs; }
    __syncthreads();
    if (F.tid == 0) { int off = 0; for (int e = 0; e < NE; ++e) { eoff[e] = off; off += (tot[e] + 255) & ~255; } eoff[NE] = off; }
    __syncthreads();
    if (F.bid == 0) { if (F.tid < NE) { for (int pm = eoff[F.tid] >> 8; pm < (eoff[F.tid + 1] >> 8); ++pm) texp[pm] = F.tid; } if (F.tid == 0) __hip_atomic_store(ntiles, (unsigned)(eoff[NE] >> 8), RLX_AGENT); }
    for (int task = F.gw; task < T / 16; task += F.NGW) {
        const int r0 = task * 16, row = r0 + (F.lane >> 2); const int idx = row * 4 + (F.lane & 3);
        const int e = tk_e[idx], slot = eoff[e] + bas[e] + tk_l[idx]; slot_of[idx] = slot; rowtok[slot] = row;
        for (int i = 0; i < 64; ++i) { const int sl = __shfl(slot, i); const bf16* src = h2 + (size_t)(r0 + (i >> 2)) * D + F.lane * 8; bf16* dst = Hs + (size_t)sl * D + F.lane * 8;
            const v4u p0 = *(const v4u*)src, p1 = *(const v4u*)(src + 512); *(v4u*)dst = p0; *(v4u*)(dst + 512) = p1; }
    }
}
__device__ __forceinline__ void phase_combine(const Frame& F, float* x, const bf16* Y, const int* slot_of, const float* tk_w, const float* g2base  , int mode,
                                              const float* gainA, const float* modall, int shA, int scA, bf16* h, const float* gainB, int shB, int scB, bf16* hkv, float* out) {
    for (int task = F.gw; task < T / 16; task += F.NGW) {
        const int r0 = task * 16, b = r0 >> 11; ModVec mv, mk; f32x4 g2[4];
        load_modvec(mv, gainA, modall + (size_t)b * MODC + scA, modall + (size_t)b * MODC + shA, F.lane);
        if (mode == 1) load_modvec(mk, gainB, modall + (size_t)b * MODC + scB, modall + (size_t)b * MODC + shB, F.lane);
#pragma unroll
        for (int j = 0; j < 4; ++j) g2[j] = *(const f32x4*)(g2base + (size_t)b * MODC + 4 * F.lane + 256 * j);
        const int myslot = slot_of[r0 * 4 + F.lane]; const float myw = tk_w[r0 * 4 + F.lane];
        for (int i = 0; i < 16; ++i) { const size_t ro = (size_t)(r0 + i) * D; f32x4 acc[4];
#pragma unroll
            for (int j = 0; j < 4; ++j) acc[j] = (f32x4){0.f, 0.f, 0.f, 0.f};
#pragma unroll
            for (int k = 0; k < 4; ++k) { const int sl = __shfl(myslot, i * 4 + k); const float w = __shfl(myw, i * 4 + k); const bf16* yr = Y + (size_t)sl * D;
#pragma unroll
                for (int j = 0; j < 4; ++j) acc[j] += unpack4(*(const v2u*)(yr + 4 * F.lane + 256 * j)) * w; }
            f32x4 v[4]; float ss = 0.f;
#pragma unroll
            for (int j = 0; j < 4; ++j) { v[j] = *(const f32x4*)(x + ro + 4 * F.lane + 256 * j) + g2[j] * acc[j]; ss += dot4(v[j]); }
            if (mode != 2) {
#pragma unroll
                for (int j = 0; j < 4; ++j) *(f32x4*)(x + ro + 4 * F.lane + 256 * j) = v[j]; }
            const float rstd = 1.0f / sqrtf(wave_sum(ss) * (1.0f / D) + EPS);
            if (mode == 2) {
#pragma unroll
                for (int j = 0; j < 4; ++j) *(f32x4*)(out + ro + 4 * F.lane + 256 * j) = v[j] * rstd * mv.a[j] + mv.b[j];
            } else {
                f32x4 o[4];
#pragma unroll
                for (int j = 0; j < 4; ++j) o[j] = v[j] * rstd * mv.a[j] + mv.b[j];
                store_bf16_row(h + ro, o, F.lane);
                if (mode == 1) {
#pragma unroll
                    for (int j = 0; j < 4; ++j) o[j] = v[j] * rstd * mk.a[j] + mk.b[j];
                    store_bf16_row(hkv + ro, o, F.lane); }
            }
        }
    }
}

__device__ __forceinline__ int crow16(int i, int h) { return (i & 3) + 8 * (i >> 2) + 4 * h; }
struct DilTile { bf16x8 kf[4]; v4u vv[4]; };
__device__ __forceinline__ void dil_load(DilTile& t, const bf16* KV, int rowbase, int res, int dsh, int kv0, int head, int lane) {
    const int r = lane & 31, h = lane >> 5; const bf16* kp = KV + (size_t)(rowbase + res + ((kv0 + r) << dsh)) * (2 * D) + head * 64 + 8 * h;
#pragma unroll
    for (int ds = 0; ds < 4; ++ds) t.kf[ds] = *(const bf16x8*)(kp + 16 * ds);
#pragma unroll
    for (int i = 0; i < 4; ++i) { const int ci = i * 64 + lane, key = ci >> 3, part = ci & 7; t.vv[i] = *(const v4u*)(KV + (size_t)(rowbase + res + ((kv0 + key) << dsh)) * (2 * D) + D + head * 64 + part * 8); }
}
__device__ __forceinline__ void phase_dilated(const Frame& F, const bf16* Q3, const bf16* KV, bf16* OG, float* LSE) {
    LAS unsigned char* wl = F.lds + F.wave * 8192;
    const int lane = F.lane, r = lane & 31, h = lane >> 5;
    const int NTASK = NB * 16 * 3 * 64;
    for (int task = F.gw; task < NTASK; task += F.NGW) {
        const int idx64 = task & 63, t2 = task >> 6, g = t2 % 3, t3 = t2 / 3, head = t3 & 15, b = t3 >> 4;
        const int dsh = 2 * g, nvb = 64 >> dsh, res = idx64 / nvb, vb = idx64 % nvb, v0 = vb * 32, rowbase = b * S;
        const int qrow = rowbase + res + ((v0 + r) << dsh);
        const bf16* qp = Q3 + (size_t)qrow * (3 * D) + g * D + head * 64 + 8 * h;
        bf16x8 qf[4];
#pragma unroll
        for (int ds = 0; ds < 4; ++ds) qf[ds] = *(const bf16x8*)(qp + 16 * ds);
        float m = -INFINITY, l = 0.f; f32x16 o0, o1;
#pragma unroll
        for (int i = 0; i < 16; ++i) { o0[i] = 0.f; o1[i] = 0.f; }
        const int jstart = (v0 >= 128) ? 0 : ((128 - v0) >> 5);
        DilTile cur, nxt; dil_load(cur, KV, rowbase, res, dsh, v0 - 128 + 32 * jstart, head, lane);
#pragma unroll
        for (int j = 0; j < 5; ++j) {
            if (j >= jstart) {
                if (j < 4) dil_load(nxt, KV, rowbase, res, dsh, v0 - 128 + 32 * (j + 1), head, lane);
#pragma unroll
                for (int i = 0; i < 4; ++i) { const int ci = i * 64 + lane, key = ci >> 3, part = ci & 7; *(LAS v4u*)(wl + key * 144 + part * 16) = cur.vv[i]; }
                f32x16 p;
#pragma unroll
                for (int i = 0; i < 16; ++i) p[i] = 0.f;
#pragma unroll
                for (int ds = 0; ds < 4; ++ds) p = __builtin_amdgcn_mfma_f32_32x32x16_bf16(cur.kf[ds], qf[ds], p, 0, 0, 0);
                if (j == 0) {
#pragma unroll
                    for (int i = 0; i < 16; ++i) if (crow16(i, h) < r) p[i] = -INFINITY;
                }
                if (j == 4) {
#pragma unroll
                    for (int i = 0; i < 16; ++i) if (crow16(i, h) > r) p[i] = -INFINITY;
                }
                float mt = p[0];
#pragma unroll
                for (int i = 1; i < 16; ++i) mt = fmaxf(mt, p[i]);
                mt = fmaxf(mt, __shfl_xor(mt, 32));
                const float mn = fmaxf(m, mt), alpha = __builtin_amdgcn_exp2f(m - mn); m = mn;
                float rs = 0.f;
#pragma unroll
                for (int i = 0; i < 16; ++i) { p[i] = __builtin_amdgcn_exp2f(p[i] - mn); rs += p[i]; }
                l = l * alpha + rs;
#pragma unroll
                for (int i = 0; i < 16; ++i) { o0[i] *= alpha; o1[i] *= alpha; }
                bf16x8 pf[2];
#pragma unroll
                for (int s = 0; s < 2; ++s) { v4u w; w.x = pk2(p[8 * s], p[8 * s + 1]); w.y = pk2(p[8 * s + 2], p[8 * s + 3]); w.z = pk2(p[8 * s + 4], p[8 * s + 5]); w.w = pk2(p[8 * s + 6], p[8 * s + 7]); pf[s] = __builtin_bit_cast(bf16x8, w); }
                const int i16 = lane & 15, q4 = i16 >> 2, p4 = i16 & 3, blk = (lane >> 4) & 1;
#pragma unroll
                for (int s = 0; s < 2; ++s) {
#pragma unroll
                    for (int db = 0; db < 2; ++db) {
                        const LAS unsigned char* a0 = wl + (16 * s + 4 * h + q4) * 144 + (32 * db + 16 * blk + 4 * p4) * 2;
                        const s16x4 lo = __builtin_bit_cast(s16x4, __builtin_amdgcn_ds_read_tr16_b64_v4i16((LAS s16x4*)a0));
                        const s16x4 hi = __builtin_bit_cast(s16x4, __builtin_amdgcn_ds_read_tr16_b64_v4i16((LAS s16x4*)(a0 + 8 * 144)));
                        const bf16x8 vf = (bf16x8){lo[0], lo[1], lo[2], lo[3], hi[0], hi[1], hi[2], hi[3]};
                        if (db == 0) o0 = __builtin_amdgcn_mfma_f32_32x32x16_bf16(vf, pf[s], o0, 0, 0, 0); else o1 = __builtin_amdgcn_mfma_f32_32x32x16_bf16(vf, pf[s], o1, 0, 0, 0);
                    }
                }
                if (j < 4) cur = nxt;
            }
        }
        const float lt = l + __shfl_xor(l, 32), inv = 1.0f / lt;
        bf16* op = OG + (size_t)g * T * D + (size_t)qrow * D + head * 64 + 4 * h;
#pragma unroll
        for (int ig = 0; ig < 4; ++ig) { v2u w0, w1; w0.x = pk2(o0[4 * ig] * inv, o0[4 * ig + 1] * inv); w0.y = pk2(o0[4 * ig + 2] * inv, o0[4 * ig + 3] * inv); w1.x = pk2(o1[4 * ig] * inv, o1[4 * ig + 1] * inv); w1.y = pk2(o1[4 * ig + 2] * inv, o1[4 * ig + 3] * inv);
            *(v2u*)(op + 8 * ig) = w0; *(v2u*)(op + 32 + 8 * ig) = w1; }
        if (h == 0) LSE[(size_t)g * T * 16 + (size_t)qrow * 16 + head] = m + __builtin_amdgcn_logf(lt);
    }
}

__global__ void __launch_bounds__(NWAVES * 64, 2) yoco_fwd(Args a_unused) {
    extern __shared__ __attribute__((aligned(16))) unsigned char lds_raw[];
    int ph_lo, ph_hi; unsigned barx = 0;
    {
        ArgsP ap = (ArgsP)__builtin_amdgcn_kernarg_segment_ptr(); ph_lo = ap->ph_lo; ph_hi = ap->ph_hi;
        LAS unsigned char* l0 = (LAS unsigned char*)lds_raw;
        for (int u = threadIdx.x; u < (LDS_BYTES - MISC_OFF) / 4; u += NWAVES * 64) ((LAS unsigned*)(l0 + MISC_OFF))[u] = 0u;
        __syncthreads();
        if (ap->use_bar) { XcdBarrier b0 = xcd_barrier_post((unsigned*)(ap->ws + WS_CTL) + CW_BAR, (volatile LAS unsigned*)(l0 + MISC_OFF)); barx = b0.x; }
    }
    int ph = 0;
#define PH_BEGIN if (ph_lo <= ph && ph < ph_hi) { ArgsP ap = (ArgsP)__builtin_amdgcn_kernarg_segment_ptr(); asm volatile("" : "+s"(ap)); unsigned char* ws = ap->ws; Frame F; { int t_ = threadIdx.x; asm volatile("" : "+v"(t_)); \
        unsigned lb_ = 0; asm volatile("" : "+s"(lb_)); F.lds = (LAS unsigned char*)lds_raw + lb_; F.tid = t_; F.lane = t_ & 63; F.wave = __builtin_amdgcn_readfirstlane(t_ >> 6); int g_ = gridDim.x, b_ = blockIdx.x; asm volatile("" : "+s"(g_), "+s"(b_)); F.G = g_; F.bid = b_; F.gw = b_ * NWAVES + F.wave; F.NGW = g_ * NWAVES; }
#define PH_END if (ph + 1 < ph_hi) { XcdBarrier b_; b_.bar = (unsigned*)(ws + WS_CTL) + CW_BAR; b_.x = barx; b_.st = (volatile LAS unsigned*)(F.lds + MISC_OFF); xcd_barrier(b_); } } ++ph;
#define P_MODALL ((float*)(ws + WS_MOD))
#define P_XRES ((float*)(ws + WS_X))
#define P_HBUF ((bf16*)(ws + WS_H))
#define P_HKV ((bf16*)(ws + WS_HKV))
#define P_QBUF ((bf16*)(ws + WS_Q))
#define P_KVSH ((bf16*)(ws + WS_KVSH))
#define P_OBUF ((bf16*)(ws + WS_O))
#define P_OPBUF ((bf16*)(ws + WS_OP))
#define P_LSE ((float*)(ws + WS_LSE))
#define P_HS ((bf16*)(ws + WS_HS))
#define P_ACT ((bf16*)(ws + WS_ACT))
#define P_Y ((bf16*)(ws + WS_Y))
#define P_TKE ((int*)(ws + WS_TKE))
#define P_TKW ((float*)(ws + WS_TKW))
#define P_TKL ((int*)(ws + WS_TKL))
#define P_SLOT ((int*)(ws + WS_SLOT))
#define P_WGCNT ((int*)(ws + WS_WGCNT))
#define P_TEXP ((int*)(ws + WS_TEXP))
#define P_NTW ((unsigned*)(ws + WS_NT))
#define P_ROWTOK ((int*)(ws + WS_ROWTOK))
#define P_COS ((const float*)(ws + WS_ROPE))
#define P_SIN ((const float*)(ws + WS_ROPE) + S * 8)

    PH_BEGIN p0_prologue(F, ap); PH_END
    PH_BEGIN phase_modulate0(F, ap->in[I_X], ap->in[I_MIXN], P_MODALL, 0, D, P_HBUF); PH_END

    for (int st = 0; st < 5; ++st) {
        const int kind = (st < 2) ? 0 : (st == 2 ? 1 : 2);
        const int l = (st < 2) ? st : st - 1;
        const int j = l - 2;
        PH_BEGIN {
            pg8::Gemm g; pg8::EpiRope E; int nN;
            if (kind == 0) { g = pg8::Gemm{P_HBUF, (const bf16*)(ws + WS_WQKV) + (size_t)l * 3 * D * D, T, 3 * D, D, 0}; nN = 12; E = pg8::EpiRope{P_QBUF, D, D, (size_t)T * D, 2 * D, D, QSCALE, P_COS, P_SIN}; }
            else if (kind == 1) { g = pg8::Gemm{P_HKV, (const bf16*)(ws + WS_KVW), T, 2 * D, D, 0}; nN = 8; E = pg8::EpiRope{P_KVSH, 2 * D, 0, 0, D, 0, 1.0f, P_COS, P_SIN}; }
            else { g = pg8::Gemm{P_HBUF, (const bf16*)(ws + WS_BWQ) + (size_t)j * 3 * D * D, T, 3 * D, D, 0}; nN = 12; E = pg8::EpiRope{P_QBUF, 3 * D, 0, 0, 3 * D, 3 * D, QSCALE, P_COS, P_SIN}; }
            pg8::Order O; O.init(T / 256, nN, F.G, F.bid, nullptr);
            pg8::gemm_phase<pg8::EpiRope, pg8::Order, true, true>(F.lds, g, O, E);
        } PH_END
        if (kind == 1) continue;
        if (kind == 0) {
            PH_BEGIN {
                const attn_body::bf16* Qp = (const attn_body::bf16*)P_QBUF; const attn_body::bf16* Kp = Qp + (size_t)T * D; const attn_body::bf16* Vp = Kp + (size_t)T * D; attn_body::bf16* Op = (attn_body::bf16*)P_OPBUF;
                const int vcu = (F.G % 8 == 0) ? (F.bid % 8) * (F.G / 8) + F.bid / 8 : F.bid;
                for (int p = vcu; p < NB * 16; p += F.G) { const int b = p >> 4, hh = p & 15, hq = hh >> 1, mm = hh & 1;
                    for (int half = 0; half < 2; ++half)
                        for (int qb = 0; qb < S / 256; ++qb)
                            attn_body::attn_unit<8>(b, qb, Qp + hh * 64, Kp + hh * 64, Vp + hq * 128 + half * 64, Op + (size_t)mm * T * D + hq * 128 + half * 64, (char*)F.lds); }
            } PH_END
            PH_BEGIN phase_subln(F, P_OPBUF, ap->in[I_ALAM] + l * 256, ap->in[I_ASUBLN] + l * 128, ap->lam_init[l & 1], P_OBUF); PH_END
        } else {
            PH_BEGIN phase_dilated(F, P_QBUF, P_KVSH, P_OPBUF, P_LSE); PH_END
            PH_BEGIN phase_merge(F, P_OPBUF, P_LSE, P_OBUF); PH_END
        }
        PH_BEGIN {
            const bf16* wo = (kind == 0) ? (const bf16*)(ws + WS_AWO) + (size_t)l * D * D : (const bf16*)(ws + WS_BWO) + (size_t)j * D * D;
            pg8::Gemm g{P_OBUF, wo, T, D, D, 0}; pg8::Order O; O.init(T / 256, 4, F.G, F.bid, nullptr);
            pg8::EpiResid E{(l == 0) ? ap->in[I_X] : P_XRES, P_XRES, P_MODALL + l * 6 * D + 2 * D, MODC};
            pg8::gemm_phase<pg8::EpiResid, pg8::Order, true, true>(F.lds, g, O, E);
        } PH_END
        PH_BEGIN phase_mod2_router(F, P_XRES, ap->in[I_FFNN] + l * D, P_MODALL, l * 6 * D + 3 * D, l * 6 * D + 4 * D, (const bf16*)(ws + WS_RFRAG) + (size_t)l * 65536, ap->in[I_RB] + l * NE, P_HBUF, P_TKE, P_TKW, P_TKL, P_WGCNT); PH_END
        PH_BEGIN phase_scatter(F, P_WGCNT, P_TKE, P_TKL, P_SLOT, P_ROWTOK, P_TEXP, P_NTW, P_HBUF, P_HS); PH_END
        PH_BEGIN {
            const int nt = (int)__hip_atomic_load(P_NTW, RLX_AGENT); LAS int* tl = (LAS int*)(F.lds + TEXP_OFF);
            for (int i = F.tid; i < nt; i += NWAVES * 64) tl[i] = P_TEXP[i];
            __syncthreads();
            pg8::Gemm g{P_HS, (const bf16*)(ws + WS_WGU) + (size_t)l * NE * 2 * D * D, nt * 256, 2 * D, D, (size_t)2 * D * D * 2}; pg8::Order O; O.init(nt, 8, F.G, F.bid, tl);
            pg8::EpiSwiglu E{P_ACT, ap->in[I_BGU] + (size_t)l * NE * 2 * D};
            pg8::gemm_phase<pg8::EpiSwiglu, pg8::Order, true, true>(F.lds, g, O, E);
        } PH_END
        PH_BEGIN {
            const int nt = (int)__hip_atomic_load(P_NTW, RLX_AGENT); LAS int* tl = (LAS int*)(F.lds + TEXP_OFF);
            for (int i = F.tid; i < nt; i += NWAVES * 64) tl[i] = P_TEXP[i];
            __syncthreads();
            pg8::Gemm g{P_ACT, (const bf16*)(ws + WS_WDN) + (size_t)l * NE * D * D, nt * 256, D, D, (size_t)D * D * 2}; pg8::Order O; O.init(nt, 4, F.G, F.bid, tl);
            pg8::EpiDown E{P_Y, ap->in[I_BDN] + (size_t)l * NE * D};
            pg8::gemm_phase<pg8::EpiDown, pg8::Order, true, true>(F.lds, g, O, E);
        } PH_END
        PH_BEGIN {
            const int mode = (l == 3) ? 2 : (l == 1 ? 1 : 0);
            const float* gainA = (l == 3) ? ap->in[I_FINN] : ap->in[I_MIXN] + (l + 1) * D; const int shA = (l == 3) ? MOD_FIN : (l + 1) * 6 * D, scA = shA + D;
            phase_combine(F, P_XRES, P_Y, P_SLOT, P_TKW, P_MODALL + l * 6 * D + 5 * D, mode, gainA, P_MODALL, shA, scA, P_HBUF, ap->in[I_KVN], MOD_KV, MOD_KV + D, P_HKV, ap->out);
        } PH_END
    }
#undef PH_BEGIN
#undef PH_END
}
constexpr int N_PHASES = 2 + 9 + 9 + 1 + 9 + 9;

#ifndef MK_PER_PHASE
#define MK_PER_PHASE 1
#endif
extern "C" void kernel_launch(void* const* d_in, const int* in_sizes, int n_in, void* d_out, int out_size, void* d_ws, size_t ws_size, hipStream_t stream) {
    static int grid = 0;
    if (grid == 0) {
        if (n_in != 25 || in_sizes[0] != T * D || out_size != T * D || ws_size < WS_END) { fprintf(stderr, "kernel_launch: unexpected shapes / workspace (n_in %d, ws %zu)\n", n_in, ws_size); grid = -1; return; }
        int dev = 0, cus = 0, per_cu = 0;
        if (hipGetDevice(&dev) != hipSuccess || hipDeviceGetAttribute(&cus, hipDeviceAttributeMultiprocessorCount, dev) != hipSuccess) { grid = -1; return; }
        if (hipFuncSetAttribute((const void*)yoco_fwd, hipFuncAttributeMaxDynamicSharedMemorySize, LDS_BYTES) != hipSuccess) { fprintf(stderr, "kernel_launch: hipFuncSetAttribute failed\n"); grid = -1; return; }
        if (hipOccupancyMaxActiveBlocksPerMultiprocessor(&per_cu, (const void*)yoco_fwd, NWAVES * 64, LDS_BYTES) != hipSuccess || per_cu < 1) fprintf(stderr, "kernel_launch: occupancy query reports %d\n", per_cu);
        (void)hipGetLastError();
        grid = cus;
    }
    if (grid < 0) return;
    if (hipMemsetAsync((char*)d_ws + WS_CTL, 0, CTL_ZERO_BYTES, stream) != hipSuccess) return;
    Args a{};
    for (int i = 0; i < 25; ++i) a.in[i] = (const float*)d_in[i];
    a.out = (float*)d_out; a.ws = (unsigned char*)d_ws;
    for (int i = 0; i < 8; ++i) a.invf[i] = (float)pow(500000.0, -(double)(2 * i) / 16.0);
    a.lam_init[0] = (float)(0.8 - 0.6 * exp(-0.3 * 0.0)); a.lam_init[1] = (float)(0.8 - 0.6 * exp(-0.3 * 1.0));
#if MK_PER_PHASE
    for (int p = 0; p < N_PHASES; ++p) { a.ph_lo = p; a.ph_hi = p + 1; a.use_bar = 0; hipLaunchKernelGGL(yoco_fwd, dim3(grid), dim3(NWAVES * 64), LDS_BYTES, stream, a); }
#else
    a.ph_lo = 0; a.ph_hi = N_PHASES; a.use_bar = 1; hipLaunchKernelGGL(yoco_fwd, dim3(grid), dim3(NWAVES * 64), LDS_BYTES, stream, a);
#endif
}
```

```cpp
#include <hip/hip_runtime.h>
#include <hip/hip_bf16.h>
#include <cstdio>
#include <cstdint>
#include <cmath>
namespace pg8 {
#define PG8_LAS __attribute__((address_space(3)))
typedef unsigned short bf16_t;
typedef short bf16x8 __attribute__((ext_vector_type(8)));
typedef float f32x4 __attribute__((ext_vector_type(4)));
typedef unsigned u32x4 __attribute__((ext_vector_type(4)));
constexpr int BM = 256, BK = 64, HALF = 128, HTB = HALF * BK * 2  , STAGE_BYTES = 8 * HTB, NXCD = 8, WGM = 8;

__host__ __device__ __forceinline__ int lds_byte(int r, int c) { const int st = (r >> 4) * 2 + (c >> 5), rr = r & 15, cc = c & 31, ob = rr * 64 + cc * 2; return st * 1024 + (ob ^ (((ob >> 9) & 1) << 5)); }
__host__ __device__ __forceinline__ void stage_rc(int b, int& R, int& C) { const int st = b / 1024, sb = b % 1024, swz = sb ^ (((sb >> 9) & 1) << 5); R = (st >> 1) * 16 + swz / 64; C = (st & 1) * 32 + (swz % 64) / 2; }
__host__ __device__ __forceinline__ int perm32(int rho) { const int n = rho >> 4, i = rho & 15; return 8 * (i >> 2) + 4 * n + (i & 3); }

struct Unit { int pm, pn, e; };
struct Gemm { const bf16_t* A; const bf16_t* Bt; int M, N, K; size_t estride; };

struct Order {
    int nM, nN, nwg, G, c; const PG8_LAS int* texp;
    __device__ __forceinline__ void init(int nM_, int nN_, int G_, int c_, const PG8_LAS int* texp_) { nM = nM_; nN = nN_; nwg = nM * nN; G = G_; c = c_; texp = texp_; }
    __device__ __forceinline__ bool next(int i, Unit& u) const {
        const long L = (long)i * G + c; if (L >= nwg) return false;
        int wgid = (int)L; { const int q = nwg / NXCD, r = nwg % NXCD, xcd = wgid % NXCD, off = wgid / NXCD; wgid = (xcd < r ? xcd * (q + 1) : r * (q + 1) + (xcd - r) * q) + off; }
        const int nig = WGM * nN, gid = wgid / nig, fm = gid * WGM, gsz = (nM - fm) < WGM ? (nM - fm) : WGM;
        u.pm = fm + ((wgid % nig) % gsz); u.pn = (wgid % nig) / gsz; u.e = texp ? texp[u.pm] : 0; return true;
    }
    __device__ __forceinline__ void a_ready(const Unit&) const {}
    __device__ __forceinline__ void done(const Unit&) const {}
};

__device__ __forceinline__ unsigned cvt_pk_bf16(float lo, float hi) { unsigned r; asm volatile("v_cvt_pk_bf16_f32 %0, %1, %2" : "=v"(r) : "v"(lo), "v"(hi)); return r; }
__device__ __forceinline__ f32x4 shfl16(f32x4 v) { f32x4 o; o[0] = __shfl_xor(v[0], 16); o[1] = __shfl_xor(v[1], 16); o[2] = __shfl_xor(v[2], 16); o[3] = __shfl_xor(v[3], 16); return o; }

struct EpiRope {
    static constexpr bool PERM = true, AFTER_DRAIN = false;
    bf16_t* O; int ldc; int split_cols; size_t split_stride; int rope_cols, scale_cols; float qscale; const float* cosT; const float* sinT;
    __device__ __forceinline__ void operator()(const f32x4 (&acc)[2][2][4][2], const Unit& u, int wr, int wc, int fr, int fq) const {
        const int row0 = u.pm * BM + wr * 64 + fr; int colt = u.pn * BM; bf16_t* base = O;
        const bool do_rope = (colt < rope_cols) && ((wc & 1) == 0); const float sc = (colt < scale_cols) ? qscale : 1.f;
        if (split_cols) { const int t = colt / split_cols; base += (size_t)t * split_stride; colt -= t * split_cols; }
        const int col0 = colt + wc * 32 + 8 * fq;
#pragma unroll
        for (int ai = 0; ai < 2; ++ai)
#pragma unroll
            for (int m = 0; m < 4; ++m) { const int row = row0 + ai * HALF + m * 16; bf16_t* rowp = base + (size_t)row * ldc + col0;
                f32x4 c0 = (f32x4){1.f, 1.f, 1.f, 1.f}, c1 = c0, s0 = (f32x4){0.f, 0.f, 0.f, 0.f}, s1 = s0;
                if (do_rope) { const int t = row & 2047; c0 = *(const f32x4*)(cosT + t * 8); c1 = *(const f32x4*)(cosT + t * 8 + 4); s0 = *(const f32x4*)(sinT + t * 8); s1 = *(const f32x4*)(sinT + t * 8 + 4);
                    if (fq == 0) { s0 = -s0; s1 = -s1; } else if (fq >= 2) { c0 = (f32x4){1.f, 1.f, 1.f, 1.f}; c1 = c0; s0 = (f32x4){0.f, 0.f, 0.f, 0.f}; s1 = s0; } }
#pragma unroll
                for (int bj = 0; bj < 2; ++bj) { f32x4 v0 = acc[ai][bj][m][0], v1 = acc[ai][bj][m][1];
                    if (do_rope) { const f32x4 o0 = shfl16(v0), o1 = shfl16(v1); v0 = v0 * c0 + o0 * s0; v1 = v1 * c1 + o1 * s1; }
                    v0 = v0 * sc; v1 = v1 * sc; u32x4 w; w.x = cvt_pk_bf16(v0[0], v0[1]); w.y = cvt_pk_bf16(v0[2], v0[3]); w.z = cvt_pk_bf16(v1[0], v1[1]); w.w = cvt_pk_bf16(v1[2], v1[3]);
                    *(u32x4*)(rowp + bj * HALF) = w; } }
    }
};
struct EpiResid {
    static constexpr bool PERM = false, AFTER_DRAIN = false;
    const float* xin; float* xout; const float* gate; int gstride;
    __device__ __forceinline__ void operator()(const f32x4 (&acc)[2][2][4][2], const Unit& u, int wr, int wc, int fr, int fq) const {
        const int row0 = u.pm * BM + wr * 64 + fr, col0 = u.pn * BM + wc * 32 + 4 * fq; const float* gp = gate + (size_t)(u.pm >> 3) * gstride + col0;
        f32x4 gv[2][2];
#pragma unroll
        for (int bj = 0; bj < 2; ++bj)
#pragma unroll
            for (int n = 0; n < 2; ++n) gv[bj][n] = *(const f32x4*)(gp + bj * HALF + n * 16);
#pragma unroll
        for (int ai = 0; ai < 2; ++ai)
#pragma unroll
            for (int m = 0; m < 4; ++m) { const size_t off = (size_t)(row0 + ai * HALF + m * 16) * 1024 + col0;
#pragma unroll
                for (int bj = 0; bj < 2; ++bj)
#pragma unroll
                    for (int n = 0; n < 2; ++n) { const f32x4 xi = *(const f32x4*)(xin + off + bj * HALF + n * 16); *(f32x4*)(xout + off + bj * HALF + n * 16) = xi + gv[bj][n] * acc[ai][bj][m][n]; }
                if (m & 1) asm volatile("" ::: "memory"); }
    }
};
struct EpiSwiglu {
    static constexpr bool PERM = true, AFTER_DRAIN = false;
    bf16_t* act; const float* bgu;
    __device__ __forceinline__ void operator()(const f32x4 (&acc)[2][2][4][2], const Unit& u, int wr, int wc, int fr, int fq) const {
        const int row0 = u.pm * BM + wr * 64 + fr, acol0 = u.pn * HALF + wc * 32 + 8 * fq; const float* bp = bgu + (size_t)u.e * 2048 + acol0;
        const f32x4 bg0 = *(const f32x4*)(bp), bg1 = *(const f32x4*)(bp + 4), bu0 = *(const f32x4*)(bp + 1024), bu1 = *(const f32x4*)(bp + 1028);
#pragma unroll
        for (int ai = 0; ai < 2; ++ai)
#pragma unroll
            for (int m = 0; m < 4; ++m) { bf16_t* rowp = act + (size_t)(row0 + ai * HALF + m * 16) * 1024 + acol0;
                f32x4 g0 = acc[ai][0][m][0] + bg0, g1 = acc[ai][0][m][1] + bg1, u0 = acc[ai][1][m][0] + bu0, u1 = acc[ai][1][m][1] + bu1; f32x4 r0, r1;
#pragma unroll
                for (int j = 0; j < 4; ++j) { const float ga = fminf(g0[j], 7.0f), gb = fminf(g1[j], 7.0f), ua = fminf(fmaxf(u0[j], -7.0f), 7.0f), ub = fminf(fmaxf(u1[j], -7.0f), 7.0f);
                    const float sa = __builtin_amdgcn_rcpf(1.0f + __builtin_amdgcn_exp2f(ga * (-1.702f * 1.4426950408889634f))), sb = __builtin_amdgcn_rcpf(1.0f + __builtin_amdgcn_exp2f(gb * (-1.702f * 1.4426950408889634f)));
                    r0[j] = (ua + 1.0f) * (ga * sa); r1[j] = (ub + 1.0f) * (gb * sb); }
                u32x4 w; w.x = cvt_pk_bf16(r0[0], r0[1]); w.y = cvt_pk_bf16(r0[2], r0[3]); w.z = cvt_pk_bf16(r1[0], r1[1]); w.w = cvt_pk_bf16(r1[2], r1[3]);
                *(u32x4*)rowp = w; }
    }
};
struct EpiDown {
    static constexpr bool PERM = true, AFTER_DRAIN = false;
    bf16_t* Y; const float* bd;
    __device__ __forceinline__ void operator()(const f32x4 (&acc)[2][2][4][2], const Unit& u, int wr, int wc, int fr, int fq) const {
        const int row0 = u.pm * BM + wr * 64 + fr, col0 = u.pn * BM + wc * 32 + 8 * fq; const float* bp = bd + (size_t)u.e * 1024 + col0;
        f32x4 bv[2][2];
#pragma unroll
        for (int bj = 0; bj < 2; ++bj)
#pragma unroll
            for (int n = 0; n < 2; ++n) bv[bj][n] = *(const f32x4*)(bp + bj * HALF + 4 * n);
#pragma unroll
        for (int ai = 0; ai < 2; ++ai)
#pragma unroll
            for (int m = 0; m < 4; ++m) { bf16_t* rowp = Y + (size_t)(row0 + ai * HALF + m * 16) * 1024 + col0;
#pragma unroll
                for (int bj = 0; bj < 2; ++bj) { const f32x4 v0 = acc[ai][bj][m][0] + bv[bj][0], v1 = acc[ai][bj][m][1] + bv[bj][1];
                    u32x4 w; w.x = cvt_pk_bf16(v0[0], v0[1]); w.y = cvt_pk_bf16(v0[2], v0[3]); w.z = cvt_pk_bf16(v1[0], v1[1]); w.w = cvt_pk_bf16(v1[2], v1[3]);
                    *(u32x4*)(rowp + bj * HALF) = w; } }
    }
};

template <class Epi, class Sched, bool ALIGN_EPI = false, bool SP2 = false>
__device__ __forceinline__ void gemm_phase(PG8_LAS unsigned char* lds, const Gemm g, const Sched& S, const Epi& E) {
    int tid_ = threadIdx.x; asm volatile("" : "+v"(tid_));
    const int tid = tid_, wid = __builtin_amdgcn_readfirstlane(tid >> 6), lane = tid & 63, wr = wid >> 2, wc = wid & 3, fr = lane & 15, fq = lane >> 4;
    constexpr int K = 1024, nt = K / BK;
    unsigned voffA[2], voffB[2];
#pragma unroll
    for (int i = 0; i < 2; ++i) { int R, C; stage_rc(tid * 16 + i * 8192, R, C); const int Rb = Epi::PERM ? ((R & ~31) + perm32(R & 31)) : R;
        voffA[i] = (unsigned)(R * K + C) * 2u; voffB[i] = (unsigned)(Rb * K + C) * 2u; }
    const size_t kstep = (size_t)(BK * 2);
    const size_t hstep = (size_t)HALF * K * 2;
    const size_t tstep = 2 * hstep;
    const unsigned ldsw = (unsigned)wid * 1024u;
    const int aoff = lds_byte(wr * 64 + fr, fq * 8), boff = lds_byte(wc * 32 + fr, fq * 8);
#define PG8_SA(b, h) (((b) * 2 + (h)) * HTB)
#define PG8_SB(b, h) ((4 + (b) * 2 + (h)) * HTB)
#define PG8_STAGE(bufoff, gbase, voff) do { _Pragma("unroll") for (int _i = 0; _i < 2; ++_i) \
        __builtin_amdgcn_global_load_lds((const unsigned*)((const char*)(gbase) + (voff)[_i]), (PG8_LAS unsigned*)(lds + (bufoff) + ldsw + _i * 8192), 16, 0, 0); } while (0)
#define PG8_LDA(dst, b, h) do { _Pragma("unroll") for (int m = 0; m < 4; ++m) _Pragma("unroll") for (int k = 0; k < 2; ++k) dst[m][k] = *(const PG8_LAS bf16x8*)(lds + PG8_SA(b, h) + aoff + m * 2048 + k * 1024); } while (0)
#define PG8_LDB(dst, b, h) do { _Pragma("unroll") for (int n = 0; n < 2; ++n) _Pragma("unroll") for (int k = 0; k < 2; ++k) dst[n][k] = *(const PG8_LAS bf16x8*)(lds + PG8_SB(b, h) + boff + n * 2048 + k * 1024); } while (0)
#define PG8_MMA(ai, bj, At, Bt) do { __builtin_amdgcn_s_setprio(1); _Pragma("unroll") for (int m = 0; m < 4; ++m) _Pragma("unroll") for (int n = 0; n < 2; ++n) _Pragma("unroll") for (int k = 0; k < 2; ++k) \
        acc[ai][bj][m][n] = __builtin_amdgcn_mfma_f32_16x16x32_bf16(Bt[n][k], At[m][k], acc[ai][bj][m][n], 0, 0, 0); __builtin_amdgcn_s_setprio(0); } while (0)
#define PG8_WAIT_V(n) asm volatile("s_waitcnt vmcnt(" #n ")" ::: "memory")
#define PG8_WAIT_L(n) asm volatile("s_waitcnt lgkmcnt(" #n ")" ::: "memory")
#define PG8_BAR __builtin_amdgcn_s_barrier()
#define PG8_SCHED __builtin_amdgcn_sched_barrier(0)
    Unit cur, nxt; int ui = 0;
    if (!S.next(0, cur)) return;
    f32x4 acc[2][2][4][2];
#pragma unroll
    for (int a = 0; a < 2; ++a)
#pragma unroll
        for (int b = 0; b < 2; ++b)
#pragma unroll
            for (int m = 0; m < 4; ++m)
#pragma unroll
                for (int n = 0; n < 2; ++n) acc[a][b][m][n] = (f32x4){0.f, 0.f, 0.f, 0.f};
    bf16x8 At[4][2], B0[2][2], B1[2][2];
    const char* cA = (const char*)g.A + (size_t)cur.pm * tstep; const char* cB = (const char*)g.Bt + (size_t)cur.pn * tstep + (size_t)cur.e * g.estride;
    S.a_ready(cur);
    if constexpr (SP2) {
        PG8_STAGE(PG8_SB(0, 0), cB, voffB); PG8_STAGE(PG8_SB(0, 1), cB + hstep, voffB); PG8_STAGE(PG8_SA(0, 0), cA, voffA); PG8_STAGE(PG8_SA(0, 1), cA + hstep, voffA);
        if (wr == 1) PG8_BAR;
        PG8_WAIT_V(2); PG8_BAR;
        PG8_STAGE(PG8_SB(1, 0), cB + kstep, voffB); PG8_STAGE(PG8_SA(1, 0), cA + kstep, voffA); PG8_STAGE(PG8_SB(1, 1), cB + hstep + kstep, voffB);
        PG8_WAIT_V(6); PG8_BAR;
    } else {
        PG8_STAGE(PG8_SB(0, 0), cB, voffB); PG8_STAGE(PG8_SA(0, 0), cA, voffA); PG8_STAGE(PG8_SB(0, 1), cB + hstep, voffB); PG8_STAGE(PG8_SA(0, 1), cA + hstep, voffA);
        if (wr == 1) PG8_BAR;
        PG8_WAIT_V(4); PG8_BAR;
        PG8_STAGE(PG8_SB(1, 0), cB + kstep, voffB); PG8_STAGE(PG8_SA(1, 0), cA + kstep, voffA); PG8_STAGE(PG8_SB(1, 1), cB + hstep + kstep, voffB);
        PG8_WAIT_V(6); PG8_BAR;
    }
    for (;;) {
        const bool has_next = S.next(ui + 1, nxt);
        const char* nA = has_next ? (const char*)g.A + (size_t)nxt.pm * tstep : cA; const char* nB = has_next ? (const char*)g.Bt + (size_t)nxt.pn * tstep + (size_t)nxt.e * g.estride : cB;
        for (int t = 0; t < nt; t += 2) {
            const bool last = (t == nt - 2);
            const char* a1 = cA + (size_t)(t + 1) * kstep;
            const char* a2 = last ? nA : cA + (size_t)(t + 2) * kstep; const char* b2 = last ? nB : cB + (size_t)(t + 2) * kstep;
            const char* a3 = a2 + kstep; const char* b3 = b2 + kstep;
            if (last && has_next) S.a_ready(nxt);
            if constexpr (SP2) {
            PG8_LDB(B0, 0, 0); PG8_LDB(B1, 0, 1); PG8_SCHED; PG8_LDA(At, 0, 0); PG8_STAGE(PG8_SA(1, 1), a1 + hstep, voffA);
            PG8_WAIT_V(8); PG8_WAIT_L(0); PG8_BAR; PG8_MMA(0, 0, At, B0); PG8_MMA(0, 1, At, B1); PG8_BAR; PG8_SCHED;
            PG8_LDA(At, 0, 1); PG8_STAGE(PG8_SB(0, 0), b2, voffB); PG8_STAGE(PG8_SB(0, 1), b2 + hstep, voffB); PG8_STAGE(PG8_SA(0, 0), a2, voffA);
            PG8_WAIT_V(8); PG8_WAIT_L(0); PG8_BAR; PG8_MMA(1, 0, At, B0); PG8_MMA(1, 1, At, B1); PG8_BAR; PG8_SCHED;
            PG8_LDB(B0, 1, 0); PG8_LDB(B1, 1, 1); PG8_SCHED; PG8_LDA(At, 1, 0); PG8_STAGE(PG8_SA(0, 1), a2 + hstep, voffA);
            PG8_WAIT_V(8); PG8_WAIT_L(0); PG8_BAR; PG8_MMA(0, 0, At, B0); PG8_MMA(0, 1, At, B1); PG8_BAR; PG8_SCHED;
            PG8_LDA(At, 1, 1); PG8_STAGE(PG8_SB(1, 0), b3, voffB); PG8_STAGE(PG8_SB(1, 1), b3 + hstep, voffB); PG8_STAGE(PG8_SA(1, 0), a3, voffA);
            PG8_WAIT_V(8); PG8_WAIT_L(0); PG8_BAR; PG8_MMA(1, 0, At, B0); PG8_MMA(1, 1, At, B1); PG8_BAR; PG8_SCHED;
            } else {
            PG8_LDB(B0, 0, 0); PG8_SCHED; PG8_LDA(At, 0, 0); PG8_STAGE(PG8_SA(1, 1), a1 + hstep, voffA);
            PG8_WAIT_L(8); PG8_BAR; PG8_WAIT_L(0); PG8_MMA(0, 0, At, B0); PG8_BAR; PG8_SCHED;
            PG8_LDB(B1, 0, 1); PG8_STAGE(PG8_SB(0, 0), b2, voffB);
            PG8_BAR; PG8_WAIT_L(0); PG8_MMA(0, 1, At, B1); PG8_BAR;
            PG8_LDA(At, 0, 1); PG8_STAGE(PG8_SA(0, 0), a2, voffA);
            PG8_BAR; PG8_WAIT_L(0); PG8_MMA(1, 0, At, B0); PG8_BAR; PG8_SCHED;
            PG8_STAGE(PG8_SB(0, 1), b2 + hstep, voffB);
            PG8_WAIT_V(6); PG8_BAR; PG8_MMA(1, 1, At, B1); PG8_BAR;
            PG8_LDB(B0, 1, 0); PG8_SCHED; PG8_LDA(At, 1, 0); PG8_STAGE(PG8_SA(0, 1), a2 + hstep, voffA);
            PG8_WAIT_L(8); PG8_BAR; PG8_WAIT_L(0); PG8_MMA(0, 0, At, B0); PG8_BAR; PG8_SCHED;
            PG8_LDB(B1, 1, 1); PG8_STAGE(PG8_SB(1, 0), b3, voffB);
            PG8_BAR; PG8_WAIT_L(0); PG8_MMA(0, 1, At, B1); PG8_BAR;
            PG8_LDA(At, 1, 1); PG8_STAGE(PG8_SA(1, 0), a3, voffA);
            PG8_BAR; PG8_WAIT_L(0); PG8_MMA(1, 0, At, B0); PG8_BAR; PG8_SCHED;
            PG8_STAGE(PG8_SB(1, 1), b3 + hstep, voffB);
            PG8_WAIT_V(6); PG8_BAR; PG8_MMA(1, 1, At, B1); PG8_BAR;
            }
        }
        if constexpr (ALIGN_EPI) { if (wr == 0) PG8_BAR; }
        if constexpr (!Epi::AFTER_DRAIN) { E(acc, cur, wr, wc, fr, fq); S.done(cur); }
        if (!has_next) break;
#pragma unroll
        for (int a = 0; a < 2; ++a)
#pragma unroll
            for (int b = 0; b < 2; ++b)
#pragma unroll
                for (int m = 0; m < 4; ++m)
#pragma unroll
                    for (int n = 0; n < 2; ++n) acc[a][b][m][n] = (f32x4){0.f, 0.f, 0.f, 0.f};
        cur = nxt; cA = nA; cB = nB; ++ui;
        if constexpr (ALIGN_EPI) { if (wr == 1) PG8_BAR; }
    }
    PG8_WAIT_V(0);
    if constexpr (!ALIGN_EPI) { if (wr == 0) PG8_BAR; }
    PG8_BAR;
    if constexpr (Epi::AFTER_DRAIN) { E.fused(acc, cur, wr, wc, fr, fq, lds, wid, lane); S.done(cur); }
#undef PG8_SA
#undef PG8_SB
#undef PG8_STAGE
#undef PG8_LDA
#undef PG8_LDB
#undef PG8_MMA
#undef PG8_WAIT_V
#undef PG8_WAIT_L
#undef PG8_BAR
#undef PG8_SCHED
}
}
namespace attn_body {
using bf16=__hip_bfloat16;
using bf16x8=__attribute__((ext_vector_type(8)))short;
using s16x4=__attribute__((ext_vector_type(4)))short;
using f32x16=__attribute__((ext_vector_type(16)))float;
using u32x4=__attribute__((ext_vector_type(4)))unsigned;
constexpr int BATCH=16,NHEAD=16,SEQ=2048,D=64,DM=NHEAD*D;
constexpr int NW=8,QBLK=32,QB=QBLK*NW,KVBLK=64,NQB=SEQ/QB;
constexpr int ATTN_PITCH=DM, ATTN_UNIT_ROWS=QB;
__device__ __forceinline__ int crow(int r,int hi){return (r&3)+8*(r>>2)+4*hi;}
#define SBAR() __builtin_amdgcn_sched_barrier(0)
__device__ __forceinline__ void cmask(f32x16&p0,f32x16&p1,int jb,int qrel,int hi){
  const float NEG=-INFINITY; int kb=64*jb+4*hi;
  #pragma unroll
  for(int r=0;r<16;++r){int kv=kb+(r&3)+8*(r>>2); if(kv>qrel)p0[r]=NEG; if(kv+32>qrel)p1[r]=NEG;}
}

constexpr int NSLOT=3, SLOTB=8192;
constexpr int LDS_K=0, LDS_V=NSLOT*SLOTB, LDS_WS=2*NSLOT*SLOTB, LDS_OST=LDS_WS+NW*64*4, LDS_BYTES=LDS_OST+NW*4096;
constexpr float C2=0.125f*1.4426950408889634f;
__device__ __forceinline__ void glds16(const void*gsrc,unsigned lds_dst){unsigned keep;
  asm volatile("s_mov_b32 %0, m0\n\ts_mov_b32 m0, %2\n\ts_nop 0\n\tglobal_load_lds_dwordx4 %1, off\n\ts_mov_b32 m0, %0":"=&s"(keep):"v"(gsrc),"s"(lds_dst):"memory");}
__device__ __forceinline__ float max3f(float a,float b,float c){float r;asm("v_max3_f32 %0, %1, %2, %3":"=v"(r):"v"(a),"v"(b),"v"(c));return r;}
__device__ __forceinline__ float max2f(float a,float b){float r;asm("v_max_f32_e32 %0, %1, %2":"=v"(r):"v"(a),"v"(b));return r;}
__device__ __forceinline__ float fadd_s(float a,float b){float r;asm("v_add_f32_e32 %0, %1, %2":"=v"(r):"v"(a),"v"(b));return r;}
__device__ __forceinline__ float fsub_s(float a,float b){float r;asm("v_sub_f32_e32 %0, %1, %2":"=v"(r):"v"(a),"v"(b));return r;}
typedef float f32x2_t __attribute__((ext_vector_type(2))); typedef __bf16 bf16x2_t __attribute__((ext_vector_type(2)));
__device__ __forceinline__ unsigned cvtpk_s(float lo,float hi){f32x2_t v={lo,hi};bf16x2_t b=__builtin_convertvector(v,bf16x2_t);return __builtin_bit_cast(unsigned,b);}
#define WAIT_BAR(N) asm volatile("s_waitcnt vmcnt(" #N ") lgkmcnt(0)\n\ts_barrier":::"memory")

__device__ __forceinline__ void qkt(f32x16&p0,f32x16&p1,const char*Kslot,const bf16x8*qr,const f32x16&negm,int r32,int hi){
  const char*kb=Kslot+hi*1024+r32*16;
  #pragma unroll
  for(int d0=0;d0<4;++d0){
    const bf16x8 b0=*reinterpret_cast<const bf16x8*>(kb+d0*2048);
    const bf16x8 b1=*reinterpret_cast<const bf16x8*>(kb+d0*2048+512);
    if(d0==0){p0=__builtin_amdgcn_mfma_f32_32x32x16_bf16(b0,qr[0],negm,0,0,0);p1=__builtin_amdgcn_mfma_f32_32x32x16_bf16(b1,qr[0],negm,0,0,0);}
    else{p0=__builtin_amdgcn_mfma_f32_32x32x16_bf16(b0,qr[d0],p0,0,0,0);p1=__builtin_amdgcn_mfma_f32_32x32x16_bf16(b1,qr[d0],p1,0,0,0);}}
}
typedef __attribute__((address_space(3))) const char* lds_cptr;
typedef short v4i16_t __attribute__((ext_vector_type(4)));
__device__ __forceinline__ void kload8(bf16x8*kf,lds_cptr kp){
  kf[0]=*(const __attribute__((address_space(3))) bf16x8*)(kp);      kf[1]=*(const __attribute__((address_space(3))) bf16x8*)(kp+512);
  kf[2]=*(const __attribute__((address_space(3))) bf16x8*)(kp+2048); kf[3]=*(const __attribute__((address_space(3))) bf16x8*)(kp+2560);
  kf[4]=*(const __attribute__((address_space(3))) bf16x8*)(kp+4096); kf[5]=*(const __attribute__((address_space(3))) bf16x8*)(kp+4608);
  kf[6]=*(const __attribute__((address_space(3))) bf16x8*)(kp+6144); kf[7]=*(const __attribute__((address_space(3))) bf16x8*)(kp+6656);
}
__device__ __forceinline__ void kload2(bf16x8*kf,lds_cptr kp,int j){ kf[2*j]=*(const __attribute__((address_space(3))) bf16x8*)(kp+j*2048); kf[2*j+1]=*(const __attribute__((address_space(3))) bf16x8*)(kp+j*2048+512); }
__device__ __forceinline__ s16x4 vtr(lds_cptr p){ return __builtin_bit_cast(s16x4,__builtin_amdgcn_ds_read_tr16_b64_v4i16((__attribute__((address_space(3))) v4i16_t*)p)); }
__device__ __forceinline__ float rowmax(const f32x16&p0,const f32x16&p1){
  float a=max3f(p0[0],p0[1],p1[0]),b=max3f(p0[2],p0[3],p1[1]);a=max3f(a,p1[2],p1[3]);
  #pragma unroll
  for(int r=4;r<16;r+=4){a=max3f(a,p0[r],p0[r+1]);b=max3f(b,p0[r+2],p0[r+3]);a=max3f(a,p1[r],p1[r+1]);b=max3f(b,p1[r+2],p1[r+3]);}
  const float m=max2f(a,b);
  auto rr=__builtin_amdgcn_permlane32_swap(__float_as_uint(m),__float_as_uint(m),false,false);
  return max2f(__uint_as_float(rr[0]),__uint_as_float(rr[1]));
}
__device__ __forceinline__ void pv(f32x16*o,int vb,bf16x8 pa0,bf16x8 pa1,bf16x8 pa2,bf16x8 pa3){
  #pragma unroll
  for(int d0=0;d0<2;++d0){s16x4 lo[4],hi[4];
    #pragma unroll
    for(int ks=0;ks<4;++ks){
      asm volatile("ds_read_b64_tr_b16 %0,%1 offset:%c2":"=&v"(lo[ks]):"v"(vb),"i"(d0*4096+ks*1024):"memory");
      asm volatile("ds_read_b64_tr_b16 %0,%1 offset:%c2":"=&v"(hi[ks]):"v"(vb),"i"(d0*4096+ks*1024+512):"memory");}
    asm volatile("s_waitcnt lgkmcnt(0)":::"memory");SBAR();
    #define PK(k) (bf16x8){lo[k][0],lo[k][1],lo[k][2],lo[k][3],hi[k][0],hi[k][1],hi[k][2],hi[k][3]}
    o[d0]=__builtin_amdgcn_mfma_f32_32x32x16_bf16(pa0,PK(0),o[d0],0,0,0);
    o[d0]=__builtin_amdgcn_mfma_f32_32x32x16_bf16(pa1,PK(1),o[d0],0,0,0);
    o[d0]=__builtin_amdgcn_mfma_f32_32x32x16_bf16(pa2,PK(2),o[d0],0,0,0);
    o[d0]=__builtin_amdgcn_mfma_f32_32x32x16_bf16(pa3,PK(3),o[d0],0,0,0);
    #undef PK
  }
}

#ifndef ATTN_STORE16
#define ATTN_STORE16(p,v) (*(u32x4*)(p)=(v))
#endif
template<int THRL> __device__ __forceinline__ void attn_unit(int b,int qb,const bf16*Q,const bf16*__restrict__ K,const bf16*__restrict__ V,bf16*O,char*shm){
  int tid_=threadIdx.x; asm volatile("":"+v"(tid_)); const int tid=tid_,lane=tid&63,r32=lane&31,hi=lane>>5; const int wid=__builtin_amdgcn_readfirstlane(tid>>6);
  const long rowbase=(long)b*SEQ; const int q0=qb*QB;
  const bf16*Qw=Q+(rowbase+q0+wid*QBLK)*DM;
  const bf16*Kh=K+rowbase*DM,*Vh=V+rowbase*DM;
  const unsigned lds0=(unsigned)(uintptr_t)shm;
  float*wsf=(float*)(shm+LDS_WS)+wid*64;
  const bf16*ksrc=Kh+(long)lane*DM+wid*8;
  const bf16*vsrc=Vh+(long)(16*(wid&3)+(lane>>2))*DM+(wid>>2)*32+(lane&3)*8;
  const unsigned kdst=lds0+LDS_K+wid*1024, vdst=lds0+LDS_V+wid*1024;
  #define DMA_K(t,slot) glds16(ksrc+(long)(t)*KVBLK*DM,(unsigned)__builtin_amdgcn_readfirstlane(kdst+(slot)))
  #define DMA_V(t,slot) glds16(vsrc+(long)(t)*KVBLK*DM,(unsigned)__builtin_amdgcn_readfirstlane(vdst+(slot)))
  const int vb0=(int)(lds0+LDS_V)+((lane>>4)&1)*32+(lane&3)*8+(4*hi+((lane&15)>>2))*64;
  const char*Kbase=shm+LDS_K; bf16x8 kf[8];
  const lds_cptr shm3=(lds_cptr)shm; const lds_cptr kp0=shm3+LDS_K+hi*1024+r32*16; const lds_cptr vp0=shm3+LDS_V+((lane>>4)&1)*32+(lane&3)*8+(4*hi+((lane&15)>>2))*64;
  const int NT=(q0+QB)/KVBLK;
  DMA_K(0,0);DMA_V(0,0);DMA_K(1,SLOTB);
  bf16x8 qr[4];
  #pragma unroll
  for(int d0=0;d0<4;++d0)qr[d0]=*reinterpret_cast<const bf16x8*>(&Qw[(long)r32*DM+d0*16+hi*8]);
  float mhat=0.f,l_reg=0.f;f32x16 o[2];o[0]=f32x16{};o[1]=f32x16{};f32x16 negm=f32x16{};asm volatile("":"+v"(negm));
  const int qrel=wid*QBLK+r32;
  #define CMASK(P0,P1,t) do{int jb_=(t)-(NT-4); if(jb_>=0)cmask(P0,P1,jb_,qrel,hi);}while(0)
  bool resc=false;
  #define START(P0,P1) do{ const float rm=rowmax(P0,P1); resc=false; \
    { const float dl=rm; mhat=fadd_s(mhat,dl); \
      _Pragma("unroll") for(int r=0;r<16;++r){P0[r]=fsub_s(P0[r],dl);P1[r]=fsub_s(P1[r],dl);} \
      _Pragma("unroll") for(int r=0;r<16;++r)negm[r]=-mhat; asm volatile("":"+v"(negm)); } \
    _Pragma("unroll") for(int r=0;r<16;++r)P0[r]=__builtin_amdgcn_exp2f(P0[r]); }while(0)
  #define RESC() do{ if(resc){ asm volatile("s_waitcnt lgkmcnt(0)":::"memory"); \
      _Pragma("unroll") for(int d_=0;d_<2;++d_) _Pragma("unroll") for(int r=0;r<16;++r)o[d_][r]*=wsf[crow(r,hi)]; } }while(0)
  f32x16 pA0,pA1,pB0,pB1;
  int sl_prev=0,sl_cur=0,sl_next=SLOTB;
  #define ROT() do{sl_prev=sl_cur;sl_cur=sl_next;sl_next=(sl_next==(NSLOT-1)*SLOTB)?0:sl_next+SLOTB;}while(0)
  DMA_K(2,2*SLOTB);
  WAIT_BAR(3);
  qkt(pA0,pA1,Kbase,qr,negm,r32,hi);asm volatile("s_nop 15\n\ts_nop 7":"+v"(pA0),"+v"(pA1));CMASK(pA0,pA1,0);
  START(pA0,pA1);
  _Pragma("unroll") for(int r=0;r<16;++r)pA1[r]=__builtin_amdgcn_exp2f(pA1[r]);
  WAIT_BAR(0);
  DMA_K(3,0);DMA_V(1,SLOTB);
  ROT();
  kload8(kf,kp0+sl_cur);
  WAIT_BAR(2);
  s16x4 vlo[8],vhi[8]; u32x4 pw0,pw1,pw2,pw3;
  #define PKW(P,B) cvtpk_s(P[B],P[B+1])
  #define PAF(k) __builtin_bit_cast(bf16x8,pw##k)
  #define VFR(i) (bf16x8){vlo[i][0],vlo[i][1],vlo[i][2],vlo[i][3],vhi[i][0],vhi[i][1],vhi[i][2],vhi[i][3]}
  #define PIN(x) asm volatile("":"+v"(x))
  #define MX3(a,b,c) __builtin_fmaxf(__builtin_fmaxf((a),(b)),(c))
  #define GAPA(MF,A0,A1,A2,A3,W0,W1,PW) do{ MF; sacc+=A0; sacc+=A1; sacc+=A2; sacc+=A3; PIN(sacc); W0; W1; PIN(PW); SBAR(); }while(0)
  #define EX(v) __builtin_amdgcn_exp2f(v)
  #define GAPB(MF,X,B) do{ MF; X[B]=EX(X[B]); X[B+1]=EX(X[B+1]); X[B+2]=EX(X[B+2]); X[B+3]=EX(X[B+3]); PIN(X); SBAR(); }while(0)
  #define VRD(i) do{ vlo[i]=vtr(vp_+(((i)>>2)*4096+((i)&3)*1024)); vhi[i]=vtr(vp_+(((i)>>2)*4096+((i)&3)*1024+512)); }while(0)
  #define KRD(G,j) do{ if(G){ kload2(kf,kp0+sl_next,j); SBAR(); } }while(0)
  #define STEP(C0,C1,P0,P1,t,GK,GV,GL) do{ SBAR(); \
    const lds_cptr vp_=vp0+sl_prev; \
    VRD(0); SBAR(); float sacc=(P0[0]+P0[1]); \
    GAPA(C0=__builtin_amdgcn_mfma_f32_32x32x16_bf16(kf[0],qr[0],negm,0,0,0), P0[2],P0[3],P0[4],P0[5],     pw0[0]=PKW(P0,0), pw0[1]=PKW(P0,2), pw0); \
    VRD(4); SBAR(); GAPA(C1=__builtin_amdgcn_mfma_f32_32x32x16_bf16(kf[1],qr[0],negm,0,0,0), P0[6],P0[7],P0[8],P0[9],     pw0[2]=PKW(P0,4), pw0[3]=PKW(P0,6), pw0); \
    VRD(1); SBAR(); GAPA(C0=__builtin_amdgcn_mfma_f32_32x32x16_bf16(kf[2],qr[1],C0,0,0,0),   P0[10],P0[11],P0[12],P0[13], pw1[0]=PKW(P0,8), pw1[1]=PKW(P0,10), pw1); \
    VRD(5); SBAR(); GAPA(C1=__builtin_amdgcn_mfma_f32_32x32x16_bf16(kf[3],qr[1],C1,0,0,0),   P0[14],P0[15],P1[0],P1[1],   pw1[2]=PKW(P0,12),pw1[3]=PKW(P0,14), pw1); \
    VRD(2); SBAR(); GAPA(C0=__builtin_amdgcn_mfma_f32_32x32x16_bf16(kf[4],qr[2],C0,0,0,0),   P1[2],P1[3],P1[4],P1[5],     pw2[0]=PKW(P1,0), pw2[1]=PKW(P1,2), pw2); \
    VRD(6); SBAR(); GAPA(C1=__builtin_amdgcn_mfma_f32_32x32x16_bf16(kf[5],qr[2],C1,0,0,0),   P1[6],P1[7],P1[8],P1[9],     pw2[2]=PKW(P1,4), pw2[3]=PKW(P1,6), pw2); \
    VRD(3); SBAR(); GAPA(C0=__builtin_amdgcn_mfma_f32_32x32x16_bf16(kf[6],qr[3],C0,0,0,0),   P1[10],P1[11],P1[12],P1[13], pw3[0]=PKW(P1,8), pw3[1]=PKW(P1,10), pw3); \
    VRD(7); SBAR(); GAPA(C1=__builtin_amdgcn_mfma_f32_32x32x16_bf16(kf[7],qr[3],C1,0,0,0),   P1[14],P1[15],0.f,0.f,       pw3[2]=PKW(P1,12),pw3[3]=PKW(P1,14), pw3); \
    l_reg+=sacc; \
    if(GK){DMA_K((t)+3,sl_cur);} if(GV){DMA_V((t)+1,sl_next);} \
    CMASK(C0,C1,t); \
    { float a=MX3(C0[0],C0[1],C1[0]),b=MX3(C0[2],C0[3],C1[1]); a=MX3(a,C1[2],C1[3]); \
      _Pragma("unroll") for(int r=4;r<16;r+=4){a=MX3(a,C0[r],C0[r+1]);b=MX3(b,C0[r+2],C0[r+3]);a=MX3(a,C1[r],C1[r+1]);b=MX3(b,C1[r+2],C1[r+3]);} \
      float rm=__builtin_fmaxf(a,b); { auto rr=__builtin_amdgcn_permlane32_swap(__float_as_uint(rm),__float_as_uint(rm),false,false); rm=__builtin_fmaxf(__uint_as_float(rr[0]),__uint_as_float(rr[1])); } \
      resc=false; \
      if(__builtin_expect(__any(rm>(float)THRL),0)){ const float dl=__builtin_fmaxf(rm,0.f); mhat+=dl; \
        _Pragma("unroll") for(int r=0;r<16;++r){C0[r]-=dl;C1[r]-=dl;} \
        _Pragma("unroll") for(int r=0;r<16;++r)negm[r]=-mhat; asm volatile("":"+v"(negm)); \
        const float f=__builtin_amdgcn_exp2f(-dl); l_reg*=f; if(hi==0)wsf[r32]=f; resc=true; } } \
    SBAR(); \
    GAPB(o[0]=__builtin_amdgcn_mfma_f32_32x32x16_bf16(PAF(0),VFR(0),o[0],0,0,0), C0,0); \
    GAPB(o[1]=__builtin_amdgcn_mfma_f32_32x32x16_bf16(PAF(0),VFR(4),o[1],0,0,0), C0,4); \
    KRD(GL,0); GAPB(o[0]=__builtin_amdgcn_mfma_f32_32x32x16_bf16(PAF(1),VFR(1),o[0],0,0,0), C0,8); \
    KRD(GL,1); GAPB(o[1]=__builtin_amdgcn_mfma_f32_32x32x16_bf16(PAF(1),VFR(5),o[1],0,0,0), C0,12); \
    KRD(GL,2); GAPB(o[0]=__builtin_amdgcn_mfma_f32_32x32x16_bf16(PAF(2),VFR(2),o[0],0,0,0), C1,0); \
    KRD(GL,3); GAPB(o[1]=__builtin_amdgcn_mfma_f32_32x32x16_bf16(PAF(2),VFR(6),o[1],0,0,0), C1,4); \
    GAPB(o[0]=__builtin_amdgcn_mfma_f32_32x32x16_bf16(PAF(3),VFR(3),o[0],0,0,0), C1,8); \
    GAPB(o[1]=__builtin_amdgcn_mfma_f32_32x32x16_bf16(PAF(3),VFR(7),o[1],0,0,0), C1,12); \
    }while(0)
  int t=1;
  #undef CMASK
  #define CMASK(P0,P1,t) do{}while(0)
  for(;t+5<NT;t+=2){
    STEP(pB0,pB1,pA0,pA1,t,true,true,true);     WAIT_BAR(2); RESC(); ROT();
    STEP(pA0,pA1,pB0,pB1,t+1,true,true,true);   WAIT_BAR(2); RESC(); ROT();
  }
  #undef CMASK
  #define CMASK(P0,P1,t) do{int jb_=(t)-(NT-4); if(jb_>=0)cmask(P0,P1,jb_,qrel,hi);}while(0)
  #define ENDW(tt) do{ if((tt)+3<NT){WAIT_BAR(2);} else if((tt)+2<NT){WAIT_BAR(1);} else {WAIT_BAR(0);} }while(0)
  for(;t+1<NT;t+=2){
    STEP(pB0,pB1,pA0,pA1,t,(t+3<NT),(t+1<NT),(t+1<NT));       ENDW(t);   RESC(); ROT();
    STEP(pA0,pA1,pB0,pB1,t+1,(t+4<NT),(t+2<NT),(t+2<NT));     ENDW(t+1); RESC(); ROT();
  }
  STEP(pB0,pB1,pA0,pA1,NT-1,false,false,false); RESC();
  { float sacc=pB0[0]+pB0[1]; _Pragma("unroll") for(int r=2;r<16;++r)sacc+=pB0[r]; _Pragma("unroll") for(int r=0;r<16;++r)sacc+=pB1[r]; l_reg+=sacc;
    pw0=(u32x4){PKW(pB0,0),PKW(pB0,2),PKW(pB0,4),PKW(pB0,6)};pw1=(u32x4){PKW(pB0,8),PKW(pB0,10),PKW(pB0,12),PKW(pB0,14)};pw2=(u32x4){PKW(pB1,0),PKW(pB1,2),PKW(pB1,4),PKW(pB1,6)};pw3=(u32x4){PKW(pB1,8),PKW(pB1,10),PKW(pB1,12),PKW(pB1,14)};
    SBAR(); pv(o,vb0+sl_cur,PAF(0),PAF(1),PAF(2),PAF(3)); }
  #undef PKW
  #undef PAF
  #undef VFR
  #undef PIN
  #undef MX3
  #undef GAPA
  #undef GAPB
  #undef EX
  #undef VRD
  #undef KRD
  #undef STEP
  #undef ENDW
  {auto rr=__builtin_amdgcn_permlane32_swap(__float_as_uint(l_reg),__float_as_uint(l_reg),false,false);l_reg=__uint_as_float(rr[0])+__uint_as_float(rr[1]);}
  if(hi==0)wsf[32+r32]=l_reg;asm volatile("s_waitcnt lgkmcnt(0)":::"memory");
  float rli[16];
  #pragma unroll
  for(int r=0;r<16;++r)rli[r]=__builtin_amdgcn_rcpf(wsf[32+crow(r,hi)]);
  bf16*Ow=O+(rowbase+q0+wid*QBLK)*DM;
  { bf16*stg=(bf16*)(shm+LDS_OST)+wid*2048;
    #pragma unroll
    for(int r=0;r<16;++r){const int orow=crow(r,hi);
      #pragma unroll
      for(int d0=0;d0<2;++d0)stg[orow*64+d0*32+r32]=__float2bfloat16(o[d0][r]*rli[r]);}
    asm volatile("s_waitcnt lgkmcnt(0)":::"memory");
    #pragma unroll
    for(int i=0;i<4;++i){const int row=i*8+(lane>>3),ch=lane&7; const u32x4 v=*(const u32x4*)(stg+row*64+ch*8); ATTN_STORE16(Ow+(long)row*DM+ch*8,v);} }
  asm volatile("s_waitcnt lgkmcnt(0)\n\ts_barrier":::"memory");
  #undef DMA_K
  #undef DMA_V
  #undef CMASK
  #undef START
  #undef RESC
  #undef ROT
}
constexpr int ATTN_LDS_BYTES=LDS_BYTES;
#undef SBAR
#undef WAIT_BAR
}


constexpr int NWAVES = 8;
constexpr int NB = 16, S = 2048, D = 1024, T = NB * S;
constexpr int NL = 4, NE = 32, TOPK = 4;
constexpr int SLOT_ROWS = T * TOPK + NE * 256;
constexpr int MODC = 6 * D * NL + 2 * D + 2 * D;
constexpr int MOD_KV = 6 * D * NL, MOD_FIN = MOD_KV + 2 * D;
constexpr float EPS = 1e-5f;
constexpr float QSCALE = 0.125f * 1.4426950408889634f;
constexpr size_t MiB = 1u << 20;
constexpr size_t WS_CTL = 0, CTL_ZERO_BYTES = 1 * MiB;
constexpr size_t WS_MOD = 4 * MiB;
constexpr size_t WS_ROPE = 6 * MiB;
constexpr size_t WS_RFRAG = 7 * MiB;
constexpr size_t WS_TKE = 8 * MiB, WS_TKW = WS_TKE + 512 * 1024, WS_TKL = WS_TKW + 512 * 1024, WS_SLOT = WS_TKL + 512 * 1024;
constexpr size_t WS_WGCNT = 10 * MiB, WS_TEXP = WS_WGCNT + 64 * 1024, WS_NT = WS_TEXP + 64 * 1024;
constexpr size_t WS_ROWTOK = 11 * MiB;
constexpr size_t WS_WQKV = 16 * MiB, WS_AWO = 28 * MiB, WS_KVW = 32 * MiB, WS_BWQ = 36 * MiB, WS_BWO = 48 * MiB;
constexpr size_t WS_WGU = 64 * MiB, WS_WDN = 576 * MiB;
constexpr size_t WS_X = 832 * MiB, WS_H = 960 * MiB, WS_Q = 1024 * MiB, WS_KVSH = 1216 * MiB, WS_O = 1344 * MiB, WS_OP = 1408 * MiB, WS_LSE = 1600 * MiB, WS_HKV = 1608 * MiB;
constexpr size_t WS_HS = 1672 * MiB, WS_ACT = 1944 * MiB, WS_Y = 2216 * MiB, WS_END = 2488 * MiB;
constexpr int CW_BAR = 4096;
constexpr int RING_BYTES = 131072;
constexpr int MISC_OFF = RING_BYTES;
constexpr int HIST_OFF = MISC_OFF + 256, TEXP_OFF = MISC_OFF + 1024;
constexpr int LDS_BYTES = 147456;

#define GAS __attribute__((address_space(1)))
#define LAS __attribute__((address_space(3)))
typedef unsigned short bf16;
typedef unsigned v4u __attribute__((ext_vector_type(4)));
typedef unsigned v2u __attribute__((ext_vector_type(2)));
typedef float f32x4 __attribute__((ext_vector_type(4)));
typedef float f32x16 __attribute__((ext_vector_type(16)));
typedef short bf16x8 __attribute__((ext_vector_type(8)));
typedef short s16x4 __attribute__((ext_vector_type(4)));
#define RLX_AGENT __ATOMIC_RELAXED, __HIP_MEMORY_SCOPE_AGENT
#define LDS_WAIT() asm volatile("s_waitcnt lgkmcnt(0)" ::: "memory")
#define VM_WAIT() asm volatile("s_waitcnt vmcnt(0)" ::: "memory")
__device__ __forceinline__ unsigned f2bf(float f) { unsigned u = __builtin_bit_cast(unsigned, f); return (u + 0x7fffu + ((u >> 16) & 1u)) >> 16; }
__device__ __forceinline__ float bf2f(unsigned b) { return __builtin_bit_cast(float, b << 16); }
__device__ __forceinline__ unsigned pk2(float lo, float hi) { return f2bf(lo) | (f2bf(hi) << 16); }
__device__ __forceinline__ f32x4 unpack4(v2u r) { return (f32x4){bf2f(r.x & 0xffffu), bf2f(r.x >> 16), bf2f(r.y & 0xffffu), bf2f(r.y >> 16)}; }
__device__ __forceinline__ float wave_sum(float v) {
#pragma unroll
    for (int o = 1; o < 64; o <<= 1) v += __shfl_xor(v, o);
    return v;
}
__device__ __forceinline__ float dot4(f32x4 a) { return (a.x * a.x + a.y * a.y) + (a.z * a.z + a.w * a.w); }
#define XB_TMO      128
#define XB_XCNT(j)  (256  + 64 * (j))
#define XB_XSUB(j)  (1280 + 64 * (j))
#define XB_XGEN(j)  (2304 + 64 * (j))
#define XB_TOP      3328
#define XB_TOPGEN   3392
#define XCD_BAR_WORDS 3456
#define XB_SPIN_CAP (1u << 22)

__device__ __forceinline__ unsigned xb_ld(unsigned* p)              { return __hip_atomic_load(p, __ATOMIC_RELAXED, __HIP_MEMORY_SCOPE_AGENT); }
__device__ __forceinline__ unsigned xb_add(unsigned* p, unsigned v) { return __hip_atomic_fetch_add(p, v, __ATOMIC_RELAXED, __HIP_MEMORY_SCOPE_AGENT); }
__device__ __forceinline__ unsigned xb_xcc_id() { return (unsigned)__builtin_amdgcn_s_getreg((3 << 11) | 20) & 0xFu; }
#define XB_SPIN(cond, bar) do { unsigned _sp = 0; while (cond) { __builtin_amdgcn_s_sleep(1); \
    if ((++_sp & 255u) == 0u) { if (xb_ld(&(bar)[XB_TMO])) break; if (_sp > XB_SPIN_CAP) { atomicAdd(&(bar)[XB_TMO], 1u); break; } } } } while (0)

struct XcdBarrier {
    unsigned* bar; unsigned x;
    volatile LAS unsigned* st;
};

__device__ __forceinline__ XcdBarrier xcd_barrier_post(unsigned* bar, volatile LAS unsigned* st) {
    XcdBarrier b; b.bar = bar; b.x = xb_xcc_id(); b.st = st;
    if (threadIdx.x == 0) (void)xb_add(&bar[XB_XCNT(b.x)], 1u);
    return b;
}
__device__ __forceinline__ void xcd_barrier_complete(unsigned* bar, unsigned x, unsigned& nloc, unsigned& nx) {
    const unsigned G = gridDim.x * gridDim.y * gridDim.z;
    unsigned sum, cnt, mine, sp = 0u;
    for (;;) {
        sum = 0u; cnt = 0u; mine = 0u;
#pragma unroll
        for (unsigned j = 0; j < 16; ++j) { const unsigned c = xb_ld(&bar[XB_XCNT(j)]); sum += c; cnt += (c > 0u) ? 1u : 0u; mine = (j == x) ? c : mine; }
        if (sum == G) break;
        __builtin_amdgcn_s_sleep(1);
        if ((++sp & 255u) == 0u) { if (xb_ld(&bar[XB_TMO])) break; if (sp > XB_SPIN_CAP) { atomicAdd(&bar[XB_TMO], 1u); break; } }
    }
    nloc = mine > 0u ? mine : 1u; nx = cnt > 0u ? cnt : 1u;
}

__device__ __forceinline__ void xcd_barrier(const XcdBarrier& b) {
    asm volatile("s_waitcnt vmcnt(0)" ::: "memory");
    __syncthreads();
    if (threadIdx.x == 0) {
        unsigned* bar = b.bar;
        __builtin_amdgcn_s_waitcnt(0);
        unsigned nloc = b.st[0], nx = b.st[1];
        if (nloc == 0u) { xcd_barrier_complete(bar, b.x, nloc, nx); b.st[0] = nloc; b.st[1] = nx; }
        const unsigned old = xb_add(&bar[XB_XSUB(b.x)], 1u);
        const unsigned gen = old / nloc;
        if (old + 1u == (gen + 1u) * nloc) {
            __builtin_amdgcn_fence(__ATOMIC_RELEASE, "agent");
            asm volatile("s_waitcnt vmcnt(0)" ::: "memory");
            const unsigned og = xb_add(&bar[XB_TOP], 1u);
            const unsigned tg = og / nx;
            if (og + 1u == (tg + 1u) * nx) xb_add(&bar[XB_TOPGEN], 1u);
            else XB_SPIN(xb_ld(&bar[XB_TOPGEN]) == tg, bar);
            __builtin_amdgcn_fence(__ATOMIC_ACQUIRE, "agent");
            xb_add(&bar[XB_XGEN(b.x)], 1u);
            asm volatile("s_waitcnt vmcnt(0)" ::: "memory");
        } else {
            XB_SPIN(xb_ld(&bar[XB_XGEN(b.x)]) == gen, bar);
            __builtin_amdgcn_fence(__ATOMIC_ACQUIRE, "agent");
            asm volatile("s_waitcnt vmcnt(0)" ::: "memory");
        }
    }
    __syncthreads();
}

struct Args { const float* in[25]; float* out; unsigned char* ws; float invf[8]; float lam_init[2]; int ph_lo, ph_hi, use_bar, pad; };
enum { I_X = 0, I_C, I_MODW, I_MODB, I_MIXN, I_FFNN, I_AWQKV, I_AWO, I_ALAM, I_ASUBLN, I_KVN, I_KVMODW, I_KVMODB, I_KVW, I_BWQ, I_BWO, I_RW, I_RB, I_WGU, I_BGU, I_WDN, I_BDN, I_FINN, I_FINMODW, I_FINMODB };
struct Frame { LAS unsigned char* lds; int tid, lane, wave, G, gw, NGW, bid; };
typedef const __attribute__((address_space(4))) Args* ArgsP;

__device__ __forceinline__ void p0_transpose_item(const float* W, int N, int K, bf16* WT, int dst_row0, LAS float* scr, int k0, int n0, int lane) {
#pragma unroll 8
    for (int i = 0; i < 32; ++i) { const int kk = 2 * i + (lane >> 5); scr[kk * 33 + (lane & 31)] = W[(size_t)(k0 + kk) * N + n0 + (lane & 31)]; }
    LDS_WAIT(); asm volatile("" ::: "memory");
    const int c = lane & 7;
#pragma unroll
    for (int j = 0; j < 4; ++j) { const int n = (lane >> 3) + 8 * j; const LAS float* s = scr + (8 * c) * 33 + n;
        v4u o; o.x = pk2(s[0 * 33], s[1 * 33]); o.y = pk2(s[2 * 33], s[3 * 33]); o.z = pk2(s[4 * 33], s[5 * 33]); o.w = pk2(s[6 * 33], s[7 * 33]);
        *(GAS v4u*)(WT + (size_t)(dst_row0 + n) * K + k0 + 8 * c) = o; }
    LDS_WAIT(); asm volatile("" ::: "memory");
}
__device__ __forceinline__ void p0_prologue(const Frame& F, ArgsP ap) {
    unsigned char* ws = ap->ws;
    {
        LAS float* cT = (LAS float*)F.lds;
        LAS float* red = (LAS float*)(F.lds + 65536);
        const float* c = ap->in[I_C];
        for (int idx = F.tid; idx < NB * D; idx += NWAVES * 64) { const int b = idx >> 10, k = idx & 1023; const float v = c[idx]; cT[k * 16 + b] = v / (1.0f + __expf(-v)); }
        __syncthreads();
        float* modall = (float*)(ws + WS_MOD);
        for (int g = F.bid; g < MODC / 64; g += F.G) {
            const int cg0 = g * 64; const float* W; const float* bias; int N, col0;
            if (cg0 < MOD_KV) { const int l = cg0 / (6 * D); col0 = cg0 % (6 * D); W = ap->in[I_MODW] + (size_t)l * D * 6 * D; N = 6 * D; bias = ap->in[I_MODB] + l * 6 * D + col0; }
            else if (cg0 < MOD_FIN) { col0 = cg0 - MOD_KV; W = ap->in[I_KVMODW]; N = 2 * D; bias = ap->in[I_KVMODB] + col0; }
            else { col0 = cg0 - MOD_FIN; W = ap->in[I_FINMODW]; N = 2 * D; bias = ap->in[I_FINMODB] + col0; }
            float acc[16];
#pragma unroll
            for (int b = 0; b < 16; ++b) acc[b] = 0.f;
            const float* wp = W + (size_t)(F.wave * 128) * N + col0 + F.lane;
#pragma unroll 8
            for (int kk = 0; kk < 128; ++kk) { const float w = wp[(size_t)kk * N]; const LAS f32x4* cv = (const LAS f32x4*)(cT + (F.wave * 128 + kk) * 16);
                const f32x4 c0 = cv[0], c1 = cv[1], c2 = cv[2], c3 = cv[3];
                acc[0] += w * c0.x; acc[1] += w * c0.y; acc[2] += w * c0.z; acc[3] += w * c0.w; acc[4] += w * c1.x; acc[5] += w * c1.y; acc[6] += w * c1.z; acc[7] += w * c1.w;
                acc[8] += w * c2.x; acc[9] += w * c2.y; acc[10] += w * c2.z; acc[11] += w * c2.w; acc[12] += w * c3.x; acc[13] += w * c3.y; acc[14] += w * c3.z; acc[15] += w * c3.w; }
#pragma unroll
            for (int b = 0; b < 16; ++b) red[(F.wave * 16 + b) * 64 + F.lane] = acc[b];
            __syncthreads();
            for (int o = F.tid; o < 1024; o += NWAVES * 64) { const int b = o >> 6, ln = o & 63; float s = bias[ln];
#pragma unroll
                for (int w = 0; w < 8; ++w) s += red[(w * 16 + b) * 64 + ln];
                modall[(size_t)b * MODC + cg0 + ln] = s; }
            __syncthreads();
        }
        __syncthreads();
    }
    {
        const int gt = F.bid * (NWAVES * 64) + F.tid, NT_ = F.G * NWAVES * 64;
        float* cosT = (float*)(ws + WS_ROPE); float* sinT = cosT + S * 8;
        for (int idx = gt; idx < S * 8; idx += NT_) { const int pos = idx >> 3, i = idx & 7; float inv = ap->invf[0];
#pragma unroll
            for (int q = 1; q < 8; ++q) inv = (i == q) ? ap->invf[q] : inv;
            const float angf = (float)pos * inv; const double x = (double)angf; const double n = __builtin_rint(x * 0.15915494309189533577); const double r = x - n * 6.283185307179586476925; const double r2 = r * r;
            double sn = 1.0, cs = 1.0;
#pragma unroll
            for (int q = 14; q >= 1; --q) { sn = 1.0 - sn * r2 / (double)((2 * q) * (2 * q + 1)); cs = 1.0 - cs * r2 / (double)((2 * q - 1) * (2 * q)); }
            sn *= r; cosT[idx] = (float)cs; sinT[idx] = (float)sn; }
        bf16* rfrag = (bf16*)(ws + WS_RFRAG); const float* rw = ap->in[I_RW];
        for (int idx = gt; idx < NL * 32 * 2 * 64 * 8; idx += NT_) { const int j = idx & 7, lane = (idx >> 3) & 63, nb = (idx >> 9) & 1, s = (idx >> 10) & 31, l = idx >> 15;
            const float w = rw[((size_t)l * D + 32 * s + 8 * (lane >> 4) + j) * NE + 16 * nb + (lane & 15)]; const unsigned hi = f2bf(w), lo = f2bf(w - bf2f(hi));
            const size_t base = ((((size_t)l * 32 + s) * 2 + nb) * 2) * 512 + lane * 8 + j; rfrag[base] = (bf16)hi; rfrag[base + 512] = (bf16)lo; }
    }
    {
        LAS float* scr = (LAS float*)(F.lds + F.wave * 16384);
        constexpr int I_QKV = 16 * 96, I_SQ = 16 * 32, I_KV = 16 * 64, I_GU = 16 * 64, I_DN = 16 * 32;
        constexpr int E0 = 2 * I_QKV, E1 = E0 + 2 * I_SQ, E2 = E1 + I_KV, E3 = E2 + 2 * I_QKV, E4 = E3 + 2 * I_SQ, E5 = E4 + NL * NE * I_GU, E6 = E5 + NL * NE * I_DN;
        for (int it = F.gw; it < E6; it += F.NGW) {
            const float* W; bf16* WT; int N, r, per; bool gu = false;
            if (it < E0) { r = it; per = I_QKV; N = 3 * D; W = ap->in[I_AWQKV]; WT = (bf16*)(ws + WS_WQKV); }
            else if (it < E1) { r = it - E0; per = I_SQ; N = D; W = ap->in[I_AWO]; WT = (bf16*)(ws + WS_AWO); }
            else if (it < E2) { r = it - E1; per = I_KV; N = 2 * D; W = ap->in[I_KVW]; WT = (bf16*)(ws + WS_KVW); }
            else if (it < E3) { r = it - E2; per = I_QKV; N = 3 * D; W = ap->in[I_BWQ]; WT = (bf16*)(ws + WS_BWQ); }
            else if (it < E4) { r = it - E3; per = I_SQ; N = D; W = ap->in[I_BWO]; WT = (bf16*)(ws + WS_BWO); }
            else if (it < E5) { r = it - E4; per = I_GU; N = 2 * D; W = ap->in[I_WGU]; WT = (bf16*)(ws + WS_WGU); gu = true; }
            else { r = it - E5; per = I_DN; N = D; W = ap->in[I_WDN]; WT = (bf16*)(ws + WS_WDN); }
            const int mat = r / per, item = r % per, nblk = N / 32, kb = item / nblk, nb = item % nblk, n0 = 32 * nb;
            int drow = n0; if (gu) { const int half = n0 >> 10, rem = n0 & 1023; drow = (rem >> 7) * 256 + half * 128 + (rem & 127); }
            p0_transpose_item(W + (size_t)mat * D * N, N, D, WT + (size_t)mat * N * D, drow, scr, 64 * kb, n0, F.lane);
        }
    }
}

struct ModVec { f32x4 a[4], b[4]; };
__device__ __forceinline__ void load_modvec(ModVec& mv, const float* gain, const float* scale, const float* shift, int lane) {
#pragma unroll
    for (int j = 0; j < 4; ++j) { const int c = 4 * lane + 256 * j; const f32x4 g = *(const f32x4*)(gain + c), sc = *(const f32x4*)(scale + c); mv.a[j] = g * (sc + 1.0f); mv.b[j] = *(const f32x4*)(shift + c); }
}
__device__ __forceinline__ void store_bf16_row(bf16* orow, const f32x4 (&v)[4], int lane) {
#pragma unroll
    for (int j = 0; j < 4; ++j) { v2u w; w.x = pk2(v[j].x, v[j].y); w.y = pk2(v[j].z, v[j].w); *(v2u*)(orow + 4 * lane + 256 * j) = w; }
}
__device__ __forceinline__ void phase_modulate0(const Frame& F, const float* x, const float* gain, const float* modall, int sh_col, int sc_col, bf16* h) {
    for (int task = F.gw; task < T / 16; task += F.NGW) {
        const int r0 = task * 16, b = r0 >> 11; ModVec mv; load_modvec(mv, gain, modall + (size_t)b * MODC + sc_col, modall + (size_t)b * MODC + sh_col, F.lane);
        for (int i = 0; i < 16; ++i) { const float* xr = x + (size_t)(r0 + i) * D; f32x4 v[4]; float ss = 0.f;
#pragma unroll
            for (int j = 0; j < 4; ++j) { v[j] = *(const f32x4*)(xr + 4 * F.lane + 256 * j); ss += dot4(v[j]); }
            const float rstd = 1.0f / sqrtf(wave_sum(ss) * (1.0f / D) + EPS);
#pragma unroll
            for (int j = 0; j < 4; ++j) v[j] = v[j] * rstd * mv.a[j] + mv.b[j];
            store_bf16_row(h + (size_t)(r0 + i) * D, v, F.lane); }
    }
}
__device__ __forceinline__ void phase_subln(const Frame& F, const bf16* OP, const float* lamv  , const float* subln  , float lam_init, bf16* O) {
    float lam; { const float p1 = wave_sum(lamv[F.lane] * lamv[64 + F.lane]), p2 = wave_sum(lamv[128 + F.lane] * lamv[192 + F.lane]); lam = __expf(p1) - __expf(p2) + lam_init; }
    const f32x4 gsub = *(const f32x4*)(subln + ((4 * F.lane) & 127)) * (1.0f - lam_init);
    for (int task = F.gw; task < T / 16; task += F.NGW) {
        for (int i = 0; i < 16; ++i) { const size_t ro = (size_t)(task * 16 + i) * D; f32x4 v[4];
#pragma unroll
            for (int j = 0; j < 4; ++j) { const int c = 4 * F.lane + 256 * j; const f32x4 o0 = unpack4(*(const v2u*)(OP + ro + c)), o1 = unpack4(*(const v2u*)(OP + (size_t)T * D + ro + c));
                v[j] = o0 - o1 * lam; float ss = dot4(v[j]);
#pragma unroll
                for (int o = 1; o < 32; o <<= 1) ss += __shfl_xor(ss, o);
                v[j] = v[j] * (1.0f / sqrtf(ss * (1.0f / 128.0f) + EPS)) * gsub; }
            store_bf16_row(O + ro, v, F.lane); }
    }
}
__device__ __forceinline__ void phase_merge(const Frame& F, const bf16* OG, const float* LSE, bf16* O) {
    for (int task = F.gw; task < T / 16; task += F.NGW) {
        for (int i = 0; i < 16; ++i) { const int row = task * 16 + i; const size_t ro = (size_t)row * D; f32x4 v[4];
#pragma unroll
            for (int j = 0; j < 4; ++j) { const int c = 4 * F.lane + 256 * j, head = c >> 6;
                const float l0 = LSE[(size_t)row * 16 + head], l1 = LSE[(size_t)T * 16 + (size_t)row * 16 + head], l2 = LSE[(size_t)2 * T * 16 + (size_t)row * 16 + head];
                const float mx = fmaxf(l0, fmaxf(l1, l2)); const float a0 = __builtin_amdgcn_exp2f(l0 - mx), a1 = __builtin_amdgcn_exp2f(l1 - mx), a2 = __builtin_amdgcn_exp2f(l2 - mx); const float inv = 1.0f / (a0 + a1 + a2);
                const f32x4 o0 = unpack4(*(const v2u*)(OG + ro + c)), o1 = unpack4(*(const v2u*)(OG + (size_t)T * D + ro + c)), o2 = unpack4(*(const v2u*)(OG + (size_t)2 * T * D + ro + c));
                v[j] = (o0 * a0 + o1 * a1 + o2 * a2) * inv; }
            store_bf16_row(O + ro, v, F.lane); }
    }
}
__device__ __forceinline__ void phase_mod2_router(const Frame& F, const float* x, const float* gain, const float* modall, int sh_col, int sc_col, const bf16* rfrag, const float* rb,
                                                  bf16* h2, int* tk_e, float* tk_w, int* tk_l, int* wgcnt) {
    LAS int* hist = (LAS int*)(F.lds + HIST_OFF);
    if (F.tid < NE) hist[F.tid] = 0;
    __syncthreads();
    const int r = F.lane & 15, kq = F.lane >> 4;
    for (int task = F.gw; task < T / 16; task += F.NGW) {
        const int r0 = task * 16, b = r0 >> 11; const float* xr = x + (size_t)(r0 + r) * D + 8 * kq;
        float ss = 0.f;
#pragma unroll 8
        for (int s = 0; s < 32; ++s) ss += dot4(*(const f32x4*)(xr + 32 * s)) + dot4(*(const f32x4*)(xr + 32 * s + 4));
        ss += __shfl_xor(ss, 16); ss += __shfl_xor(ss, 32);
        const float rstd = 1.0f / sqrtf(ss * (1.0f / D) + EPS);
        const float* gp = gain + 8 * kq; const float* scp = modall + (size_t)b * MODC + sc_col + 8 * kq; const float* shp = modall + (size_t)b * MODC + sh_col + 8 * kq;
        bf16* hr = h2 + (size_t)(r0 + r) * D + 8 * kq;
        f32x4 acc0 = (f32x4){0.f, 0.f, 0.f, 0.f}, acc1 = acc0;
#pragma unroll 4
        for (int s = 0; s < 32; ++s) {
            const f32x4 xa = *(const f32x4*)(xr + 32 * s), xb = *(const f32x4*)(xr + 32 * s + 4);
            const f32x4 ga = *(const f32x4*)(gp + 32 * s), gb = *(const f32x4*)(gp + 32 * s + 4), sa = *(const f32x4*)(scp + 32 * s), sb = *(const f32x4*)(scp + 32 * s + 4), ha = *(const f32x4*)(shp + 32 * s), hb = *(const f32x4*)(shp + 32 * s + 4);
            const f32x4 va = xa * rstd * ga * (sa + 1.0f) + ha, vb = xb * rstd * gb * (sb + 1.0f) + hb;
            bf16x8 Ahi, Alo;
#pragma unroll
            for (int j = 0; j < 4; ++j) { const unsigned h0 = f2bf(va[j]), h1 = f2bf(vb[j]); Ahi[j] = (short)h0; Ahi[4 + j] = (short)h1; Alo[j] = (short)f2bf(va[j] - bf2f(h0)); Alo[4 + j] = (short)f2bf(vb[j] - bf2f(h1)); }
            *(bf16x8*)(hr + 32 * s) = Ahi;
            const bf16* fp = rfrag + (size_t)s * 2048 + F.lane * 8;
            const bf16x8 Bh0 = *(const bf16x8*)(fp), Bl0 = *(const bf16x8*)(fp + 512), Bh1 = *(const bf16x8*)(fp + 1024), Bl1 = *(const bf16x8*)(fp + 1536);
            acc0 = __builtin_amdgcn_mfma_f32_16x16x32_bf16(Ahi, Bh0, acc0, 0, 0, 0); acc0 = __builtin_amdgcn_mfma_f32_16x16x32_bf16(Alo, Bh0, acc0, 0, 0, 0); acc0 = __builtin_amdgcn_mfma_f32_16x16x32_bf16(Ahi, Bl0, acc0, 0, 0, 0);
            acc1 = __builtin_amdgcn_mfma_f32_16x16x32_bf16(Ahi, Bh1, acc1, 0, 0, 0); acc1 = __builtin_amdgcn_mfma_f32_16x16x32_bf16(Alo, Bh1, acc1, 0, 0, 0); acc1 = __builtin_amdgcn_mfma_f32_16x16x32_bf16(Ahi, Bl1, acc1, 0, 0, 0);
        }
        const float b0 = rb[r], b1 = rb[16 + r];
#pragma unroll
        for (int reg = 0; reg < 4; ++reg) {
            float v0 = acc0[reg] + b0, v1 = acc1[reg] + b1; float tv[4]; int te[4];
#pragma unroll
            for (int k = 0; k < 4; ++k) {
                float bv = (v0 >= v1) ? v0 : v1; int be = (v0 >= v1) ? r : 16 + r;
#pragma unroll
                for (int o = 1; o < 16; o <<= 1) { const float ov = __shfl_xor(bv, o); const int oe = __shfl_xor(be, o); if (ov > bv || (ov == bv && oe < be)) { bv = ov; be = oe; } }
                tv[k] = bv; te[k] = be; if (be == r) v0 = -INFINITY; if (be == 16 + r) v1 = -INFINITY;
            }
            const float p1 = __expf(tv[1] - tv[0]), p2 = __expf(tv[2] - tv[0]), p3 = __expf(tv[3] - tv[0]); const float inv = 1.0f / (1.0f + p1 + p2 + p3);
            if (r == 0) { const int row = r0 + 4 * kq + reg; const float pw[4] = {inv, p1 * inv, p2 * inv, p3 * inv};
#pragma unroll
                for (int k = 0; k < 4; ++k) { tk_e[row * 4 + k] = te[k]; tk_w[row * 4 + k] = pw[k]; tk_l[row * 4 + k] = __hip_atomic_fetch_add(hist + te[k], 1, __ATOMIC_RELAXED, __HIP_MEMORY_SCOPE_WORKGROUP); } }
        }
    }
    __syncthreads();
    if (F.tid < NE) wgcnt[F.bid * NE + F.tid] = hist[F.tid];
}
__device__ __forceinline__ void phase_scatter(const Frame& F, const int* wgcnt, const int* tk_e, const int* tk_l, int* slot_of, int* rowtok, int* texp, unsigned* ntiles, const bf16* h2, bf16* Hs) {
    LAS int* cnt = (LAS int*)F.lds; LAS int* tot = (LAS int*)(F.lds + 65536); LAS int* bas = tot + 32; LAS int* eoff = tot + 64;
    for (int i = F.tid; i < F.G * NE; i += NWAVES * 64) cnt[i] = wgcnt[i];
    __syncthreads();
    if (F.tid < NE) { int t = 0, bs = 0; for (int w = 0; w < F.G; ++w) { const int c = cnt[w * NE + F.tid]; bs += (w < F.bid) ? c : 0; t += c; } tot[F.tid] = t; bas[F.tid] = bs; }
    __syncthreads();
    if (F.tid == 0) { int off = 0; for (int e = 0; e < NE; ++e) { eoff[e] = off; off += (tot[e] + 255) & ~255; } eoff[NE] = off; }
    __syncthreads();
    if (F.bid == 0) { if (F.tid < NE) { for (int pm = eoff[F.tid] >> 8; pm < (eoff[F.tid + 1] >> 8); ++pm) texp[pm] = F.tid; } if (F.tid == 0) __hip_atomic_store(ntiles, (unsigned)(eoff[NE] >> 8), RLX_AGENT); }
    for (int task = F.gw; task < T / 16; task += F.NGW) {
        const int r0 = task * 16, row = r0 + (F.lane >> 2); const int idx = row * 4 + (F.lane & 3);
        const int e = tk_e[idx], slot = eoff[e] + bas[e] + tk_l[idx]; slot_of[idx] = slot; rowtok[slot] = row;
        for (int i = 0; i < 64; ++i) { const int sl = __shfl(slot, i); const bf16* src = h2 + (size_t)(r0 + (i >> 2)) * D + F.lane * 8; bf16* dst = Hs + (size_t)sl * D + F.lane * 8;
            const v4u p0 = *(const v4u*)src, p1 = *(const v4u*)(src + 512); *(v4u*)dst = p0; *(v4u*)(dst + 512) = p1; }
    }
}
__device__ __forceinline__ void phase_combine(const Frame& F, float* x, const bf16* Y, const int* slot_of, const float* tk_w, const float* g2base  , int mode,
                                              const float* gainA, const float* modall, int shA, int scA, bf16* h, const float* gainB, int shB, int scB, bf16* hkv, float* out) {
    for (int task = F.gw; task < T / 16; task += F.NGW) {
        const int r0 = task * 16, b = r0 >> 11; ModVec mv, mk; f32x4 g2[4];
        load_modvec(mv, gainA, modall + (size_t)b * MODC + scA, modall + (size_t)b * MODC + shA, F.lane);
        if (mode == 1) load_modvec(mk, gainB, modall + (size_t)b * MODC + scB, modall + (size_t)b * MODC + shB, F.lane);
#pragma unroll
        for (int j = 0; j < 4; ++j) g2[j] = *(const f32x4*)(g2base + (size_t)b * MODC + 4 * F.lane + 256 * j);
        const int myslot = slot_of[r0 * 4 + F.lane]; const float myw = tk_w[r0 * 4 + F.lane];
        for (int i = 0; i < 16; ++i) { const size_t ro = (size_t)(r0 + i) * D; f32x4 acc[4];
#pragma unroll
            for (int j = 0; j < 4; ++j) acc[j] = (f32x4){0.f, 0.f, 0.f, 0.f};
#pragma unroll
            for (int k = 0; k < 4; ++k) { const int sl = __shfl(myslot, i * 4 + k); const float w = __shfl(myw, i * 4 + k); const bf16* yr = Y + (size_t)sl * D;
#pragma unroll
                for (int j = 0; j < 4; ++j) acc[j] += unpack4(*(const v2u*)(yr + 4 * F.lane + 256 * j)) * w; }
            f32x4 v[4]; float ss = 0.f;
#pragma unroll
            for (int j = 0; j < 4; ++j) { v[j] = *(const f32x4*)(x + ro + 4 * F.lane + 256 * j) + g2[j] * acc[j]; ss += dot4(v[j]); }
            if (mode != 2) {
#pragma unroll
                for (int j = 0; j < 4; ++j) *(f32x4*)(x + ro + 4 * F.lane + 256 * j) = v[j]; }
            const float rstd = 1.0f / sqrtf(wave_sum(ss) * (1.0f / D) + EPS);
            if (mode == 2) {
#pragma unroll
                for (int j = 0; j < 4; ++j) *(f32x4*)(out + ro + 4 * F.lane + 256 * j) = v[j] * rstd * mv.a[j] + mv.b[j];
            } else {
                f32x4 o[4];
#pragma unroll
                for (int j = 0; j < 4; ++j) o[j] = v[j] * rstd * mv.a[j] + mv.b[j];
                store_bf16_row(h + ro, o, F.lane);
                if (mode == 1) {
#pragma unroll
                    for (int j = 0; j < 4; ++j) o[j] = v[j] * rstd * mk.a[j] + mk.b[j];
                    store_bf16_row(hkv + ro, o, F.lane); }
            }
        }
    }
}

__device__ __forceinline__ int crow16(int i, int h) { return (i & 3) + 8 * (i >> 2) + 4 * h; }
struct DilTile { bf16x8 kf[4]; v4u vv[4]; };
__device__ __forceinline__ void dil_load(DilTile& t, const bf16* KV, int rowbase, int res, int dsh, int kv0, int head, int lane) {
    const int r = lane & 31, h = lane >> 5; const bf16* kp = KV + (size_t)(rowbase + res + ((kv0 + r) << dsh)) * (2 * D) + head * 64 + 8 * h;
#pragma unroll
    for (int ds = 0; ds < 4; ++ds) t.kf[ds] = *(const bf16x8*)(kp + 16 * ds);
#pragma unroll
    for (int i = 0; i < 4; ++i) { const int ci = i * 64 + lane, key = ci >> 3, part = ci & 7; t.vv[i] = *(const v4u*)(KV + (size_t)(rowbase + res + ((kv0 + key) << dsh)) * (2 * D) + D + head * 64 + part * 8); }
}
__device__ __forceinline__ void phase_dilated(const Frame& F, const bf16* Q3, const bf16* KV, bf16* OG, float* LSE) {
    LAS unsigned char* wl = F.lds + F.wave * 8192;
    const int lane = F.lane, r = lane & 31, h = lane >> 5;
    const int NTASK = NB * 16 * 3 * 64;
    for (int task = F.gw; task < NTASK; task += F.NGW) {
        const int idx64 = task & 63, t2 = task >> 6, g = t2 % 3, t3 = t2 / 3, head = t3 & 15, b = t3 >> 4;
        const int dsh = 2 * g, nvb = 64 >> dsh, res = idx64 / nvb, vb = idx64 % nvb, v0 = vb * 32, rowbase = b * S;
        const int qrow = rowbase + res + ((v0 + r) << dsh);
        const bf16* qp = Q3 + (size_t)qrow * (3 * D) + g * D + head * 64 + 8 * h;
        bf16x8 qf[4];
#pragma unroll
        for (int ds = 0; ds < 4; ++ds) qf[ds] = *(const bf16x8*)(qp + 16 * ds);
        float m = -INFINITY, l = 0.f; f32x16 o0, o1;
#pragma unroll
        for (int i = 0; i < 16; ++i) { o0[i] = 0.f; o1[i] = 0.f; }
        const int jstart = (v0 >= 128) ? 0 : ((128 - v0) >> 5);
        DilTile cur, nxt; dil_load(cur, KV, rowbase, res, dsh, v0 - 128 + 32 * jstart, head, lane);
#pragma unroll
        for (int j = 0; j < 5; ++j) {
            if (j >= jstart) {
                if (j < 4) dil_load(nxt, KV, rowbase, res, dsh, v0 - 128 + 32 * (j + 1), head, lane);
#pragma unroll
                for (int i = 0; i < 4; ++i) { const int ci = i * 64 + lane, key = ci >> 3, part = ci & 7; *(LAS v4u*)(wl + key * 144 + part * 16) = cur.vv[i]; }
                f32x16 p;
#pragma unroll
                for (int i = 0; i < 16; ++i) p[i] = 0.f;
#pragma unroll
                for (int ds = 0; ds < 4; ++ds) p = __builtin_amdgcn_mfma_f32_32x32x16_bf16(cur.kf[ds], qf[ds], p, 0, 0, 0);
                if (j == 0) {
#pragma unroll
                    for (int i = 0; i < 16; ++i) if (crow16(i, h) < r) p[i] = -INFINITY;
                }
                if (j == 4) {
#pragma unroll
                    for (int i = 0; i < 16; ++i) if (crow16(i, h) > r) p[i] = -INFINITY;
                }
                float mt = p[0];
#pragma unroll
                for (int i = 1; i < 16; ++i) mt = fmaxf(mt, p[i]);
                mt = fmaxf(mt, __shfl_xor(mt, 32));
                const float mn = fmaxf(m, mt), alpha = __builtin_amdgcn_exp2f(m - mn); m = mn;
                float rs = 0.f;
#pragma unroll
                for (int i = 0; i < 16; ++i) { p[i] = __builtin_amdgcn_exp2f(p[i] - mn); rs += p[i]; }
                l = l * alpha + rs;
#pragma unroll
                for (int i = 0; i < 16; ++i) { o0[i] *= alpha; o1[i] *= alpha; }
                bf16x8 pf[2];
#pragma unroll
                for (int s = 0; s < 2; ++s) { v4u w; w.x = pk2(p[8 * s], p[8 * s + 1]); w.y = pk2(p[8 * s + 2], p[8 * s + 3]); w.z = pk2(p[8 * s + 4], p[8 * s + 5]); w.w = pk2(p[8 * s + 6], p[8 * s + 7]); pf[s] = __builtin_bit_cast(bf16x8, w); }
                const int i16 = lane & 15, q4 = i16 >> 2, p4 = i16 & 3, blk = (lane >> 4) & 1;
#pragma unroll
                for (int s = 0; s < 2; ++s) {
#pragma unroll
                    for (int db = 0; db < 2; ++db) {
                        const LAS unsigned char* a0 = wl + (16 * s + 4 * h + q4) * 144 + (32 * db + 16 * blk + 4 * p4) * 2;
                        const s16x4 lo = __builtin_bit_cast(s16x4, __builtin_amdgcn_ds_read_tr16_b64_v4i16((LAS s16x4*)a0));
                        const s16x4 hi = __builtin_bit_cast(s16x4, __builtin_amdgcn_ds_read_tr16_b64_v4i16((LAS s16x4*)(a0 + 8 * 144)));
                        const bf16x8 vf = (bf16x8){lo[0], lo[1], lo[2], lo[3], hi[0], hi[1], hi[2], hi[3]};
                        if (db == 0) o0 = __builtin_amdgcn_mfma_f32_32x32x16_bf16(vf, pf[s], o0, 0, 0, 0); else o1 = __builtin_amdgcn_mfma_f32_32x32x16_bf16(vf, pf[s], o1, 0, 0, 0);
                    }
                }
                if (j < 4) cur = nxt;
            }
        }
        const float lt = l + __shfl_xor(l, 32), inv = 1.0f / lt;
        bf16* op = OG + (size_t)g * T * D + (size_t)qrow * D + head * 64 + 4 * h;
#pragma unroll
        for (int ig = 0; ig < 4; ++ig) { v2u w0, w1; w0.x = pk2(o0[4 * ig] * inv, o0[4 * ig + 1] * inv); w0.y = pk2(o0[4 * ig + 2] * inv, o0[4 * ig + 3] * inv); w1.x = pk2(o1[4 * ig] * inv, o1[4 * ig + 1] * inv); w1.y = pk2(o1[4 * ig + 2] * inv, o1[4 * ig + 3] * inv);
            *(v2u*)(op + 8 * ig) = w0; *(v2u*)(op + 32 + 8 * ig) = w1; }
        if (h == 0) LSE[(size_t)g * T * 16 + (size_t)qrow * 16 + head] = m + __builtin_amdgcn_logf(lt);
    }
}

__global__ void __launch_bounds__(NWAVES * 64, 2) yoco_fwd(Args a_unused) {
    extern __shared__ __attribute__((aligned(16))) unsigned char lds_raw[];
    int ph_lo, ph_hi; unsigned barx = 0;
    {
        ArgsP ap = (ArgsP)__builtin_amdgcn_kernarg_segment_ptr(); ph_lo = ap->ph_lo; ph_hi = ap->ph_hi;
        LAS unsigned char* l0 = (LAS unsigned char*)lds_raw;
        for (int u = threadIdx.x; u < (LDS_BYTES - MISC_OFF) / 4; u += NWAVES * 64) ((LAS unsigned*)(l0 + MISC_OFF))[u] = 0u;
        __syncthreads();
        if (ap->use_bar) { XcdBarrier b0 = xcd_barrier_post((unsigned*)(ap->ws + WS_CTL) + CW_BAR, (volatile LAS unsigned*)(l0 + MISC_OFF)); barx = b0.x; }
    }
    int ph = 0;
#define PH_BEGIN if (ph_lo <= ph && ph < ph_hi) { ArgsP ap = (ArgsP)__builtin_amdgcn_kernarg_segment_ptr(); asm volatile("" : "+s"(ap)); unsigned char* ws = ap->ws; Frame F; { int t_ = threadIdx.x; asm volatile("" : "+v"(t_)); \
        unsigned lb_ = 0; asm volatile("" : "+s"(lb_)); F.lds = (LAS unsigned char*)lds_raw + lb_; F.tid = t_; F.lane = t_ & 63; F.wave = __builtin_amdgcn_readfirstlane(t_ >> 6); int g_ = gridDim.x, b_ = blockIdx.x; asm volatile("" : "+s"(g_), "+s"(b_)); F.G = g_; F.bid = b_; F.gw = b_ * NWAVES + F.wave; F.NGW = g_ * NWAVES; }
#define PH_END if (ph + 1 < ph_hi) { XcdBarrier b_; b_.bar = (unsigned*)(ws + WS_CTL) + CW_BAR; b_.x = barx; b_.st = (volatile LAS unsigned*)(F.lds + MISC_OFF); xcd_barrier(b_); } } ++ph;
#define P_MODALL ((float*)(ws + WS_MOD))
#define P_XRES ((float*)(ws + WS_X))
#define P_HBUF ((bf16*)(ws + WS_H))
#define P_HKV ((bf16*)(ws + WS_HKV))
#define P_QBUF ((bf16*)(ws + WS_Q))
#define P_KVSH ((bf16*)(ws + WS_KVSH))
#define P_OBUF ((bf16*)(ws + WS_O))
#define P_OPBUF ((bf16*)(ws + WS_OP))
#define P_LSE ((float*)(ws + WS_LSE))
#define P_HS ((bf16*)(ws + WS_HS))
#define P_ACT ((bf16*)(ws + WS_ACT))
#define P_Y ((bf16*)(ws + WS_Y))
#define P_TKE ((int*)(ws + WS_TKE))
#define P_TKW ((float*)(ws + WS_TKW))
#define P_TKL ((int*)(ws + WS_TKL))
#define P_SLOT ((int*)(ws + WS_SLOT))
#define P_WGCNT ((int*)(ws + WS_WGCNT))
#define P_TEXP ((int*)(ws + WS_TEXP))
#define P_NTW ((unsigned*)(ws + WS_NT))
#define P_ROWTOK ((int*)(ws + WS_ROWTOK))
#define P_COS ((const float*)(ws + WS_ROPE))
#define P_SIN ((const float*)(ws + WS_ROPE) + S * 8)

    PH_BEGIN p0_prologue(F, ap); PH_END
    PH_BEGIN phase_modulate0(F, ap->in[I_X], ap->in[I_MIXN], P_MODALL, 0, D, P_HBUF); PH_END

    for (int st = 0; st < 5; ++st) {
        const int kind = (st < 2) ? 0 : (st == 2 ? 1 : 2);
        const int l = (st < 2) ? st : st - 1;
        const int j = l - 2;
        PH_BEGIN {
            pg8::Gemm g; pg8::EpiRope E; int nN;
            if (kind == 0) { g = pg8::Gemm{P_HBUF, (const bf16*)(ws + WS_WQKV) + (size_t)l * 3 * D * D, T, 3 * D, D, 0}; nN = 12; E = pg8::EpiRope{P_QBUF, D, D, (size_t)T * D, 2 * D, D, QSCALE, P_COS, P_SIN}; }
            else if (kind == 1) { g = pg8::Gemm{P_HKV, (const bf16*)(ws + WS_KVW), T, 2 * D, D, 0}; nN = 8; E = pg8::EpiRope{P_KVSH, 2 * D, 0, 0, D, 0, 1.0f, P_COS, P_SIN}; }
            else { g = pg8::Gemm{P_HBUF, (const bf16*)(ws + WS_BWQ) + (size_t)j * 3 * D * D, T, 3 * D, D, 0}; nN = 12; E = pg8::EpiRope{P_QBUF, 3 * D, 0, 0, 3 * D, 3 * D, QSCALE, P_COS, P_SIN}; }
            pg8::Order O; O.init(T / 256, nN, F.G, F.bid, nullptr);
            pg8::gemm_phase<pg8::EpiRope, pg8::Order, true, true>(F.lds, g, O, E);
        } PH_END
        if (kind == 1) continue;
        if (kind == 0) {
            PH_BEGIN {
                const attn_body::bf16* Qp = (const attn_body::bf16*)P_QBUF; const attn_body::bf16* Kp = Qp + (size_t)T * D; const attn_body::bf16* Vp = Kp + (size_t)T * D; attn_body::bf16* Op = (attn_body::bf16*)P_OPBUF;
                const int vcu = (F.G % 8 == 0) ? (F.bid % 8) * (F.G / 8) + F.bid / 8 : F.bid;
                for (int p = vcu; p < NB * 16; p += F.G) { const int b = p >> 4, hh = p & 15, hq = hh >> 1, mm = hh & 1;
                    for (int half = 0; half < 2; ++half)
                        for (int qb = 0; qb < S / 256; ++qb)
                            attn_body::attn_unit<8>(b, qb, Qp + hh * 64, Kp + hh * 64, Vp + hq * 128 + half * 64, Op + (size_t)mm * T * D + hq * 128 + half * 64, (char*)F.lds); }
            } PH_END
            PH_BEGIN phase_subln(F, P_OPBUF, ap->in[I_ALAM] + l * 256, ap->in[I_ASUBLN] + l * 128, ap->lam_init[l & 1], P_OBUF); PH_END
        } else {
            PH_BEGIN phase_dilated(F, P_QBUF, P_KVSH, P_OPBUF, P_LSE); PH_END
            PH_BEGIN phase_merge(F, P_OPBUF, P_LSE, P_OBUF); PH_END
        }
        PH_BEGIN {
            const bf16* wo = (kind == 0) ? (const bf16*)(ws + WS_AWO) + (size_t)l * D * D : (const bf16*)(ws + WS_BWO) + (size_t)j * D * D;
            pg8::Gemm g{P_OBUF, wo, T, D, D, 0}; pg8::Order O; O.init(T / 256, 4, F.G, F.bid, nullptr);
            pg8::EpiResid E{(l == 0) ? ap->in[I_X] : P_XRES, P_XRES, P_MODALL + l * 6 * D + 2 * D, MODC};
            pg8::gemm_phase<pg8::EpiResid, pg8::Order, true, true>(F.lds, g, O, E);
        } PH_END
        PH_BEGIN phase_mod2_router(F, P_XRES, ap->in[I_FFNN] + l * D, P_MODALL, l * 6 * D + 3 * D, l * 6 * D + 4 * D, (const bf16*)(ws + WS_RFRAG) + (size_t)l * 65536, ap->in[I_RB] + l * NE, P_HBUF, P_TKE, P_TKW, P_TKL, P_WGCNT); PH_END
        PH_BEGIN phase_scatter(F, P_WGCNT, P_TKE, P_TKL, P_SLOT, P_ROWTOK, P_TEXP, P_NTW, P_HBUF, P_HS); PH_END
        PH_BEGIN {
            const int nt = (int)__hip_atomic_load(P_NTW, RLX_AGENT); LAS int* tl = (LAS int*)(F.lds + TEXP_OFF);
            for (int i = F.tid; i < nt; i += NWAVES * 64) tl[i] = P_TEXP[i];
            __syncthreads();
            pg8::Gemm g{P_HS, (const bf16*)(ws + WS_WGU) + (size_t)l * NE * 2 * D * D, nt * 256, 2 * D, D, (size_t)2 * D * D * 2}; pg8::Order O; O.init(nt, 8, F.G, F.bid, tl);
            pg8::EpiSwiglu E{P_ACT, ap->in[I_BGU] + (size_t)l * NE * 2 * D};
            pg8::gemm_phase<pg8::EpiSwiglu, pg8::Order, true, true>(F.lds, g, O, E);
        } PH_END
        PH_BEGIN {
            const int nt = (int)__hip_atomic_load(P_NTW, RLX_AGENT); LAS int* tl = (LAS int*)(F.lds + TEXP_OFF);
            for (int i = F.tid; i < nt; i += NWAVES * 64) tl[i] = P_TEXP[i];
            __syncthreads();
            pg8::Gemm g{P_ACT, (const bf16*)(ws + WS_WDN) + (size_t)l * NE * D * D, nt * 256, D, D, (size_t)D * D * 2}; pg8::Order O; O.init(nt, 4, F.G, F.bid, tl);
            pg8::EpiDown E{P_Y, ap->in[I_BDN] + (size_t)l * NE * D};
            pg8::gemm_phase<pg8::EpiDown, pg8::Order, true, true>(F.lds, g, O, E);
        } PH_END
        PH_BEGIN {
            const int mode = (l == 3) ? 2 : (l == 1 ? 1 : 0);
            const float* gainA = (l == 3) ? ap->in[I_FINN] : ap->in[I_MIXN] + (l + 1) * D; const int shA = (l == 3) ? MOD_FIN : (l + 1) * 6 * D, scA = shA + D;
            phase_combine(F, P_XRES, P_Y, P_SLOT, P_TKW, P_MODALL + l * 6 * D + 5 * D, mode, gainA, P_MODALL, shA, scA, P_HBUF, ap->in[I_KVN], MOD_KV, MOD_KV + D, P_HKV, ap->out);
        } PH_END
    }
#undef PH_BEGIN
#undef PH_END
}
constexpr int N_PHASES = 2 + 9 + 9 + 1 + 9 + 9;

#ifndef MK_PER_PHASE
#define MK_PER_PHASE 0
#endif
extern "C" void kernel_launch(void* const* d_in, const int* in_sizes, int n_in, void* d_out, int out_size, void* d_ws, size_t ws_size, hipStream_t stream) {
    static int grid = 0;
    if (grid == 0) {
        if (n_in != 25 || in_sizes[0] != T * D || out_size != T * D || ws_size < WS_END) { fprintf(stderr, "kernel_launch: unexpected shapes / workspace (n_in %d, ws %zu)\n", n_in, ws_size); grid = -1; return; }
        int dev = 0, cus = 0, per_cu = 0;
        if (hipGetDevice(&dev) != hipSuccess || hipDeviceGetAttribute(&cus, hipDeviceAttributeMultiprocessorCount, dev) != hipSuccess) { grid = -1; return; }
        if (hipFuncSetAttribute((const void*)yoco_fwd, hipFuncAttributeMaxDynamicSharedMemorySize, LDS_BYTES) != hipSuccess) { fprintf(stderr, "kernel_launch: hipFuncSetAttribute failed\n"); grid = -1; return; }
        if (hipOccupancyMaxActiveBlocksPerMultiprocessor(&per_cu, (const void*)yoco_fwd, NWAVES * 64, LDS_BYTES) != hipSuccess || per_cu < 1) fprintf(stderr, "kernel_launch: occupancy query reports %d\n", per_cu);
        (void)hipGetLastError();
        grid = cus;
    }
    if (grid < 0) return;
    if (hipMemsetAsync((char*)d_ws + WS_CTL, 0, CTL_ZERO_BYTES, stream) != hipSuccess) return;
    Args a{};
    for (int i = 0; i < 25; ++i) a.in[i] = (const float*)d_in[i];
    a.out = (float*)d_out; a.ws = (unsigned char*)d_ws;
    for (int i = 0; i < 8; ++i) a.invf[i] = (float)pow(500000.0, -(double)(2 * i) / 16.0);
    a.lam_init[0] = (float)(0.8 - 0.6 * exp(-0.3 * 0.0)); a.lam_init[1] = (float)(0.8 - 0.6 * exp(-0.3 * 1.0));
#if MK_PER_PHASE
    for (int p = 0; p < N_PHASES; ++p) { a.ph_lo = p; a.ph_hi = p + 1; a.use_bar = 0; hipLaunchKernelGGL(yoco_fwd, dim3(grid), dim3(NWAVES * 64), LDS_BYTES, stream, a); }
#else
    a.ph_lo = 0; a.ph_hi = N_PHASES; a.use_bar = 1; hipLaunchKernelGGL(yoco_fwd, dim3(grid), dim3(NWAVES * 64), LDS_BYTES, stream, a);
#endif
}
```

```cpp
#include <hip/hip_runtime.h>
#include <hip/hip_bf16.h>
#include <cstdio>
#include <cstdint>
#include <cmath>
namespace pg8 {
#define PG8_LAS __attribute__((address_space(3)))
typedef unsigned short bf16_t;
typedef short bf16x8 __attribute__((ext_vector_type(8)));
typedef float f32x4 __attribute__((ext_vector_type(4)));
typedef unsigned u32x4 __attribute__((ext_vector_type(4)));
constexpr int BM = 256, BK = 64, HALF = 128, HTB = HALF * BK * 2  , STAGE_BYTES = 8 * HTB, NXCD = 8, WGM = 8;

__host__ __device__ __forceinline__ int lds_byte(int r, int c) { const int st = (r >> 4) * 2 + (c >> 5), rr = r & 15, cc = c & 31, ob = rr * 64 + cc * 2; return st * 1024 + (ob ^ (((ob >> 9) & 1) << 5)); }
__host__ __device__ __forceinline__ void stage_rc(int b, int& R, int& C) { const int st = b / 1024, sb = b % 1024, swz = sb ^ (((sb >> 9) & 1) << 5); R = (st >> 1) * 16 + swz / 64; C = (st & 1) * 32 + (swz % 64) / 2; }
__host__ __device__ __forceinline__ int perm32(int rho) { const int n = rho >> 4, i = rho & 15; return 8 * (i >> 2) + 4 * n + (i & 3); }

struct Unit { int pm, pn, e, ui; };
struct Gemm { const bf16_t* A; const bf16_t* Bt; int M, N, K; size_t estride; };

template <bool GATHER> struct OrderT {
    int nM, nN, nwg, G, c; const PG8_LAS int* texp; const PG8_LAS int* rowtab;
    __device__ __forceinline__ void init(int nM_, int nN_, int G_, int c_, const PG8_LAS int* texp_, const PG8_LAS int* rowtab_) { nM = nM_; nN = nN_; nwg = nM * nN; G = G_; c = c_; texp = texp_; rowtab = rowtab_; }
    __device__ __forceinline__ bool next(int i, Unit& u) const {
        const long L = (long)i * G + c; if (L >= nwg) return false;
        int wgid = (int)L; { const int q = nwg / NXCD, r = nwg % NXCD, xcd = wgid % NXCD, off = wgid / NXCD; wgid = (xcd < r ? xcd * (q + 1) : r * (q + 1) + (xcd - r) * q) + off; }
        const int nig = WGM * nN, gid = wgid / nig, fm = gid * WGM, gsz = (nM - fm) < WGM ? (nM - fm) : WGM;
        u.pm = fm + ((wgid % nig) % gsz); u.pn = (wgid % nig) / gsz; u.e = texp ? texp[u.pm] : 0; u.ui = i; return true;
    }
    __device__ __forceinline__ int arow(const Unit& u, int r) const { if constexpr (GATHER) return rowtab[u.ui * 256 + r]; else return u.pm * 256 + r; }
};
typedef OrderT<false> Order;

__device__ __forceinline__ unsigned cvt_pk_bf16(float lo, float hi) { unsigned r; asm volatile("v_cvt_pk_bf16_f32 %0, %1, %2" : "=v"(r) : "v"(lo), "v"(hi)); return r; }
__device__ __forceinline__ unsigned pk4_fp8(float a, float b, float c, float d) { unsigned u = (unsigned)__builtin_amdgcn_cvt_pk_fp8_f32(a, b, 0, false); return (unsigned)__builtin_amdgcn_cvt_pk_fp8_f32(c, d, (int)u, true); }
__device__ __forceinline__ f32x4 shfl16(f32x4 v) { f32x4 o; o[0] = __shfl_xor(v[0], 16); o[1] = __shfl_xor(v[1], 16); o[2] = __shfl_xor(v[2], 16); o[3] = __shfl_xor(v[3], 16); return o; }

struct EpiRope {
    static constexpr bool PERM = true, AFTER_DRAIN = false;
    bf16_t* O; int ldc; int split_cols; size_t split_stride; int rope_cols, scale_cols; float qscale; const float* cosT; const float* sinT;
    __device__ __forceinline__ void operator()(const f32x4 (&acc)[2][2][4][2], const Unit& u, int wr, int wc, int fr, int fq) const {
        const int row0 = u.pm * BM + wr * 64 + fr; int colt = u.pn * BM; bf16_t* base = O;
        const bool do_rope = (colt < rope_cols) && ((wc & 1) == 0); const float sc = (colt < scale_cols) ? qscale : 1.f;
        if (split_cols) { const int t = colt / split_cols; base += (size_t)t * split_stride; colt -= t * split_cols; }
        const int col0 = colt + wc * 32 + 8 * fq;
#pragma unroll
        for (int ai = 0; ai < 2; ++ai)
#pragma unroll
            for (int m = 0; m < 4; ++m) { const int row = row0 + ai * HALF + m * 16; bf16_t* rowp = base + (size_t)row * ldc + col0;
                f32x4 c0 = (f32x4){1.f, 1.f, 1.f, 1.f}, c1 = c0, s0 = (f32x4){0.f, 0.f, 0.f, 0.f}, s1 = s0;
                if (do_rope) { const int t = row & 2047; c0 = *(const f32x4*)(cosT + t * 8); c1 = *(const f32x4*)(cosT + t * 8 + 4); s0 = *(const f32x4*)(sinT + t * 8); s1 = *(const f32x4*)(sinT + t * 8 + 4);
                    if (fq == 0) { s0 = -s0; s1 = -s1; } else if (fq >= 2) { c0 = (f32x4){1.f, 1.f, 1.f, 1.f}; c1 = c0; s0 = (f32x4){0.f, 0.f, 0.f, 0.f}; s1 = s0; } }
#pragma unroll
                for (int bj = 0; bj < 2; ++bj) { f32x4 v0 = acc[ai][bj][m][0], v1 = acc[ai][bj][m][1];
                    if (do_rope) { const f32x4 o0 = shfl16(v0), o1 = shfl16(v1); v0 = v0 * c0 + o0 * s0; v1 = v1 * c1 + o1 * s1; }
                    v0 = v0 * sc; v1 = v1 * sc; u32x4 w; w.x = cvt_pk_bf16(v0[0], v0[1]); w.y = cvt_pk_bf16(v0[2], v0[3]); w.z = cvt_pk_bf16(v1[0], v1[1]); w.w = cvt_pk_bf16(v1[2], v1[3]);
                    *(u32x4*)(rowp + bj * HALF) = w; } }
    }
};
struct EpiResid {
    static constexpr bool PERM = false, AFTER_DRAIN = false;
    const float* xin; float* xout; const float* gate; int gstride;
    __device__ __forceinline__ void operator()(const f32x4 (&acc)[2][2][4][2], const Unit& u, int wr, int wc, int fr, int fq) const {
        const int row0 = u.pm * BM + wr * 64 + fr, col0 = u.pn * BM + wc * 32 + 4 * fq; const float* gp = gate + (size_t)(u.pm >> 3) * gstride + col0;
        f32x4 gv[2][2];
#pragma unroll
        for (int bj = 0; bj < 2; ++bj)
#pragma unroll
            for (int n = 0; n < 2; ++n) gv[bj][n] = *(const f32x4*)(gp + bj * HALF + n * 16);
#pragma unroll
        for (int ai = 0; ai < 2; ++ai)
#pragma unroll
            for (int m = 0; m < 4; ++m) { const size_t off = (size_t)(row0 + ai * HALF + m * 16) * 1024 + col0;
#pragma unroll
                for (int bj = 0; bj < 2; ++bj)
#pragma unroll
                    for (int n = 0; n < 2; ++n) { const f32x4 xi = *(const f32x4*)(xin + off + bj * HALF + n * 16); *(f32x4*)(xout + off + bj * HALF + n * 16) = xi + gv[bj][n] * acc[ai][bj][m][n]; }
                if (m & 1) asm volatile("" ::: "memory"); }
    }
};
template <bool F8> struct EpiSwiglu {
    static constexpr bool PERM = true, AFTER_DRAIN = false;
    bf16_t* act; const float* bgu;
    __device__ __forceinline__ void operator()(const f32x4 (&acc)[2][2][4][2], const Unit& u, int wr, int wc, int fr, int fq) const {
        const int row0 = u.pm * BM + wr * 64 + fr, acol0 = u.pn * HALF + wc * 32 + 8 * fq; const float* bp = bgu + (size_t)u.e * 2048 + acol0;
        const f32x4 bg0 = *(const f32x4*)(bp), bg1 = *(const f32x4*)(bp + 4), bu0 = *(const f32x4*)(bp + 1024), bu1 = *(const f32x4*)(bp + 1028);
#pragma unroll
        for (int ai = 0; ai < 2; ++ai)
#pragma unroll
            for (int m = 0; m < 4; ++m) { const size_t eoff_ = (size_t)(row0 + ai * HALF + m * 16) * 1024 + acol0;
                f32x4 g0 = acc[ai][0][m][0] + bg0, g1 = acc[ai][0][m][1] + bg1, u0 = acc[ai][1][m][0] + bu0, u1 = acc[ai][1][m][1] + bu1; f32x4 r0, r1;
#pragma unroll
                for (int j = 0; j < 4; ++j) { const float ga = fminf(g0[j], 7.0f), gb = fminf(g1[j], 7.0f), ua = fminf(fmaxf(u0[j], -7.0f), 7.0f), ub = fminf(fmaxf(u1[j], -7.0f), 7.0f);
                    const float sa = __builtin_amdgcn_rcpf(1.0f + __builtin_amdgcn_exp2f(ga * (-1.702f * 1.4426950408889634f))), sb = __builtin_amdgcn_rcpf(1.0f + __builtin_amdgcn_exp2f(gb * (-1.702f * 1.4426950408889634f)));
                    r0[j] = (ua + 1.0f) * (ga * sa); r1[j] = (ub + 1.0f) * (gb * sb); }
                if constexpr (F8) { typedef unsigned u32x2_ __attribute__((ext_vector_type(2))); u32x2_ w; w.x = pk4_fp8(r0[0], r0[1], r0[2], r0[3]); w.y = pk4_fp8(r1[0], r1[1], r1[2], r1[3]); *(u32x2_*)((unsigned char*)act + eoff_) = w; }
                else { u32x4 w; w.x = cvt_pk_bf16(r0[0], r0[1]); w.y = cvt_pk_bf16(r0[2], r0[3]); w.z = cvt_pk_bf16(r1[0], r1[1]); w.w = cvt_pk_bf16(r1[2], r1[3]); *(u32x4*)(act + eoff_) = w; } }
    }
};
struct EpiDown {
    static constexpr bool PERM = true, AFTER_DRAIN = false;
    bf16_t* Y; const float* bd;
    __device__ __forceinline__ void operator()(const f32x4 (&acc)[2][2][4][2], const Unit& u, int wr, int wc, int fr, int fq) const {
        const int row0 = u.pm * BM + wr * 64 + fr, col0 = u.pn * BM + wc * 32 + 8 * fq; const float* bp = bd + (size_t)u.e * 1024 + col0;
        f32x4 bv[2][2];
#pragma unroll
        for (int bj = 0; bj < 2; ++bj)
#pragma unroll
            for (int n = 0; n < 2; ++n) bv[bj][n] = *(const f32x4*)(bp + bj * HALF + 4 * n);
#pragma unroll
        for (int ai = 0; ai < 2; ++ai)
#pragma unroll
            for (int m = 0; m < 4; ++m) { bf16_t* rowp = Y + (size_t)(row0 + ai * HALF + m * 16) * 1024 + col0;
#pragma unroll
                for (int bj = 0; bj < 2; ++bj) { const f32x4 v0 = acc[ai][bj][m][0] + bv[bj][0], v1 = acc[ai][bj][m][1] + bv[bj][1];
                    u32x4 w; w.x = cvt_pk_bf16(v0[0], v0[1]); w.y = cvt_pk_bf16(v0[2], v0[3]); w.z = cvt_pk_bf16(v1[0], v1[1]); w.w = cvt_pk_bf16(v1[2], v1[3]);
                    *(u32x4*)(rowp + bj * HALF) = w; } }
    }
};

typedef int v8i_t __attribute__((ext_vector_type(8)));
typedef int v4i_t __attribute__((ext_vector_type(4)));
template <class Epi, class Sched, bool F8>
__device__ __forceinline__ void gemm_phase(PG8_LAS unsigned char* lds, const Gemm g, const Sched& S, const Epi& E) {
    int tid_ = threadIdx.x; asm volatile("" : "+v"(tid_));
    const int tid = tid_, wid = __builtin_amdgcn_readfirstlane(tid >> 6), lane = tid & 63, wr = wid >> 2, wc = wid & 3, fr = lane & 15, fq = lane >> 4;
    constexpr int ROWB = F8 ? 1024 : 2048, nt = ROWB / 128;
    unsigned voffB[2], cvA0[2], cvA1[2];
#pragma unroll
    for (int i = 0; i < 2; ++i) { int R, C; stage_rc(tid * 16 + i * 8192, R, C); const int Rb = Epi::PERM ? ((R & ~31) + perm32(R & 31)) : R; voffB[i] = (unsigned)(Rb * ROWB) + (unsigned)C * 2u; }
    constexpr size_t kstep = 128;
    constexpr size_t hstep = (size_t)HALF * ROWB;
    constexpr size_t tstep = 2 * hstep;
    const unsigned ldsm0 = (unsigned)__builtin_amdgcn_readfirstlane((int)((unsigned)(uintptr_t)lds + (unsigned)wid * 1024u));
    unsigned abase_ = (unsigned)(uintptr_t)(lds + lds_byte(wr * 64 + fr, fq * 8)), bbase_ = (unsigned)(uintptr_t)(lds + 4 * HTB + lds_byte(wc * 32 + fr, fq * 8));
    asm volatile("" : "+v"(abase_), "+v"(bbase_));
    const PG8_LAS unsigned char* const abase = (const PG8_LAS unsigned char*)(uintptr_t)abase_; const PG8_LAS unsigned char* const bbase = (const PG8_LAS unsigned char*)(uintptr_t)bbase_;
#define PG8_SA(b, h) (((b) * 2 + (h)) * HTB)
#define PG8_SB(b, h) ((4 + (b) * 2 + (h)) * HTB)
#define PG8_STAGE(bufoff, gbase, voff) do { _Pragma("unroll") for (int _i = 0; _i < 2; ++_i) { unsigned keep_; \
        asm volatile("s_mov_b32 %0, m0\n\ts_mov_b32 m0, %3\n\ts_nop 0\n\tglobal_load_lds_dwordx4 %1, %2\n\ts_mov_b32 m0, %0" : "=&s"(keep_) : "v"((voff)[_i]), "s"((const char*)(gbase)), "s"(ldsm0 + (unsigned)((bufoff) + _i * 8192)) : "memory"); } } while (0)
#define PG8_RD(p) __builtin_bit_cast(v4i_t, *(const PG8_LAS bf16x8*)(p))
#define PG8_LDA(dst, b, h) do { _Pragma("unroll") for (int m = 0; m < 4; ++m) dst[m] = __builtin_shufflevector(PG8_RD(abase + PG8_SA(b, h) + m * 2048), PG8_RD(abase + PG8_SA(b, h) + m * 2048 + 1024), 0, 1, 2, 3, 4, 5, 6, 7); } while (0)
#define PG8_LDB(dst, b, h) do { _Pragma("unroll") for (int n = 0; n < 2; ++n) dst[n] = __builtin_shufflevector(PG8_RD(bbase + (PG8_SB(b, h) - 4 * HTB) + n * 2048), PG8_RD(bbase + (PG8_SB(b, h) - 4 * HTB) + n * 2048 + 1024), 0, 1, 2, 3, 4, 5, 6, 7); } while (0)
#define PG8_LO(x) __builtin_bit_cast(bf16x8, __builtin_shufflevector((x), (x), 0, 1, 2, 3))
#define PG8_HI(x) __builtin_bit_cast(bf16x8, __builtin_shufflevector((x), (x), 4, 5, 6, 7))
#define PG8_MMA(ai, bj, At, Bt) do { __builtin_amdgcn_s_setprio(1); \
        if constexpr (F8) { _Pragma("unroll") for (int m = 0; m < 4; ++m) _Pragma("unroll") for (int n = 0; n < 2; ++n) \
            acc[ai][bj][m][n] = __builtin_amdgcn_mfma_scale_f32_16x16x128_f8f6f4(Bt[n], At[m], acc[ai][bj][m][n], 0, 0, 0, 0x7b7b7b7b, 0, 0x7b7b7b7b);     } \
        else { _Pragma("unroll") for (int m = 0; m < 4; ++m) _Pragma("unroll") for (int n = 0; n < 2; ++n) { \
            acc[ai][bj][m][n] = __builtin_amdgcn_mfma_f32_16x16x32_bf16(PG8_LO(Bt[n]), PG8_LO(At[m]), acc[ai][bj][m][n], 0, 0, 0); \
            acc[ai][bj][m][n] = __builtin_amdgcn_mfma_f32_16x16x32_bf16(PG8_HI(Bt[n]), PG8_HI(At[m]), acc[ai][bj][m][n], 0, 0, 0); } } \
        __builtin_amdgcn_s_setprio(0); } while (0)
#define PG8_WAIT_V(n) asm volatile("s_waitcnt vmcnt(" #n ")" ::: "memory")
#define PG8_WAIT_L(n) asm volatile("s_waitcnt lgkmcnt(" #n ")" ::: "memory")
#define PG8_BAR __builtin_amdgcn_s_barrier()
#define PG8_SCHED __builtin_amdgcn_sched_barrier(0)
    Unit cur, nxt; int ui = 0;
    if (!S.next(0, cur)) return;
    f32x4 acc[2][2][4][2];
#pragma unroll
    for (int a = 0; a < 2; ++a)
#pragma unroll
        for (int b = 0; b < 2; ++b)
#pragma unroll
            for (int m = 0; m < 4; ++m)
#pragma unroll
                for (int n = 0; n < 2; ++n) acc[a][b][m][n] = (f32x4){0.f, 0.f, 0.f, 0.f};
    v8i_t At[4], B0[2], B1[2];
    const char* const Ab = (const char*)g.A;
#pragma unroll
    for (int i = 0; i < 2; ++i) { int R, C; stage_rc(tid * 16 + i * 8192, R, C); cvA0[i] = (unsigned)S.arow(cur, R) * (unsigned)ROWB + (unsigned)C * 2u; cvA1[i] = (unsigned)S.arow(cur, HALF + R) * (unsigned)ROWB + (unsigned)C * 2u; }
    const char* cB = (const char*)g.Bt + (size_t)cur.pn * tstep + (size_t)cur.e * g.estride;
    PG8_STAGE(PG8_SB(0, 0), cB, voffB); PG8_STAGE(PG8_SB(0, 1), cB + hstep, voffB); PG8_STAGE(PG8_SA(0, 0), Ab, cvA0); PG8_STAGE(PG8_SA(0, 1), Ab, cvA1);
    if (wr == 1) PG8_BAR;
    PG8_WAIT_V(2); PG8_BAR;
    PG8_STAGE(PG8_SB(1, 0), cB + kstep, voffB); PG8_STAGE(PG8_SA(1, 0), Ab + kstep, cvA0); PG8_STAGE(PG8_SB(1, 1), cB + hstep + kstep, voffB);
    PG8_WAIT_V(6); PG8_BAR;
    for (;;) {
        const bool has_next = S.next(ui + 1, nxt);
        const char* nB = has_next ? (const char*)g.Bt + (size_t)nxt.pn * tstep + (size_t)nxt.e * g.estride : cB;
#pragma clang loop unroll(disable)
        for (int t = 0; t < nt; t += 2) {
            const bool last = (t == nt - 2);
            const char* a1 = Ab + (size_t)(t + 1) * kstep;
            const char* a2 = last ? Ab : Ab + (size_t)(t + 2) * kstep; const char* b2 = last ? nB : cB + (size_t)(t + 2) * kstep;
            const char* a3 = a2 + kstep; const char* b3 = b2 + kstep;
            PG8_LDB(B0, 0, 0); PG8_LDB(B1, 0, 1); PG8_SCHED; PG8_LDA(At, 0, 0); PG8_STAGE(PG8_SA(1, 1), a1, cvA1);
            if (last && has_next) {
                int t2_ = tid; asm volatile("" : "+v"(t2_));
#pragma unroll
                for (int i = 0; i < 2; ++i) { int R, C; stage_rc(t2_ * 16 + i * 8192, R, C); cvA0[i] = (unsigned)S.arow(nxt, R) * (unsigned)ROWB + (unsigned)C * 2u; cvA1[i] = (unsigned)S.arow(nxt, HALF + R) * (unsigned)ROWB + (unsigned)C * 2u; }
            }
            PG8_WAIT_V(8); PG8_WAIT_L(0); PG8_BAR; PG8_MMA(0, 0, At, B0); PG8_MMA(0, 1, At, B1); PG8_BAR; PG8_SCHED;
            PG8_LDA(At, 0, 1); PG8_STAGE(PG8_SB(0, 0), b2, voffB); PG8_STAGE(PG8_SB(0, 1), b2 + hstep, voffB); PG8_STAGE(PG8_SA(0, 0), a2, cvA0);
            PG8_WAIT_V(8); PG8_WAIT_L(0); PG8_BAR; PG8_MMA(1, 0, At, B0); PG8_MMA(1, 1, At, B1); PG8_BAR; PG8_SCHED;
            PG8_LDB(B0, 1, 0); PG8_LDB(B1, 1, 1); PG8_SCHED; PG8_LDA(At, 1, 0); PG8_STAGE(PG8_SA(0, 1), a2, cvA1);
            PG8_WAIT_V(8); PG8_WAIT_L(0); PG8_BAR; PG8_MMA(0, 0, At, B0); PG8_MMA(0, 1, At, B1); PG8_BAR; PG8_SCHED;
            PG8_LDA(At, 1, 1); PG8_STAGE(PG8_SB(1, 0), b3, voffB); PG8_STAGE(PG8_SB(1, 1), b3 + hstep, voffB); PG8_STAGE(PG8_SA(1, 0), a3, cvA0);
            PG8_WAIT_V(8); PG8_WAIT_L(0); PG8_BAR; PG8_MMA(1, 0, At, B0); PG8_MMA(1, 1, At, B1); PG8_BAR; PG8_SCHED;
        }
        if (wr == 0) PG8_BAR;
        E(acc, cur, wr, wc, fr, fq);
        if (!has_next) break;
#pragma unroll
        for (int a = 0; a < 2; ++a)
#pragma unroll
            for (int b = 0; b < 2; ++b)
#pragma unroll
                for (int m = 0; m < 4; ++m)
#pragma unroll
                    for (int n = 0; n < 2; ++n) acc[a][b][m][n] = (f32x4){0.f, 0.f, 0.f, 0.f};
        cur = nxt; cB = nB; ++ui;
        if (wr == 1) PG8_BAR;
    }
    PG8_WAIT_V(0);
    PG8_BAR;
#undef PG8_SA
#undef PG8_SB
#undef PG8_STAGE
#undef PG8_LDA
#undef PG8_LDB
#undef PG8_RD
#undef PG8_LO
#undef PG8_HI
#undef PG8_MMA
#undef PG8_WAIT_V
#undef PG8_WAIT_L
#undef PG8_BAR
#undef PG8_SCHED
}
}
namespace attn_body {
using bf16=__hip_bfloat16;
using bf16x8=__attribute__((ext_vector_type(8)))short;
using s16x4=__attribute__((ext_vector_type(4)))short;
using f32x16=__attribute__((ext_vector_type(16)))float;
using u32x4=__attribute__((ext_vector_type(4)))unsigned;
constexpr int BATCH=16,NHEAD=16,SEQ=2048,D=64,DM=NHEAD*D;
constexpr int NW=8,QBLK=32,QB=QBLK*NW,KVBLK=64,NQB=SEQ/QB;
constexpr int ATTN_PITCH=DM, ATTN_UNIT_ROWS=QB;
__device__ __forceinline__ int crow(int r,int hi){return (r&3)+8*(r>>2)+4*hi;}
#define SBAR() __builtin_amdgcn_sched_barrier(0)
__device__ __forceinline__ void cmask(f32x16&p0,f32x16&p1,int jb,int qrel,int hi){
  const float NEG=-INFINITY; int kb=64*jb+4*hi;
  #pragma unroll
  for(int r=0;r<16;++r){int kv=kb+(r&3)+8*(r>>2); if(kv>qrel)p0[r]=NEG; if(kv+32>qrel)p1[r]=NEG;}
}

constexpr int NSLOT=3, SLOTB=8192;
constexpr int LDS_K=0, LDS_V=NSLOT*SLOTB, LDS_WS=2*NSLOT*SLOTB, LDS_OST=LDS_WS+NW*64*4, LDS_BYTES=LDS_OST+NW*4096;
constexpr float C2=0.125f*1.4426950408889634f;
__device__ __forceinline__ void glds16(const void*gsrc,unsigned lds_dst){unsigned keep;
  asm volatile("s_mov_b32 %0, m0\n\ts_mov_b32 m0, %2\n\ts_nop 0\n\tglobal_load_lds_dwordx4 %1, off\n\ts_mov_b32 m0, %0":"=&s"(keep):"v"(gsrc),"s"(lds_dst):"memory");}
__device__ __forceinline__ float max3f(float a,float b,float c){float r;asm("v_max3_f32 %0, %1, %2, %3":"=v"(r):"v"(a),"v"(b),"v"(c));return r;}
__device__ __forceinline__ float max2f(float a,float b){float r;asm("v_max_f32_e32 %0, %1, %2":"=v"(r):"v"(a),"v"(b));return r;}
__device__ __forceinline__ float fadd_s(float a,float b){float r;asm("v_add_f32_e32 %0, %1, %2":"=v"(r):"v"(a),"v"(b));return r;}
__device__ __forceinline__ float fsub_s(float a,float b){float r;asm("v_sub_f32_e32 %0, %1, %2":"=v"(r):"v"(a),"v"(b));return r;}
typedef float f32x2_t __attribute__((ext_vector_type(2))); typedef __bf16 bf16x2_t __attribute__((ext_vector_type(2)));
__device__ __forceinline__ unsigned cvtpk_s(float lo,float hi){f32x2_t v={lo,hi};bf16x2_t b=__builtin_convertvector(v,bf16x2_t);return __builtin_bit_cast(unsigned,b);}
#define WAIT_BAR(N) asm volatile("s_waitcnt vmcnt(" #N ") lgkmcnt(0)\n\ts_barrier":::"memory")

__device__ __forceinline__ void qkt(f32x16&p0,f32x16&p1,const char*Kslot,const bf16x8*qr,const f32x16&negm,int r32,int hi){
  const char*kb=Kslot+hi*1024+r32*16;
  #pragma unroll
  for(int d0=0;d0<4;++d0){
    const bf16x8 b0=*reinterpret_cast<const bf16x8*>(kb+d0*2048);
    const bf16x8 b1=*reinterpret_cast<const bf16x8*>(kb+d0*2048+512);
    if(d0==0){p0=__builtin_amdgcn_mfma_f32_32x32x16_bf16(b0,qr[0],negm,0,0,0);p1=__builtin_amdgcn_mfma_f32_32x32x16_bf16(b1,qr[0],negm,0,0,0);}
    else{p0=__builtin_amdgcn_mfma_f32_32x32x16_bf16(b0,qr[d0],p0,0,0,0);p1=__builtin_amdgcn_mfma_f32_32x32x16_bf16(b1,qr[d0],p1,0,0,0);}}
}
typedef __attribute__((address_space(3))) const char* lds_cptr;
typedef short v4i16_t __attribute__((ext_vector_type(4)));
__device__ __forceinline__ void kload8(bf16x8*kf,lds_cptr kp){
  kf[0]=*(const __attribute__((address_space(3))) bf16x8*)(kp);      kf[1]=*(const __attribute__((address_space(3))) bf16x8*)(kp+512);
  kf[2]=*(const __attribute__((address_space(3))) bf16x8*)(kp+2048); kf[3]=*(const __attribute__((address_space(3))) bf16x8*)(kp+2560);
  kf[4]=*(const __attribute__((address_space(3))) bf16x8*)(kp+4096); kf[5]=*(const __attribute__((address_space(3))) bf16x8*)(kp+4608);
  kf[6]=*(const __attribute__((address_space(3))) bf16x8*)(kp+6144); kf[7]=*(const __attribute__((address_space(3))) bf16x8*)(kp+6656);
}
__device__ __forceinline__ void kload2(bf16x8*kf,lds_cptr kp,int j){ kf[2*j]=*(const __attribute__((address_space(3))) bf16x8*)(kp+j*2048); kf[2*j+1]=*(const __attribute__((address_space(3))) bf16x8*)(kp+j*2048+512); }
__device__ __forceinline__ s16x4 vtr(lds_cptr p){ return __builtin_bit_cast(s16x4,__builtin_amdgcn_ds_read_tr16_b64_v4i16((__attribute__((address_space(3))) v4i16_t*)p)); }
__device__ __forceinline__ float rowmax(const f32x16&p0,const f32x16&p1){
  float a=max3f(p0[0],p0[1],p1[0]),b=max3f(p0[2],p0[3],p1[1]);a=max3f(a,p1[2],p1[3]);
  #pragma unroll
  for(int r=4;r<16;r+=4){a=max3f(a,p0[r],p0[r+1]);b=max3f(b,p0[r+2],p0[r+3]);a=max3f(a,p1[r],p1[r+1]);b=max3f(b,p1[r+2],p1[r+3]);}
  const float m=max2f(a,b);
  auto rr=__builtin_amdgcn_permlane32_swap(__float_as_uint(m),__float_as_uint(m),false,false);
  return max2f(__uint_as_float(rr[0]),__uint_as_float(rr[1]));
}
__device__ __forceinline__ void pv(f32x16*o,int vb,bf16x8 pa0,bf16x8 pa1,bf16x8 pa2,bf16x8 pa3){
  #pragma unroll
  for(int d0=0;d0<2;++d0){s16x4 lo[4],hi[4];
    #pragma unroll
    for(int ks=0;ks<4;++ks){
      asm volatile("ds_read_b64_tr_b16 %0,%1 offset:%c2":"=&v"(lo[ks]):"v"(vb),"i"(d0*4096+ks*1024):"memory");
      asm volatile("ds_read_b64_tr_b16 %0,%1 offset:%c2":"=&v"(hi[ks]):"v"(vb),"i"(d0*4096+ks*1024+512):"memory");}
    asm volatile("s_waitcnt lgkmcnt(0)":::"memory");SBAR();
    #define PK(k) (bf16x8){lo[k][0],lo[k][1],lo[k][2],lo[k][3],hi[k][0],hi[k][1],hi[k][2],hi[k][3]}
    o[d0]=__builtin_amdgcn_mfma_f32_32x32x16_bf16(pa0,PK(0),o[d0],0,0,0);
    o[d0]=__builtin_amdgcn_mfma_f32_32x32x16_bf16(pa1,PK(1),o[d0],0,0,0);
    o[d0]=__builtin_amdgcn_mfma_f32_32x32x16_bf16(pa2,PK(2),o[d0],0,0,0);
    o[d0]=__builtin_amdgcn_mfma_f32_32x32x16_bf16(pa3,PK(3),o[d0],0,0,0);
    #undef PK
  }
}

#ifndef ATTN_STORE16
#define ATTN_STORE16(p,v) (*(u32x4*)(p)=(v))
#endif
template<int THRL> __device__ __forceinline__ void attn_unit(int b,int qb,const bf16*Q,const bf16*__restrict__ K,const bf16*__restrict__ V,bf16*O,char*shm){
  int tid_=threadIdx.x; asm volatile("":"+v"(tid_)); const int tid=tid_,lane=tid&63,r32=lane&31,hi=lane>>5; const int wid=__builtin_amdgcn_readfirstlane(tid>>6);
  const long rowbase=(long)b*SEQ; const int q0=qb*QB;
  const bf16*Qw=Q+(rowbase+q0+wid*QBLK)*DM;
  const bf16*Kh=K+rowbase*DM,*Vh=V+rowbase*DM;
  const unsigned lds0=(unsigned)(uintptr_t)shm;
  float*wsf=(float*)(shm+LDS_WS)+wid*64;
  const bf16*ksrc=Kh+(long)lane*DM+wid*8;
  const bf16*vsrc=Vh+(long)(16*(wid&3)+(lane>>2))*DM+(wid>>2)*32+(lane&3)*8;
  const unsigned kdst=lds0+LDS_K+wid*1024, vdst=lds0+LDS_V+wid*1024;
  #define DMA_K(t,slot) glds16(ksrc+(long)(t)*KVBLK*DM,(unsigned)__builtin_amdgcn_readfirstlane(kdst+(slot)))
  #define DMA_V(t,slot) glds16(vsrc+(long)(t)*KVBLK*DM,(unsigned)__builtin_amdgcn_readfirstlane(vdst+(slot)))
  const int vb0=(int)(lds0+LDS_V)+((lane>>4)&1)*32+(lane&3)*8+(4*hi+((lane&15)>>2))*64;
  const char*Kbase=shm+LDS_K; bf16x8 kf[8];
  const lds_cptr shm3=(lds_cptr)shm; const lds_cptr kp0=shm3+LDS_K+hi*1024+r32*16; const lds_cptr vp0=shm3+LDS_V+((lane>>4)&1)*32+(lane&3)*8+(4*hi+((lane&15)>>2))*64;
  const int NT=(q0+QB)/KVBLK;
  DMA_K(0,0);DMA_V(0,0);DMA_K(1,SLOTB);
  bf16x8 qr[4];
  #pragma unroll
  for(int d0=0;d0<4;++d0)qr[d0]=*reinterpret_cast<const bf16x8*>(&Qw[(long)r32*DM+d0*16+hi*8]);
  float mhat=0.f,l_reg=0.f;f32x16 o[2];o[0]=f32x16{};o[1]=f32x16{};f32x16 negm=f32x16{};asm volatile("":"+v"(negm));
  const int qrel=wid*QBLK+r32;
  #define CMASK(P0,P1,t) do{int jb_=(t)-(NT-4); if(jb_>=0)cmask(P0,P1,jb_,qrel,hi);}while(0)
  bool resc=false;
  #define START(P0,P1) do{ const float rm=rowmax(P0,P1); resc=false; \
    { const float dl=rm; mhat=fadd_s(mhat,dl); \
      _Pragma("unroll") for(int r=0;r<16;++r){P0[r]=fsub_s(P0[r],dl);P1[r]=fsub_s(P1[r],dl);} \
      _Pragma("unroll") for(int r=0;r<16;++r)negm[r]=-mhat; asm volatile("":"+v"(negm)); } \
    _Pragma("unroll") for(int r=0;r<16;++r)P0[r]=__builtin_amdgcn_exp2f(P0[r]); }while(0)
  #define RESC() do{ if(resc){ asm volatile("s_waitcnt lgkmcnt(0)":::"memory"); \
      _Pragma("unroll") for(int d_=0;d_<2;++d_) _Pragma("unroll") for(int r=0;r<16;++r)o[d_][r]*=wsf[crow(r,hi)]; } }while(0)
  f32x16 pA0,pA1,pB0,pB1;
  int sl_prev=0,sl_cur=0,sl_next=SLOTB;
  #define ROT() do{sl_prev=sl_cur;sl_cur=sl_next;sl_next=(sl_next==(NSLOT-1)*SLOTB)?0:sl_next+SLOTB;}while(0)
  DMA_K(2,2*SLOTB);
  WAIT_BAR(3);
  qkt(pA0,pA1,Kbase,qr,negm,r32,hi);asm volatile("s_nop 15\n\ts_nop 7":"+v"(pA0),"+v"(pA1));CMASK(pA0,pA1,0);
  START(pA0,pA1);
  _Pragma("unroll") for(int r=0;r<16;++r)pA1[r]=__builtin_amdgcn_exp2f(pA1[r]);
  WAIT_BAR(0);
  DMA_K(3,0);DMA_V(1,SLOTB);
  ROT();
  kload8(kf,kp0+sl_cur);
  WAIT_BAR(2);
  s16x4 vlo[8],vhi[8]; u32x4 pw0,pw1,pw2,pw3;
  #define PKW(P,B) cvtpk_s(P[B],P[B+1])
  #define PAF(k) __builtin_bit_cast(bf16x8,pw##k)
  #define VFR(i) (bf16x8){vlo[i][0],vlo[i][1],vlo[i][2],vlo[i][3],vhi[i][0],vhi[i][1],vhi[i][2],vhi[i][3]}
  #define PIN(x) asm volatile("":"+v"(x))
  #define MX3(a,b,c) __builtin_fmaxf(__builtin_fmaxf((a),(b)),(c))
  #define GAPA(MF,A0,A1,A2,A3,W0,W1,PW) do{ MF; sacc+=A0; sacc+=A1; sacc+=A2; sacc+=A3; PIN(sacc); W0; W1; PIN(PW); SBAR(); }while(0)
  #define EX(v) __builtin_amdgcn_exp2f(v)
  #define GAPB(MF,X,B) do{ MF; X[B]=EX(X[B]); X[B+1]=EX(X[B+1]); X[B+2]=EX(X[B+2]); X[B+3]=EX(X[B+3]); PIN(X); SBAR(); }while(0)
  #define VRD(i) do{ vlo[i]=vtr(vp_+(((i)>>2)*4096+((i)&3)*1024)); vhi[i]=vtr(vp_+(((i)>>2)*4096+((i)&3)*1024+512)); }while(0)
  #define KRD(G,j) do{ if(G){ kload2(kf,kp0+sl_next,j); SBAR(); } }while(0)
  #define STEP(C0,C1,P0,P1,t,GK,GV,GL) do{ SBAR(); \
    const lds_cptr vp_=vp0+sl_prev; \
    VRD(0); SBAR(); float sacc=(P0[0]+P0[1]); \
    GAPA(C0=__builtin_amdgcn_mfma_f32_32x32x16_bf16(kf[0],qr[0],negm,0,0,0), P0[2],P0[3],P0[4],P0[5],     pw0[0]=PKW(P0,0), pw0[1]=PKW(P0,2), pw0); \
    VRD(4); SBAR(); GAPA(C1=__builtin_amdgcn_mfma_f32_32x32x16_bf16(kf[1],qr[0],negm,0,0,0), P0[6],P0[7],P0[8],P0[9],     pw0[2]=PKW(P0,4), pw0[3]=PKW(P0,6), pw0); \
    VRD(1); SBAR(); GAPA(C0=__builtin_amdgcn_mfma_f32_32x32x16_bf16(kf[2],qr[1],C0,0,0,0),   P0[10],P0[11],P0[12],P0[13], pw1[0]=PKW(P0,8), pw1[1]=PKW(P0,10), pw1); \
    VRD(5); SBAR(); GAPA(C1=__builtin_amdgcn_mfma_f32_32x32x16_bf16(kf[3],qr[1],C1,0,0,0),   P0[14],P0[15],P1[0],P1[1],   pw1[2]=PKW(P0,12),pw1[3]=PKW(P0,14), pw1); \
    VRD(2); SBAR(); GAPA(C0=__builtin_amdgcn_mfma_f32_32x32x16_bf16(kf[4],qr[2],C0,0,0,0),   P1[2],P1[3],P1[4],P1[5],     pw2[0]=PKW(P1,0), pw2[1]=PKW(P1,2), pw2); \
    VRD(6); SBAR(); GAPA(C1=__builtin_amdgcn_mfma_f32_32x32x16_bf16(kf[5],qr[2],C1,0,0,0),   P1[6],P1[7],P1[8],P1[9],     pw2[2]=PKW(P1,4), pw2[3]=PKW(P1,6), pw2); \
    VRD(3); SBAR(); GAPA(C0=__builtin_amdgcn_mfma_f32_32x32x16_bf16(kf[6],qr[3],C0,0,0,0),   P1[10],P1[11],P1[12],P1[13], pw3[0]=PKW(P1,8), pw3[1]=PKW(P1,10), pw3); \
    VRD(7); SBAR(); GAPA(C1=__builtin_amdgcn_mfma_f32_32x32x16_bf16(kf[7],qr[3],C1,0,0,0),   P1[14],P1[15],0.f,0.f,       pw3[2]=PKW(P1,12),pw3[3]=PKW(P1,14), pw3); \
    l_reg+=sacc; \
    if(GK){DMA_K((t)+3,sl_cur);} if(GV){DMA_V((t)+1,sl_next);} \
    CMASK(C0,C1,t); \
    { float a=MX3(C0[0],C0[1],C1[0]),b=MX3(C0[2],C0[3],C1[1]); a=MX3(a,C1[2],C1[3]); \
      _Pragma("unroll") for(int r=4;r<16;r+=4){a=MX3(a,C0[r],C0[r+1]);b=MX3(b,C0[r+2],C0[r+3]);a=MX3(a,C1[r],C1[r+1]);b=MX3(b,C1[r+2],C1[r+3]);} \
      float rm=__builtin_fmaxf(a,b); { auto rr=__builtin_amdgcn_permlane32_swap(__float_as_uint(rm),__float_as_uint(rm),false,false); rm=__builtin_fmaxf(__uint_as_float(rr[0]),__uint_as_float(rr[1])); } \
      resc=false; \
      if(__builtin_expect(__any(rm>(float)THRL),0)){ const float dl=__builtin_fmaxf(rm,0.f); mhat+=dl; \
        _Pragma("unroll") for(int r=0;r<16;++r){C0[r]-=dl;C1[r]-=dl;} \
        _Pragma("unroll") for(int r=0;r<16;++r)negm[r]=-mhat; asm volatile("":"+v"(negm)); \
        const float f=__builtin_amdgcn_exp2f(-dl); l_reg*=f; if(hi==0)wsf[r32]=f; resc=true; } } \
    SBAR(); \
    GAPB(o[0]=__builtin_amdgcn_mfma_f32_32x32x16_bf16(PAF(0),VFR(0),o[0],0,0,0), C0,0); \
    GAPB(o[1]=__builtin_amdgcn_mfma_f32_32x32x16_bf16(PAF(0),VFR(4),o[1],0,0,0), C0,4); \
    KRD(GL,0); GAPB(o[0]=__builtin_amdgcn_mfma_f32_32x32x16_bf16(PAF(1),VFR(1),o[0],0,0,0), C0,8); \
    KRD(GL,1); GAPB(o[1]=__builtin_amdgcn_mfma_f32_32x32x16_bf16(PAF(1),VFR(5),o[1],0,0,0), C0,12); \
    KRD(GL,2); GAPB(o[0]=__builtin_amdgcn_mfma_f32_32x32x16_bf16(PAF(2),VFR(2),o[0],0,0,0), C1,0); \
    KRD(GL,3); GAPB(o[1]=__builtin_amdgcn_mfma_f32_32x32x16_bf16(PAF(2),VFR(6),o[1],0,0,0), C1,4); \
    GAPB(o[0]=__builtin_amdgcn_mfma_f32_32x32x16_bf16(PAF(3),VFR(3),o[0],0,0,0), C1,8); \
    GAPB(o[1]=__builtin_amdgcn_mfma_f32_32x32x16_bf16(PAF(3),VFR(7),o[1],0,0,0), C1,12); \
    }while(0)
  int t=1;
  #undef CMASK
  #define CMASK(P0,P1,t) do{}while(0)
  for(;t+5<NT;t+=2){
    STEP(pB0,pB1,pA0,pA1,t,true,true,true);     WAIT_BAR(2); RESC(); ROT();
    STEP(pA0,pA1,pB0,pB1,t+1,true,true,true);   WAIT_BAR(2); RESC(); ROT();
  }
  #undef CMASK
  #define CMASK(P0,P1,t) do{int jb_=(t)-(NT-4); if(jb_>=0)cmask(P0,P1,jb_,qrel,hi);}while(0)
  #define ENDW(tt) do{ if((tt)+3<NT){WAIT_BAR(2);} else if((tt)+2<NT){WAIT_BAR(1);} else {WAIT_BAR(0);} }while(0)
  for(;t+1<NT;t+=2){
    STEP(pB0,pB1,pA0,pA1,t,(t+3<NT),(t+1<NT),(t+1<NT));       ENDW(t);   RESC(); ROT();
    STEP(pA0,pA1,pB0,pB1,t+1,(t+4<NT),(t+2<NT),(t+2<NT));     ENDW(t+1); RESC(); ROT();
  }
  STEP(pB0,pB1,pA0,pA1,NT-1,false,false,false); RESC();
  { float sacc=pB0[0]+pB0[1]; _Pragma("unroll") for(int r=2;r<16;++r)sacc+=pB0[r]; _Pragma("unroll") for(int r=0;r<16;++r)sacc+=pB1[r]; l_reg+=sacc;
    pw0=(u32x4){PKW(pB0,0),PKW(pB0,2),PKW(pB0,4),PKW(pB0,6)};pw1=(u32x4){PKW(pB0,8),PKW(pB0,10),PKW(pB0,12),PKW(pB0,14)};pw2=(u32x4){PKW(pB1,0),PKW(pB1,2),PKW(pB1,4),PKW(pB1,6)};pw3=(u32x4){PKW(pB1,8),PKW(pB1,10),PKW(pB1,12),PKW(pB1,14)};
    SBAR(); pv(o,vb0+sl_cur,PAF(0),PAF(1),PAF(2),PAF(3)); }
  #undef PKW
  #undef PAF
  #undef VFR
  #undef PIN
  #undef MX3
  #undef GAPA
  #undef GAPB
  #undef EX
  #undef VRD
  #undef KRD
  #undef STEP
  #undef ENDW
  {auto rr=__builtin_amdgcn_permlane32_swap(__float_as_uint(l_reg),__float_as_uint(l_reg),false,false);l_reg=__uint_as_float(rr[0])+__uint_as_float(rr[1]);}
  if(hi==0)wsf[32+r32]=l_reg;asm volatile("s_waitcnt lgkmcnt(0)":::"memory");
  float rli[16];
  #pragma unroll
  for(int r=0;r<16;++r)rli[r]=__builtin_amdgcn_rcpf(wsf[32+crow(r,hi)]);
  bf16*Ow=O+(rowbase+q0+wid*QBLK)*DM;
  { bf16*stg=(bf16*)(shm+LDS_OST)+wid*2048;
    #pragma unroll
    for(int r=0;r<16;++r){const int orow=crow(r,hi);
      #pragma unroll
      for(int d0=0;d0<2;++d0)stg[orow*64+d0*32+r32]=__float2bfloat16(o[d0][r]*rli[r]);}
    asm volatile("s_waitcnt lgkmcnt(0)":::"memory");
    #pragma unroll
    for(int i=0;i<4;++i){const int row=i*8+(lane>>3),ch=lane&7; const u32x4 v=*(const u32x4*)(stg+row*64+ch*8); ATTN_STORE16(Ow+(long)row*DM+ch*8,v);} }
  asm volatile("s_waitcnt lgkmcnt(0)\n\ts_barrier":::"memory");
  #undef DMA_K
  #undef DMA_V
  #undef CMASK
  #undef START
  #undef RESC
  #undef ROT
}
constexpr int ATTN_LDS_BYTES=LDS_BYTES;
#undef SBAR
#undef WAIT_BAR
}


#ifndef MOE_F8
#define MOE_F8 1
#endif
constexpr int NWAVES = 8;
constexpr int NB = 16, S = 2048, D = 1024, T = NB * S;
constexpr int NL = 4, NE = 32, TOPK = 4;
constexpr int SLOT_ROWS = T * TOPK + NE * 256;
constexpr int MODC = 6 * D * NL + 2 * D + 2 * D;
constexpr int MOD_KV = 6 * D * NL, MOD_FIN = MOD_KV + 2 * D;
constexpr float EPS = 1e-5f;
constexpr float QSCALE = 0.125f * 1.4426950408889634f;
constexpr size_t MiB = 1u << 20;
constexpr size_t WS_CTL = 0, CTL_ZERO_BYTES = 1 * MiB;
constexpr size_t WS_MOD = 4 * MiB;
constexpr size_t WS_ROPE = 6 * MiB;
constexpr size_t WS_RFRAG = 7 * MiB;
constexpr size_t WS_TKE = 8 * MiB, WS_TKW = WS_TKE + 512 * 1024, WS_TKL = WS_TKW + 512 * 1024, WS_SLOT = WS_TKL + 512 * 1024;
constexpr size_t WS_WGCNT = 10 * MiB, WS_TEXP = WS_WGCNT + 64 * 1024, WS_NT = WS_TEXP + 64 * 1024;
constexpr size_t WS_ROWTOK = 11 * MiB;
constexpr size_t WS_WQKV = 16 * MiB, WS_AWO = 28 * MiB, WS_KVW = 32 * MiB, WS_BWQ = 36 * MiB, WS_BWO = 48 * MiB;
constexpr size_t WS_WGU = 64 * MiB, WS_WDN = 576 * MiB;
constexpr size_t WS_X = 832 * MiB, WS_H = 960 * MiB, WS_Q = 1024 * MiB, WS_KVSH = 1216 * MiB, WS_O = 1344 * MiB, WS_OP = 1408 * MiB, WS_LSE = 1600 * MiB, WS_HKV = 1608 * MiB;
constexpr size_t WS_HS = 1672 * MiB, WS_ACT = 1944 * MiB, WS_Y = 2216 * MiB, WS_END = 2488 * MiB;
constexpr int CW_BAR = 4096;
constexpr int RING_BYTES = 131072;
constexpr int MISC_OFF = RING_BYTES;
constexpr int HIST_OFF = MISC_OFF + 256, TEXP_OFF = MISC_OFF + 1024, ROWTAB_OFF = MISC_OFF + 8192;
constexpr int LDS_BYTES = 163840;

#define GAS __attribute__((address_space(1)))
#define LAS __attribute__((address_space(3)))
typedef unsigned short bf16;
typedef unsigned v4u __attribute__((ext_vector_type(4)));
typedef unsigned v2u __attribute__((ext_vector_type(2)));
typedef float f32x4 __attribute__((ext_vector_type(4)));
typedef float f32x16 __attribute__((ext_vector_type(16)));
typedef short bf16x8 __attribute__((ext_vector_type(8)));
typedef short s16x4 __attribute__((ext_vector_type(4)));
#define RLX_AGENT __ATOMIC_RELAXED, __HIP_MEMORY_SCOPE_AGENT
#define LDS_WAIT() asm volatile("s_waitcnt lgkmcnt(0)" ::: "memory")
#define VM_WAIT() asm volatile("s_waitcnt vmcnt(0)" ::: "memory")
__device__ __forceinline__ unsigned f2bf(float f) { unsigned u = __builtin_bit_cast(unsigned, f); return (u + 0x7fffu + ((u >> 16) & 1u)) >> 16; }
__device__ __forceinline__ float bf2f(unsigned b) { return __builtin_bit_cast(float, b << 16); }
__device__ __forceinline__ unsigned pk2(float lo, float hi) { return f2bf(lo) | (f2bf(hi) << 16); }
__device__ __forceinline__ f32x4 unpack4(v2u r) { return (f32x4){bf2f(r.x & 0xffffu), bf2f(r.x >> 16), bf2f(r.y & 0xffffu), bf2f(r.y >> 16)}; }
__device__ __forceinline__ float wave_sum(float v) {
#pragma unroll
    for (int o = 1; o < 64; o <<= 1) v += __shfl_xor(v, o);
    return v;
}
__device__ __forceinline__ float dot4(f32x4 a) { return (a.x * a.x + a.y * a.y) + (a.z * a.z + a.w * a.w); }
#define XB_TMO      128
#define XB_XCNT(j)  (256  + 64 * (j))
#define XB_XSUB(j)  (1280 + 64 * (j))
#define XB_XGEN(j)  (2304 + 64 * (j))
#define XB_TOP      3328
#define XB_TOPGEN   3392
#define XCD_BAR_WORDS 3456
#define XB_SPIN_CAP (1u << 22)

__device__ __forceinline__ unsigned xb_ld(unsigned* p)              { return __hip_atomic_load(p, __ATOMIC_RELAXED, __HIP_MEMORY_SCOPE_AGENT); }
__device__ __forceinline__ unsigned xb_add(unsigned* p, unsigned v) { return __hip_atomic_fetch_add(p, v, __ATOMIC_RELAXED, __HIP_MEMORY_SCOPE_AGENT); }
__device__ __forceinline__ unsigned xb_xcc_id() { return (unsigned)__builtin_amdgcn_s_getreg((3 << 11) | 20) & 0xFu; }
#define XB_SPIN(cond, bar) do { unsigned _sp = 0; while (cond) { __builtin_amdgcn_s_sleep(1); \
    if ((++_sp & 255u) == 0u) { if (xb_ld(&(bar)[XB_TMO])) break; if (_sp > XB_SPIN_CAP) { atomicAdd(&(bar)[XB_TMO], 1u); break; } } } } while (0)

struct XcdBarrier {
    unsigned* bar; unsigned x;
    volatile LAS unsigned* st;
};

__device__ __forceinline__ XcdBarrier xcd_barrier_post(unsigned* bar, volatile LAS unsigned* st) {
    XcdBarrier b; b.bar = bar; b.x = xb_xcc_id(); b.st = st;
    if (threadIdx.x == 0) (void)xb_add(&bar[XB_XCNT(b.x)], 1u);
    return b;
}
__device__ __forceinline__ void xcd_barrier_complete(unsigned* bar, unsigned x, unsigned& nloc, unsigned& nx) {
    const unsigned G = gridDim.x * gridDim.y * gridDim.z;
    unsigned sum, cnt, mine, sp = 0u;
    for (;;) {
        sum = 0u; cnt = 0u; mine = 0u;
#pragma unroll
        for (unsigned j = 0; j < 16; ++j) { const unsigned c = xb_ld(&bar[XB_XCNT(j)]); sum += c; cnt += (c > 0u) ? 1u : 0u; mine = (j == x) ? c : mine; }
        if (sum == G) break;
        __builtin_amdgcn_s_sleep(1);
        if ((++sp & 255u) == 0u) { if (xb_ld(&bar[XB_TMO])) break; if (sp > XB_SPIN_CAP) { atomicAdd(&bar[XB_TMO], 1u); break; } }
    }
    nloc = mine > 0u ? mine : 1u; nx = cnt > 0u ? cnt : 1u;
}

__device__ __forceinline__ void xcd_barrier(const XcdBarrier& b) {
    asm volatile("s_waitcnt vmcnt(0)" ::: "memory");
    __syncthreads();
    if (threadIdx.x == 0) {
        unsigned* bar = b.bar;
        __builtin_amdgcn_s_waitcnt(0);
        unsigned nloc = b.st[0], nx = b.st[1];
        if (nloc == 0u) { xcd_barrier_complete(bar, b.x, nloc, nx); b.st[0] = nloc; b.st[1] = nx; }
        const unsigned old = xb_add(&bar[XB_XSUB(b.x)], 1u);
        const unsigned gen = old / nloc;
        if (old + 1u == (gen + 1u) * nloc) {
            __builtin_amdgcn_fence(__ATOMIC_RELEASE, "agent");
            asm volatile("s_waitcnt vmcnt(0)" ::: "memory");
            const unsigned og = xb_add(&bar[XB_TOP], 1u);
            const unsigned tg = og / nx;
            if (og + 1u == (tg + 1u) * nx) xb_add(&bar[XB_TOPGEN], 1u);
            else XB_SPIN(xb_ld(&bar[XB_TOPGEN]) == tg, bar);
            __builtin_amdgcn_fence(__ATOMIC_ACQUIRE, "agent");
            xb_add(&bar[XB_XGEN(b.x)], 1u);
            asm volatile("s_waitcnt vmcnt(0)" ::: "memory");
        } else {
            XB_SPIN(xb_ld(&bar[XB_XGEN(b.x)]) == gen, bar);
            __builtin_amdgcn_fence(__ATOMIC_ACQUIRE, "agent");
            asm volatile("s_waitcnt vmcnt(0)" ::: "memory");
        }
    }
    __syncthreads();
}

struct Args { const float* in[25]; float* out; unsigned char* ws; float invf[8]; float lam_init[2]; int ph_lo, ph_hi, use_bar, pad; };
enum { I_X = 0, I_C, I_MODW, I_MODB, I_MIXN, I_FFNN, I_AWQKV, I_AWO, I_ALAM, I_ASUBLN, I_KVN, I_KVMODW, I_KVMODB, I_KVW, I_BWQ, I_BWO, I_RW, I_RB, I_WGU, I_BGU, I_WDN, I_BDN, I_FINN, I_FINMODW, I_FINMODB };
struct Frame { LAS unsigned char* lds; int tid, lane, wave, G, gw, NGW, bid; };
typedef const __attribute__((address_space(4))) Args* ArgsP;

__device__ __forceinline__ void p0_transpose_item(const float* W, int N, int K, bf16* WT, int dst_row0, LAS float* scr, int k0, int n0, int lane) {
#pragma unroll 8
    for (int i = 0; i < 32; ++i) { const int kk = 2 * i + (lane >> 5); scr[kk * 33 + (lane & 31)] = W[(size_t)(k0 + kk) * N + n0 + (lane & 31)]; }
    LDS_WAIT(); asm volatile("" ::: "memory");
    const int c = lane & 7;
#pragma unroll
    for (int j = 0; j < 4; ++j) { const int n = (lane >> 3) + 8 * j; const LAS float* s = scr + (8 * c) * 33 + n;
        v4u o; o.x = pk2(s[0 * 33], s[1 * 33]); o.y = pk2(s[2 * 33], s[3 * 33]); o.z = pk2(s[4 * 33], s[5 * 33]); o.w = pk2(s[6 * 33], s[7 * 33]);
        *(GAS v4u*)(WT + (size_t)(dst_row0 + n) * K + k0 + 8 * c) = o; }
    LDS_WAIT(); asm volatile("" ::: "memory");
}
__device__ __forceinline__ void p0_transpose_item_f8(const float* W, int N, int K, unsigned char* WT, int dst_row0, LAS float* scr, int k0, int n0, int lane) {
#pragma unroll 8
    for (int i = 0; i < 32; ++i) { const int kk = 2 * i + (lane >> 5); scr[kk * 33 + (lane & 31)] = W[(size_t)(k0 + kk) * N + n0 + (lane & 31)]; }
    LDS_WAIT(); asm volatile("" ::: "memory");
    const int c = lane & 3;
#pragma unroll
    for (int j = 0; j < 2; ++j) { const int n = (lane >> 2) + 16 * j; const LAS float* s = scr + (16 * c) * 33 + n; v4u o;
        o.x = pg8::pk4_fp8(s[0 * 33] * 256.f, s[1 * 33] * 256.f, s[2 * 33] * 256.f, s[3 * 33] * 256.f); o.y = pg8::pk4_fp8(s[4 * 33] * 256.f, s[5 * 33] * 256.f, s[6 * 33] * 256.f, s[7 * 33] * 256.f);
        o.z = pg8::pk4_fp8(s[8 * 33] * 256.f, s[9 * 33] * 256.f, s[10 * 33] * 256.f, s[11 * 33] * 256.f); o.w = pg8::pk4_fp8(s[12 * 33] * 256.f, s[13 * 33] * 256.f, s[14 * 33] * 256.f, s[15 * 33] * 256.f);
        *(GAS v4u*)(WT + (size_t)(dst_row0 + n) * K + k0 + 16 * c) = o; }
    LDS_WAIT(); asm volatile("" ::: "memory");
}
__device__ __forceinline__ void p0_prologue(const Frame& F, ArgsP ap) {
    unsigned char* ws = ap->ws;
    {
        LAS float* cT = (LAS float*)F.lds;
        LAS float* red = (LAS float*)(F.lds + 65536);
        const float* c = ap->in[I_C];
        for (int idx = F.tid; idx < NB * D; idx += NWAVES * 64) { const int b = idx >> 10, k = idx & 1023; const float v = c[idx]; cT[k * 16 + b] = v / (1.0f + __expf(-v)); }
        __syncthreads();
        float* modall = (float*)(ws + WS_MOD);
        for (int g = F.bid; g < MODC / 64; g += F.G) {
            const int cg0 = g * 64; const float* W; const float* bias; int N, col0;
            if (cg0 < MOD_KV) { const int l = cg0 / (6 * D); col0 = cg0 % (6 * D); W = ap->in[I_MODW] + (size_t)l * D * 6 * D; N = 6 * D; bias = ap->in[I_MODB] + l * 6 * D + col0; }
            else if (cg0 < MOD_FIN) { col0 = cg0 - MOD_KV; W = ap->in[I_KVMODW]; N = 2 * D; bias = ap->in[I_KVMODB] + col0; }
            else { col0 = cg0 - MOD_FIN; W = ap->in[I_FINMODW]; N = 2 * D; bias = ap->in[I_FINMODB] + col0; }
            float acc[16];
#pragma unroll
            for (int b = 0; b < 16; ++b) acc[b] = 0.f;
            const float* wp = W + (size_t)(F.wave * 128) * N + col0 + F.lane;
#pragma unroll 8
            for (int kk = 0; kk < 128; ++kk) { const float w = wp[(size_t)kk * N]; const LAS f32x4* cv = (const LAS f32x4*)(cT + (F.wave * 128 + kk) * 16);
                const f32x4 c0 = cv[0], c1 = cv[1], c2 = cv[2], c3 = cv[3];
                acc[0] += w * c0.x; acc[1] += w * c0.y; acc[2] += w * c0.z; acc[3] += w * c0.w; acc[4] += w * c1.x; acc[5] += w * c1.y; acc[6] += w * c1.z; acc[7] += w * c1.w;
                acc[8] += w * c2.x; acc[9] += w * c2.y; acc[10] += w * c2.z; acc[11] += w * c2.w; acc[12] += w * c3.x; acc[13] += w * c3.y; acc[14] += w * c3.z; acc[15] += w * c3.w; }
#pragma unroll
            for (int b = 0; b < 16; ++b) red[(F.wave * 16 + b) * 64 + F.lane] = acc[b];
            __syncthreads();
            for (int o = F.tid; o < 1024; o += NWAVES * 64) { const int b = o >> 6, ln = o & 63; float s = bias[ln];
#pragma unroll
                for (int w = 0; w < 8; ++w) s += red[(w * 16 + b) * 64 + ln];
                modall[(size_t)b * MODC + cg0 + ln] = s; }
            __syncthreads();
        }
        __syncthreads();
    }
    {
        const int gt = F.bid * (NWAVES * 64) + F.tid, NT_ = F.G * NWAVES * 64;
        float* cosT = (float*)(ws + WS_ROPE); float* sinT = cosT + S * 8;
        for (int idx = gt; idx < S * 8; idx += NT_) { const int pos = idx >> 3, i = idx & 7; float inv = ap->invf[0];
#pragma unroll
            for (int q = 1; q < 8; ++q) inv = (i == q) ? ap->invf[q] : inv;
            const float angf = (float)pos * inv; const double x = (double)angf; const double n = __builtin_rint(x * 0.15915494309189533577); const double r = x - n * 6.283185307179586476925; const double r2 = r * r;
            double sn = 1.0, cs = 1.0;
#pragma unroll
            for (int q = 14; q >= 1; --q) { sn = 1.0 - sn * r2 / (double)((2 * q) * (2 * q + 1)); cs = 1.0 - cs * r2 / (double)((2 * q - 1) * (2 * q)); }
            sn *= r; cosT[idx] = (float)cs; sinT[idx] = (float)sn; }
        bf16* rfrag = (bf16*)(ws + WS_RFRAG); const float* rw = ap->in[I_RW];
        for (int idx = gt; idx < NL * 32 * 2 * 64 * 8; idx += NT_) { const int j = idx & 7, lane = (idx >> 3) & 63, nb = (idx >> 9) & 1, s = (idx >> 10) & 31, l = idx >> 15;
            const float w = rw[((size_t)l * D + 32 * s + 8 * (lane >> 4) + j) * NE + 16 * nb + (lane & 15)]; const unsigned hi = f2bf(w), lo = f2bf(w - bf2f(hi));
            const size_t base = ((((size_t)l * 32 + s) * 2 + nb) * 2) * 512 + lane * 8 + j; rfrag[base] = (bf16)hi; rfrag[base + 512] = (bf16)lo; }
    }
    {
        LAS float* scr = (LAS float*)(F.lds + F.wave * 16384);
        constexpr int I_QKV = 16 * 96, I_SQ = 16 * 32, I_KV = 16 * 64, I_GU = 16 * 64, I_DN = 16 * 32;
        constexpr int E0 = 2 * I_QKV, E1 = E0 + 2 * I_SQ, E2 = E1 + I_KV, E3 = E2 + 2 * I_QKV, E4 = E3 + 2 * I_SQ, E5 = E4 + NL * NE * I_GU, E6 = E5 + NL * NE * I_DN;
        for (int it = F.gw; it < E6; it += F.NGW) {
            const float* W; bf16* WT; int N, r, per; bool gu = false;
            if (it < E0) { r = it; per = I_QKV; N = 3 * D; W = ap->in[I_AWQKV]; WT = (bf16*)(ws + WS_WQKV); }
            else if (it < E1) { r = it - E0; per = I_SQ; N = D; W = ap->in[I_AWO]; WT = (bf16*)(ws + WS_AWO); }
            else if (it < E2) { r = it - E1; per = I_KV; N = 2 * D; W = ap->in[I_KVW]; WT = (bf16*)(ws + WS_KVW); }
            else if (it < E3) { r = it - E2; per = I_QKV; N = 3 * D; W = ap->in[I_BWQ]; WT = (bf16*)(ws + WS_BWQ); }
            else if (it < E4) { r = it - E3; per = I_SQ; N = D; W = ap->in[I_BWO]; WT = (bf16*)(ws + WS_BWO); }
            else if (it < E5) { r = it - E4; per = I_GU; N = 2 * D; W = ap->in[I_WGU]; WT = (bf16*)(ws + WS_WGU); gu = true; }
            else { r = it - E5; per = I_DN; N = D; W = ap->in[I_WDN]; WT = (bf16*)(ws + WS_WDN); }
            const int mat = r / per, item = r % per, nblk = N / 32, kb = item / nblk, nb = item % nblk, n0 = 32 * nb;
            int drow = n0; if (gu) { const int half = n0 >> 10, rem = n0 & 1023; drow = (rem >> 7) * 256 + half * 128 + (rem & 127); }
            if (MOE_F8 && it >= E4) p0_transpose_item_f8(W + (size_t)mat * D * N, N, D, (unsigned char*)WT + (size_t)mat * N * D, drow, scr, 64 * kb, n0, F.lane);
            else p0_transpose_item(W + (size_t)mat * D * N, N, D, WT + (size_t)mat * N * D, drow, scr, 64 * kb, n0, F.lane);
        }
    }
}

struct ModVec { f32x4 a[4], b[4]; };
__device__ __forceinline__ void load_modvec(ModVec& mv, const float* gain, const float* scale, const float* shift, int lane) {
#pragma unroll
    for (int j = 0; j < 4; ++j) { const int c = 4 * lane + 256 * j; const f32x4 g = *(const f32x4*)(gain + c), sc = *(const f32x4*)(scale + c); mv.a[j] = g * (sc + 1.0f); mv.b[j] = *(const f32x4*)(shift + c); }
}
__device__ __forceinline__ void store_bf16_row(bf16* orow, const f32x4 (&v)[4], int lane) {
#pragma unroll
    for (int j = 0; j < 4; ++j) { v2u w; w.x = pk2(v[j].x, v[j].y); w.y = pk2(v[j].z, v[j].w); *(v2u*)(orow + 4 * lane + 256 * j) = w; }
}
__device__ __forceinline__ void phase_modulate0(const Frame& F, const float* x, const float* gain, const float* modall, int sh_col, int sc_col, bf16* h) {
    for (int task = F.gw; task < T / 16; task += F.NGW) {
        const int r0 = task * 16, b = r0 >> 11; ModVec mv; load_modvec(mv, gain, modall + (size_t)b * MODC + sc_col, modall + (size_t)b * MODC + sh_col, F.lane);
        for (int i = 0; i < 16; ++i) { const float* xr = x + (size_t)(r0 + i) * D; f32x4 v[4]; float ss = 0.f;
#pragma unroll
            for (int j = 0; j < 4; ++j) { v[j] = *(const f32x4*)(xr + 4 * F.lane + 256 * j); ss += dot4(v[j]); }
            const float rstd = 1.0f / sqrtf(wave_sum(ss) * (1.0f / D) + EPS);
#pragma unroll
            for (int j = 0; j < 4; ++j) v[j] = v[j] * rstd * mv.a[j] + mv.b[j];
            store_bf16_row(h + (size_t)(r0 + i) * D, v, F.lane); }
    }
}
__device__ __forceinline__ void phase_subln(const Frame& F, const bf16* OP, const float* lamv  , const float* subln  , float lam_init, bf16* O) {
    float lam; { const float p1 = wave_sum(lamv[F.lane] * lamv[64 + F.lane]), p2 = wave_sum(lamv[128 + F.lane] * lamv[192 + F.lane]); lam = __expf(p1) - __expf(p2) + lam_init; }
    const f32x4 gsub = *(const f32x4*)(subln + ((4 * F.lane) & 127)) * (1.0f - lam_init);
    for (int task = F.gw; task < T / 16; task += F.NGW) {
        for (int i = 0; i < 16; ++i) { const size_t ro = (size_t)(task * 16 + i) * D; f32x4 v[4];
#pragma unroll
            for (int j = 0; j < 4; ++j) { const int c = 4 * F.lane + 256 * j; const f32x4 o0 = unpack4(*(const v2u*)(OP + ro + c)), o1 = unpack4(*(const v2u*)(OP + (size_t)T * D + ro + c));
                v[j] = o0 - o1 * lam; float ss = dot4(v[j]);
#pragma unroll
                for (int o = 1; o < 32; o <<= 1) ss += __shfl_xor(ss, o);
                v[j] = v[j] * (1.0f / sqrtf(ss * (1.0f / 128.0f) + EPS)) * gsub; }
            store_bf16_row(O + ro, v, F.lane); }
    }
}
__device__ __forceinline__ void phase_merge(const Frame& F, const bf16* OG, const float* LSE, bf16* O) {
    for (int task = F.gw; task < T / 16; task += F.NGW) {
        for (int i = 0; i < 16; ++i) { const int row = task * 16 + i; const size_t ro = (size_t)row * D; f32x4 v[4];
#pragma unroll
            for (int j = 0; j < 4; ++j) { const int c = 4 * F.lane + 256 * j, head = c >> 6;
                const float l0 = LSE[(size_t)row * 16 + head], l1 = LSE[(size_t)T * 16 + (size_t)row * 16 + head], l2 = LSE[(size_t)2 * T * 16 + (size_t)row * 16 + head];
                const float mx = fmaxf(l0, fmaxf(l1, l2)); const float a0 = __builtin_amdgcn_exp2f(l0 - mx), a1 = __builtin_amdgcn_exp2f(l1 - mx), a2 = __builtin_amdgcn_exp2f(l2 - mx); const float inv = 1.0f / (a0 + a1 + a2);
                const f32x4 o0 = unpack4(*(const v2u*)(OG + ro + c)), o1 = unpack4(*(const v2u*)(OG + (size_t)T * D + ro + c)), o2 = unpack4(*(const v2u*)(OG + (size_t)2 * T * D + ro + c));
                v[j] = (o0 * a0 + o1 * a1 + o2 * a2) * inv; }
            store_bf16_row(O + ro, v, F.lane); }
    }
}
__device__ __forceinline__ void phase_mod2_router(const Frame& F, const float* x, const float* gain, const float* modall, int sh_col, int sc_col, const bf16* rfrag, const float* rb,
                                                  bf16* h2, int* tk_e, float* tk_w, int* tk_l, int* wgcnt) {
    LAS int* hist = (LAS int*)(F.lds + HIST_OFF);
    if (F.tid < NE) hist[F.tid] = 0;
    __syncthreads();
    const int r = F.lane & 15, kq = F.lane >> 4;
    for (int task = F.gw; task < T / 16; task += F.NGW) {
        const int r0 = task * 16, b = r0 >> 11; const float* xr = x + (size_t)(r0 + r) * D + 8 * kq;
        float ss = 0.f;
#pragma unroll 8
        for (int s = 0; s < 32; ++s) ss += dot4(*(const f32x4*)(xr + 32 * s)) + dot4(*(const f32x4*)(xr + 32 * s + 4));
        ss += __shfl_xor(ss, 16); ss += __shfl_xor(ss, 32);
        const float rstd = 1.0f / sqrtf(ss * (1.0f / D) + EPS);
        const float* gp = gain + 8 * kq; const float* scp = modall + (size_t)b * MODC + sc_col + 8 * kq; const float* shp = modall + (size_t)b * MODC + sh_col + 8 * kq;
        bf16* hr = h2 + (size_t)(r0 + r) * D + 8 * kq;
        f32x4 acc0 = (f32x4){0.f, 0.f, 0.f, 0.f}, acc1 = acc0;
#pragma unroll 4
        for (int s = 0; s < 32; ++s) {
            const f32x4 xa = *(const f32x4*)(xr + 32 * s), xb = *(const f32x4*)(xr + 32 * s + 4);
            const f32x4 ga = *(const f32x4*)(gp + 32 * s), gb = *(const f32x4*)(gp + 32 * s + 4), sa = *(const f32x4*)(scp + 32 * s), sb = *(const f32x4*)(scp + 32 * s + 4), ha = *(const f32x4*)(shp + 32 * s), hb = *(const f32x4*)(shp + 32 * s + 4);
            const f32x4 va = xa * rstd * ga * (sa + 1.0f) + ha, vb = xb * rstd * gb * (sb + 1.0f) + hb;
            bf16x8 Ahi, Alo;
#pragma unroll
            for (int j = 0; j < 4; ++j) { const unsigned h0 = f2bf(va[j]), h1 = f2bf(vb[j]); Ahi[j] = (short)h0; Ahi[4 + j] = (short)h1; Alo[j] = (short)f2bf(va[j] - bf2f(h0)); Alo[4 + j] = (short)f2bf(vb[j] - bf2f(h1)); }
            if (MOE_F8) { v2u w8; w8.x = pg8::pk4_fp8(va[0], va[1], va[2], va[3]); w8.y = pg8::pk4_fp8(vb[0], vb[1], vb[2], vb[3]); *(v2u*)((unsigned char*)h2 + (size_t)(r0 + r) * D + 8 * kq + 32 * s) = w8; }
            else *(bf16x8*)(hr + 32 * s) = Ahi;
            const bf16* fp = rfrag + (size_t)s * 2048 + F.lane * 8;
            const bf16x8 Bh0 = *(const bf16x8*)(fp), Bl0 = *(const bf16x8*)(fp + 512), Bh1 = *(const bf16x8*)(fp + 1024), Bl1 = *(const bf16x8*)(fp + 1536);
            acc0 = __builtin_amdgcn_mfma_f32_16x16x32_bf16(Ahi, Bh0, acc0, 0, 0, 0); acc0 = __builtin_amdgcn_mfma_f32_16x16x32_bf16(Alo, Bh0, acc0, 0, 0, 0); acc0 = __builtin_amdgcn_mfma_f32_16x16x32_bf16(Ahi, Bl0, acc0, 0, 0, 0);
            acc1 = __builtin_amdgcn_mfma_f32_16x16x32_bf16(Ahi, Bh1, acc1, 0, 0, 0); acc1 = __builtin_amdgcn_mfma_f32_16x16x32_bf16(Alo, Bh1, acc1, 0, 0, 0); acc1 = __builtin_amdgcn_mfma_f32_16x16x32_bf16(Ahi, Bl1, acc1, 0, 0, 0);
        }
        const float b0 = rb[r], b1 = rb[16 + r];
#pragma unroll
        for (int reg = 0; reg < 4; ++reg) {
            float v0 = acc0[reg] + b0, v1 = acc1[reg] + b1; float tv[4]; int te[4];
#pragma unroll
            for (int k = 0; k < 4; ++k) {
                float bv = (v0 >= v1) ? v0 : v1; int be = (v0 >= v1) ? r : 16 + r;
#pragma unroll
                for (int o = 1; o < 16; o <<= 1) { const float ov = __shfl_xor(bv, o); const int oe = __shfl_xor(be, o); if (ov > bv || (ov == bv && oe < be)) { bv = ov; be = oe; } }
                tv[k] = bv; te[k] = be; if (be == r) v0 = -INFINITY; if (be == 16 + r) v1 = -INFINITY;
            }
            const float p1 = __expf(tv[1] - tv[0]), p2 = __expf(tv[2] - tv[0]), p3 = __expf(tv[3] - tv[0]); const float inv = 1.0f / (1.0f + p1 + p2 + p3);
            if (r == 0) { const int row = r0 + 4 * kq + reg; const float pw[4] = {inv, p1 * inv, p2 * inv, p3 * inv};
#pragma unroll
                for (int k = 0; k < 4; ++k) { tk_e[row * 4 + k] = te[k]; tk_w[row * 4 + k] = pw[k]; tk_l[row * 4 + k] = __hip_atomic_fetch_add(hist + te[k], 1, __ATOMIC_RELAXED, __HIP_MEMORY_SCOPE_WORKGROUP); } }
        }
    }
    __syncthreads();
    if (F.tid < NE) wgcnt[F.bid * NE + F.tid] = hist[F.tid];
}
__device__ __forceinline__ void phase_scatter(const Frame& F, const int* wgcnt, const int* tk_e, const int* tk_l, int* slot_of, int* rowtok, int* texp, unsigned* ntiles) {
    LAS int* cnt = (LAS int*)F.lds; LAS int* tot = (LAS int*)(F.lds + 65536); LAS int* bas = tot + 32; LAS int* eoff = tot + 64;
    for (int i = F.tid; i < F.G * NE; i += NWAVES * 64) cnt[i] = wgcnt[i];
    __syncthreads();
    if (F.tid < NE) { int t = 0, bs = 0; for (int w = 0; w < F.G; ++w) { const int c = cnt[w * NE + F.tid]; bs += (w < F.bid) ? c : 0; t += c; } tot[F.tid] = t; bas[F.tid] = bs; }
    __syncthreads();
    if (F.tid == 0) { int off = 0; for (int e = 0; e < NE; ++e) { eoff[e] = off; off += (tot[e] + 255) & ~255; } eoff[NE] = off; }
    __syncthreads();
    if (F.bid == 0) { if (F.tid < NE) { for (int pm = eoff[F.tid] >> 8; pm < (eoff[F.tid + 1] >> 8); ++pm) texp[pm] = F.tid; } if (F.tid == 0) __hip_atomic_store(ntiles, (unsigned)(eoff[NE] >> 8), RLX_AGENT);
        for (int e = 0; e < NE; ++e) for (int sl = eoff[e] + tot[e] + F.tid; sl < eoff[e + 1]; sl += NWAVES * 64) rowtok[sl] = 0; }
    for (int task = F.gw; task < T / 16; task += F.NGW) {
        const int r0 = task * 16, row = r0 + (F.lane >> 2); const int idx = row * 4 + (F.lane & 3);
        const int e = tk_e[idx], slot = eoff[e] + bas[e] + tk_l[idx]; slot_of[idx] = slot; rowtok[slot] = row;
    }
}
__device__ __forceinline__ void phase_combine(const Frame& F, float* x, const bf16* Y, const int* slot_of, const float* tk_w, const float* g2base  , int mode,
                                              const float* gainA, const float* modall, int shA, int scA, bf16* h, const float* gainB, int shB, int scB, bf16* hkv, float* out) {
    for (int task = F.gw; task < T / 16; task += F.NGW) {
        const int r0 = task * 16, b = r0 >> 11; ModVec mv, mk; f32x4 g2[4];
        load_modvec(mv, gainA, modall + (size_t)b * MODC + scA, modall + (size_t)b * MODC + shA, F.lane);
        if (mode == 1) load_modvec(mk, gainB, modall + (size_t)b * MODC + scB, modall + (size_t)b * MODC + shB, F.lane);
#pragma unroll
        for (int j = 0; j < 4; ++j) g2[j] = *(const f32x4*)(g2base + (size_t)b * MODC + 4 * F.lane + 256 * j);
        const int myslot = slot_of[r0 * 4 + F.lane]; const float myw = tk_w[r0 * 4 + F.lane];
        for (int i = 0; i < 16; ++i) { const size_t ro = (size_t)(r0 + i) * D; f32x4 acc[4];
#pragma unroll
            for (int j = 0; j < 4; ++j) acc[j] = (f32x4){0.f, 0.f, 0.f, 0.f};
#pragma unroll
            for (int k = 0; k < 4; ++k) { const int sl = __shfl(myslot, i * 4 + k); const float w = __shfl(myw, i * 4 + k); const bf16* yr = Y + (size_t)sl * D;
#pragma unroll
                for (int j = 0; j < 4; ++j) acc[j] += unpack4(*(const v2u*)(yr + 4 * F.lane + 256 * j)) * w; }
            f32x4 v[4]; float ss = 0.f;
#pragma unroll
            for (int j = 0; j < 4; ++j) { v[j] = *(const f32x4*)(x + ro + 4 * F.lane + 256 * j) + g2[j] * acc[j]; ss += dot4(v[j]); }
            if (mode != 2) {
#pragma unroll
                for (int j = 0; j < 4; ++j) *(f32x4*)(x + ro + 4 * F.lane + 256 * j) = v[j]; }
            const float rstd = 1.0f / sqrtf(wave_sum(ss) * (1.0f / D) + EPS);
            if (mode == 2) {
#pragma unroll
                for (int j = 0; j < 4; ++j) *(f32x4*)(out + ro + 4 * F.lane + 256 * j) = v[j] * rstd * mv.a[j] + mv.b[j];
            } else {
                f32x4 o[4];
#pragma unroll
                for (int j = 0; j < 4; ++j) o[j] = v[j] * rstd * mv.a[j] + mv.b[j];
                store_bf16_row(h + ro, o, F.lane);
                if (mode == 1) {
#pragma unroll
                    for (int j = 0; j < 4; ++j) o[j] = v[j] * rstd * mk.a[j] + mk.b[j];
                    store_bf16_row(hkv + ro, o, F.lane); }
            }
        }
    }
}

__device__ __forceinline__ int crow16(int i, int h) { return (i & 3) + 8 * (i >> 2) + 4 * h; }
struct DilTile { bf16x8 kf[4]; v4u vv[4]; };
__device__ __forceinline__ void dil_load(DilTile& t, const bf16* KV, int rowbase, int res, int dsh, int kv0, int head, int lane) {
    const int r = lane & 31, h = lane >> 5; const bf16* kp = KV + (size_t)(rowbase + res + ((kv0 + r) << dsh)) * (2 * D) + head * 64 + 8 * h;
#pragma unroll
    for (int ds = 0; ds < 4; ++ds) t.kf[ds] = *(const bf16x8*)(kp + 16 * ds);
#pragma unroll
    for (int i = 0; i < 4; ++i) { const int ci = i * 64 + lane, key = ci >> 3, part = ci & 7; t.vv[i] = *(const v4u*)(KV + (size_t)(rowbase + res + ((kv0 + key) << dsh)) * (2 * D) + D + head * 64 + part * 8); }
}
__device__ __forceinline__ void phase_dilated(const Frame& F, const bf16* Q3, const bf16* KV, bf16* OG, float* LSE) {
    LAS unsigned char* wl = F.lds + F.wave * 8192;
    const int lane = F.lane, r = lane & 31, h = lane >> 5;
    const int NTASK = NB * 16 * 3 * 64;
    for (int task = F.gw; task < NTASK; task += F.NGW) {
        const int idx64 = task & 63, t2 = task >> 6, g = t2 % 3, t3 = t2 / 3, head = t3 & 15, b = t3 >> 4;
        const int dsh = 2 * g, nvb = 64 >> dsh, res = idx64 / nvb, vb = idx64 % nvb, v0 = vb * 32, rowbase = b * S;
        const int qrow = rowbase + res + ((v0 + r) << dsh);
        const bf16* qp = Q3 + (size_t)qrow * (3 * D) + g * D + head * 64 + 8 * h;
        bf16x8 qf[4];
#pragma unroll
        for (int ds = 0; ds < 4; ++ds) qf[ds] = *(const bf16x8*)(qp + 16 * ds);
        float m = -INFINITY, l = 0.f; f32x16 o0, o1;
#pragma unroll
        for (int i = 0; i < 16; ++i) { o0[i] = 0.f; o1[i] = 0.f; }
        const int jstart = (v0 >= 128) ? 0 : ((128 - v0) >> 5);
        DilTile cur, nxt; dil_load(cur, KV, rowbase, res, dsh, v0 - 128 + 32 * jstart, head, lane);
#pragma unroll
        for (int j = 0; j < 5; ++j) {
            if (j >= jstart) {
                if (j < 4) dil_load(nxt, KV, rowbase, res, dsh, v0 - 128 + 32 * (j + 1), head, lane);
#pragma unroll
                for (int i = 0; i < 4; ++i) { const int ci = i * 64 + lane, key = ci >> 3, part = ci & 7; *(LAS v4u*)(wl + key * 144 + part * 16) = cur.vv[i]; }
                f32x16 p;
#pragma unroll
                for (int i = 0; i < 16; ++i) p[i] = 0.f;
#pragma unroll
                for (int ds = 0; ds < 4; ++ds) p = __builtin_amdgcn_mfma_f32_32x32x16_bf16(cur.kf[ds], qf[ds], p, 0, 0, 0);
                if (j == 0) {
#pragma unroll
                    for (int i = 0; i < 16; ++i) if (crow16(i, h) < r) p[i] = -INFINITY;
                }
                if (j == 4) {
#pragma unroll
                    for (int i = 0; i < 16; ++i) if (crow16(i, h) > r) p[i] = -INFINITY;
                }
                float mt = p[0];
#pragma unroll
                for (int i = 1; i < 16; ++i) mt = fmaxf(mt, p[i]);
                mt = fmaxf(mt, __shfl_xor(mt, 32));
                const float mn = fmaxf(m, mt), alpha = __builtin_amdgcn_exp2f(m - mn); m = mn;
                float rs = 0.f;
#pragma unroll
                for (int i = 0; i < 16; ++i) { p[i] = __builtin_amdgcn_exp2f(p[i] - mn); rs += p[i]; }
                l = l * alpha + rs;
#pragma unroll
                for (int i = 0; i < 16; ++i) { o0[i] *= alpha; o1[i] *= alpha; }
                bf16x8 pf[2];
#pragma unroll
                for (int s = 0; s < 2; ++s) { v4u w; w.x = pk2(p[8 * s], p[8 * s + 1]); w.y = pk2(p[8 * s + 2], p[8 * s + 3]); w.z = pk2(p[8 * s + 4], p[8 * s + 5]); w.w = pk2(p[8 * s + 6], p[8 * s + 7]); pf[s] = __builtin_bit_cast(bf16x8, w); }
                const int i16 = lane & 15, q4 = i16 >> 2, p4 = i16 & 3, blk = (lane >> 4) & 1;
#pragma unroll
                for (int s = 0; s < 2; ++s) {
#pragma unroll
                    for (int db = 0; db < 2; ++db) {
                        const LAS unsigned char* a0 = wl + (16 * s + 4 * h + q4) * 144 + (32 * db + 16 * blk + 4 * p4) * 2;
                        const s16x4 lo = __builtin_bit_cast(s16x4, __builtin_amdgcn_ds_read_tr16_b64_v4i16((LAS s16x4*)a0));
                        const s16x4 hi = __builtin_bit_cast(s16x4, __builtin_amdgcn_ds_read_tr16_b64_v4i16((LAS s16x4*)(a0 + 8 * 144)));
                        const bf16x8 vf = (bf16x8){lo[0], lo[1], lo[2], lo[3], hi[0], hi[1], hi[2], hi[3]};
                        if (db == 0) o0 = __builtin_amdgcn_mfma_f32_32x32x16_bf16(vf, pf[s], o0, 0, 0, 0); else o1 = __builtin_amdgcn_mfma_f32_32x32x16_bf16(vf, pf[s], o1, 0, 0, 0);
                    }
                }
                if (j < 4) cur = nxt;
            }
        }
        const float lt = l + __shfl_xor(l, 32), inv = 1.0f / lt;
        bf16* op = OG + (size_t)g * T * D + (size_t)qrow * D + head * 64 + 4 * h;
#pragma unroll
        for (int ig = 0; ig < 4; ++ig) { v2u w0, w1; w0.x = pk2(o0[4 * ig] * inv, o0[4 * ig + 1] * inv); w0.y = pk2(o0[4 * ig + 2] * inv, o0[4 * ig + 3] * inv); w1.x = pk2(o1[4 * ig] * inv, o1[4 * ig + 1] * inv); w1.y = pk2(o1[4 * ig + 2] * inv, o1[4 * ig + 3] * inv);
            *(v2u*)(op + 8 * ig) = w0; *(v2u*)(op + 32 + 8 * ig) = w1; }
        if (h == 0) LSE[(size_t)g * T * 16 + (size_t)qrow * 16 + head] = m + __builtin_amdgcn_logf(lt);
    }
}

#ifndef REP_P0
#define REP_P0 1
#endif
#ifndef REP_QKV
#define REP_QKV 1
#endif
#ifndef REP_ATTN
#define REP_ATTN 1
#endif
#ifndef REP_SUBLN
#define REP_SUBLN 1
#endif
#ifndef REP_DIL
#define REP_DIL 1
#endif
#ifndef REP_MERGE
#define REP_MERGE 1
#endif
#ifndef REP_M2R
#define REP_M2R 1
#endif
#ifndef REP_SCAT
#define REP_SCAT 1
#endif
#ifndef REP_GU
#define REP_GU 1
#endif
#ifndef REP_DN
#define REP_DN 1
#endif
__global__ void __launch_bounds__(NWAVES * 64, 2) yoco_fwd(Args a_unused) {
    extern __shared__ __attribute__((aligned(16))) unsigned char lds_raw[];
    int ph_lo, ph_hi; unsigned barx = 0;
    {
        ArgsP ap = (ArgsP)__builtin_amdgcn_kernarg_segment_ptr(); ph_lo = ap->ph_lo; ph_hi = ap->ph_hi;
        LAS unsigned char* l0 = (LAS unsigned char*)lds_raw;
        for (int u = threadIdx.x; u < (LDS_BYTES - MISC_OFF) / 4; u += NWAVES * 64) ((LAS unsigned*)(l0 + MISC_OFF))[u] = 0u;
        __syncthreads();
        if (ap->use_bar) { XcdBarrier b0 = xcd_barrier_post((unsigned*)(ap->ws + WS_CTL) + CW_BAR, (volatile LAS unsigned*)(l0 + MISC_OFF)); barx = b0.x; }
    }
    int ph = 0;
#define PH_BEGIN PH_BEGIN_R(1)
#define PH_BEGIN_R(R) if (ph_lo <= ph && ph < ph_hi) { ArgsP ap = (ArgsP)__builtin_amdgcn_kernarg_segment_ptr(); asm volatile("" : "+s"(ap)); unsigned char* ws = ap->ws; Frame F; { int t_ = threadIdx.x; asm volatile("" : "+v"(t_)); \
        unsigned lb_ = 0; asm volatile("" : "+s"(lb_)); F.lds = (LAS unsigned char*)lds_raw + lb_; F.tid = t_; F.lane = t_ & 63; F.wave = __builtin_amdgcn_readfirstlane(t_ >> 6); int g_ = gridDim.x, b_ = blockIdx.x; asm volatile("" : "+s"(g_), "+s"(b_)); F.G = g_; F.bid = b_; F.gw = b_ * NWAVES + F.wave; F.NGW = g_ * NWAVES; } \
        for (int rep_ = 0; rep_ < (R); ++rep_) { if (rep_ > 0) MK_BARRIER();
#define MK_BARRIER() do { XcdBarrier b_; b_.bar = (unsigned*)(ws + WS_CTL) + CW_BAR; b_.x = barx; b_.st = (volatile LAS unsigned*)(F.lds + MISC_OFF); xcd_barrier(b_); } while (0)
#define PH_END } if (ph + 1 < ph_hi) MK_BARRIER(); } ++ph;
#define P_MODALL ((float*)(ws + WS_MOD))
#define P_XRES ((float*)(ws + WS_X))
#define P_HBUF ((bf16*)(ws + WS_H))
#define P_HKV ((bf16*)(ws + WS_HKV))
#define P_QBUF ((bf16*)(ws + WS_Q))
#define P_KVSH ((bf16*)(ws + WS_KVSH))
#define P_OBUF ((bf16*)(ws + WS_O))
#define P_OPBUF ((bf16*)(ws + WS_OP))
#define P_LSE ((float*)(ws + WS_LSE))
#define P_HS ((bf16*)(ws + WS_HS))
#define P_ACT ((bf16*)(ws + WS_ACT))
#define P_Y ((bf16*)(ws + WS_Y))
#define P_TKE ((int*)(ws + WS_TKE))
#define P_TKW ((float*)(ws + WS_TKW))
#define P_TKL ((int*)(ws + WS_TKL))
#define P_SLOT ((int*)(ws + WS_SLOT))
#define P_WGCNT ((int*)(ws + WS_WGCNT))
#define P_TEXP ((int*)(ws + WS_TEXP))
#define P_NTW ((unsigned*)(ws + WS_NT))
#define P_ROWTOK ((int*)(ws + WS_ROWTOK))
#define P_COS ((const float*)(ws + WS_ROPE))
#define P_SIN ((const float*)(ws + WS_ROPE) + S * 8)

    PH_BEGIN_R(REP_P0) p0_prologue(F, ap); PH_END
    PH_BEGIN phase_modulate0(F, ap->in[I_X], ap->in[I_MIXN], P_MODALL, 0, D, P_HBUF); PH_END

    for (int st = 0; st < 5; ++st) {
        const int kind = (st < 2) ? 0 : (st == 2 ? 1 : 2);
        const int l = (st < 2) ? st : st - 1;
        const int j = l - 2;
        PH_BEGIN_R(REP_QKV) {
            pg8::Gemm g; pg8::EpiRope E; int nN;
            if (kind == 0) { g = pg8::Gemm{P_HBUF, (const bf16*)(ws + WS_WQKV) + (size_t)l * 3 * D * D, T, 3 * D, D, 0}; nN = 12; E = pg8::EpiRope{P_QBUF, D, D, (size_t)T * D, 2 * D, D, QSCALE, P_COS, P_SIN}; }
            else if (kind == 1) { g = pg8::Gemm{P_HKV, (const bf16*)(ws + WS_KVW), T, 2 * D, D, 0}; nN = 8; E = pg8::EpiRope{P_KVSH, 2 * D, 0, 0, D, 0, 1.0f, P_COS, P_SIN}; }
            else { g = pg8::Gemm{P_HBUF, (const bf16*)(ws + WS_BWQ) + (size_t)j * 3 * D * D, T, 3 * D, D, 0}; nN = 12; E = pg8::EpiRope{P_QBUF, 3 * D, 0, 0, 3 * D, 3 * D, QSCALE, P_COS, P_SIN}; }
            pg8::Order O; O.init(T / 256, nN, F.G, F.bid, nullptr, nullptr);
            pg8::gemm_phase<pg8::EpiRope, pg8::Order, false>(F.lds, g, O, E);
        } PH_END
        if (kind == 1) continue;
        if (kind == 0) {
            PH_BEGIN_R(REP_ATTN) {
                const attn_body::bf16* Qp = (const attn_body::bf16*)P_QBUF; const attn_body::bf16* Kp = Qp + (size_t)T * D; const attn_body::bf16* Vp = Kp + (size_t)T * D; attn_body::bf16* Op = (attn_body::bf16*)P_OPBUF;
                const int vcu = (F.G % 8 == 0) ? (F.bid % 8) * (F.G / 8) + F.bid / 8 : F.bid;
                for (int p = vcu; p < NB * 16; p += F.G) { const int b = p >> 4, hh = p & 15, hq = hh >> 1, mm = hh & 1;
                    for (int half = 0; half < 2; ++half)
                        for (int qb = 0; qb < S / 256; ++qb)
                            attn_body::attn_unit<8>(b, qb, Qp + hh * 64, Kp + hh * 64, Vp + hq * 128 + half * 64, Op + (size_t)mm * T * D + hq * 128 + half * 64, (char*)F.lds); }
            } PH_END
            PH_BEGIN_R(REP_SUBLN) phase_subln(F, P_OPBUF, ap->in[I_ALAM] + l * 256, ap->in[I_ASUBLN] + l * 128, ap->lam_init[l & 1], P_OBUF); PH_END
        } else {
            PH_BEGIN_R(REP_DIL) phase_dilated(F, P_QBUF, P_KVSH, P_OPBUF, P_LSE); PH_END
            PH_BEGIN_R(REP_MERGE) phase_merge(F, P_OPBUF, P_LSE, P_OBUF); PH_END
        }
        PH_BEGIN {
            const bf16* wo = (kind == 0) ? (const bf16*)(ws + WS_AWO) + (size_t)l * D * D : (const bf16*)(ws + WS_BWO) + (size_t)j * D * D;
            pg8::Gemm g{P_OBUF, wo, T, D, D, 0}; pg8::Order O; O.init(T / 256, 4, F.G, F.bid, nullptr, nullptr);
            pg8::EpiResid E{(l == 0) ? ap->in[I_X] : P_XRES, P_XRES, P_MODALL + l * 6 * D + 2 * D, MODC};
            pg8::gemm_phase<pg8::EpiResid, pg8::Order, false>(F.lds, g, O, E);
        } PH_END
        PH_BEGIN_R(REP_M2R) phase_mod2_router(F, P_XRES, ap->in[I_FFNN] + l * D, P_MODALL, l * 6 * D + 3 * D, l * 6 * D + 4 * D, (const bf16*)(ws + WS_RFRAG) + (size_t)l * 65536, ap->in[I_RB] + l * NE, P_HBUF, P_TKE, P_TKW, P_TKL, P_WGCNT); PH_END
        PH_BEGIN_R(REP_SCAT) phase_scatter(F, P_WGCNT, P_TKE, P_TKL, P_SLOT, P_ROWTOK, P_TEXP, P_NTW); PH_END
        PH_BEGIN_R(REP_GU) {
            const int nt = (int)__hip_atomic_load(P_NTW, RLX_AGENT); LAS int* tl = (LAS int*)(F.lds + TEXP_OFF); LAS int* rt = (LAS int*)(F.lds + ROWTAB_OFF);
            for (int i = F.tid; i < nt; i += NWAVES * 64) tl[i] = P_TEXP[i];
            __syncthreads();
            constexpr size_t ESZ = MOE_F8 ? 1 : 2;
            pg8::Gemm g{(const bf16*)P_HBUF, (const bf16*)(ws + WS_WGU + (size_t)l * NE * 2 * D * D * ESZ), nt * 256, 2 * D, D, (size_t)2 * D * D * ESZ}; pg8::OrderT<true> O; O.init(nt, 8, F.G, F.bid, tl, rt);
            { pg8::Unit u_; const int* rtk = P_ROWTOK; for (int i = 0; O.next(i, u_); ++i) if (F.tid < 256) rt[i * 256 + F.tid] = rtk[u_.pm * 256 + F.tid]; }
            __syncthreads();
            pg8::EpiSwiglu<MOE_F8 != 0> E{P_ACT, ap->in[I_BGU] + (size_t)l * NE * 2 * D};
            pg8::gemm_phase<pg8::EpiSwiglu<MOE_F8 != 0>, pg8::OrderT<true>, MOE_F8 != 0>(F.lds, g, O, E);
        } PH_END
        PH_BEGIN_R(REP_DN) {
            const int nt = (int)__hip_atomic_load(P_NTW, RLX_AGENT); LAS int* tl = (LAS int*)(F.lds + TEXP_OFF);
            for (int i = F.tid; i < nt; i += NWAVES * 64) tl[i] = P_TEXP[i];
            __syncthreads();
            constexpr size_t ESZ = MOE_F8 ? 1 : 2;
            pg8::Gemm g{P_ACT, (const bf16*)(ws + WS_WDN + (size_t)l * NE * D * D * ESZ), nt * 256, D, D, (size_t)D * D * ESZ}; pg8::Order O; O.init(nt, 4, F.G, F.bid, tl, nullptr);
            pg8::EpiDown E{P_Y, ap->in[I_BDN] + (size_t)l * NE * D};
            pg8::gemm_phase<pg8::EpiDown, pg8::Order, MOE_F8 != 0>(F.lds, g, O, E);
        } PH_END
        PH_BEGIN {
            const int mode = (l == 3) ? 2 : (l == 1 ? 1 : 0);
            const float* gainA = (l == 3) ? ap->in[I_FINN] : ap->in[I_MIXN] + (l + 1) * D; const int shA = (l == 3) ? MOD_FIN : (l + 1) * 6 * D, scA = shA + D;
            phase_combine(F, P_XRES, P_Y, P_SLOT, P_TKW, P_MODALL + l * 6 * D + 5 * D, mode, gainA, P_MODALL, shA, scA, P_HBUF, ap->in[I_KVN], MOD_KV, MOD_KV + D, P_HKV, ap->out);
        } PH_END
    }
#undef PH_BEGIN
#undef PH_END
}
constexpr int N_PHASES = 2 + 9 + 9 + 1 + 9 + 9;

#ifndef MK_PER_PHASE
#define MK_PER_PHASE 0
#endif
extern "C" void kernel_launch(void* const* d_in, const int* in_sizes, int n_in, void* d_out, int out_size, void* d_ws, size_t ws_size, hipStream_t stream) {
    static int grid = 0;
    if (grid == 0) {
        if (n_in != 25 || in_sizes[0] != T * D || out_size != T * D || ws_size < WS_END) { fprintf(stderr, "kernel_launch: unexpected shapes / workspace (n_in %d, ws %zu)\n", n_in, ws_size); grid = -1; return; }
        int dev = 0, cus = 0, per_cu = 0;
        if (hipGetDevice(&dev) != hipSuccess || hipDeviceGetAttribute(&cus, hipDeviceAttributeMultiprocessorCount, dev) != hipSuccess) { grid = -1; return; }
        if (hipFuncSetAttribute((const void*)yoco_fwd, hipFuncAttributeMaxDynamicSharedMemorySize, LDS_BYTES) != hipSuccess) { fprintf(stderr, "kernel_launch: hipFuncSetAttribute failed\n"); grid = -1; return; }
        if (hipOccupancyMaxActiveBlocksPerMultiprocessor(&per_cu, (const void*)yoco_fwd, NWAVES * 64, LDS_BYTES) != hipSuccess || per_cu < 1) fprintf(stderr, "kernel_launch: occupancy query reports %d\n", per_cu);
        (void)hipGetLastError();
        grid = cus;
    }
    if (grid < 0) return;
    if (hipMemsetAsync((char*)d_ws + WS_CTL, 0, CTL_ZERO_BYTES, stream) != hipSuccess) return;
    Args a{};
    for (int i = 0; i < 25; ++i) a.in[i] = (const float*)d_in[i];
    a.out = (float*)d_out; a.ws = (unsigned char*)d_ws;
    for (int i = 0; i < 8; ++i) a.invf[i] = (float)pow(500000.0, -(double)(2 * i) / 16.0);
    a.lam_init[0] = (float)(0.8 - 0.6 * exp(-0.3 * 0.0)); a.lam_init[1] = (float)(0.8 - 0.6 * exp(-0.3 * 1.0));
#if MK_PER_PHASE
    for (int p = 0; p < N_PHASES; ++p) { a.ph_lo = p; a.ph_hi = p + 1; a.use_bar = 0; hipLaunchKernelGGL(yoco_fwd, dim3(grid), dim3(NWAVES * 64), LDS_BYTES, stream, a); }
#else
    a.ph_lo = 0; a.ph_hi = N_PHASES; a.use_bar = 1; hipLaunchKernelGGL(yoco_fwd, dim3(grid), dim3(NWAVES * 64), LDS_BYTES, stream, a);
#endif
}
```

```cpp
#include <hip/hip_runtime.h>
#include <hip/hip_bf16.h>
#include <cstdio>
#include <cstdint>
#include <cmath>
namespace pg8 {
#define PG8_LAS __attribute__((address_space(3)))
typedef unsigned short bf16_t;
typedef short bf16x8 __attribute__((ext_vector_type(8)));
typedef float f32x4 __attribute__((ext_vector_type(4)));
typedef unsigned u32x4 __attribute__((ext_vector_type(4)));
constexpr int BM = 256, BK = 64, HALF = 128, HTB = HALF * BK * 2  , STAGE_BYTES = 8 * HTB, NXCD = 8, WGM = 8;

__host__ __device__ __forceinline__ int lds_byte(int r, int c) { const int st = (r >> 4) * 2 + (c >> 5), rr = r & 15, cc = c & 31, ob = rr * 64 + cc * 2; return st * 1024 + (ob ^ (((ob >> 9) & 1) << 5)); }
__host__ __device__ __forceinline__ void stage_rc(int b, int& R, int& C) { const int st = b / 1024, sb = b % 1024, swz = sb ^ (((sb >> 9) & 1) << 5); R = (st >> 1) * 16 + swz / 64; C = (st & 1) * 32 + (swz % 64) / 2; }
__host__ __device__ __forceinline__ int perm32(int rho) { const int n = rho >> 4, i = rho & 15; return 8 * (i >> 2) + 4 * n + (i & 3); }

struct Unit { int pm, pn, e, ui; };
struct Gemm { const bf16_t* A; const bf16_t* Bt; int M, N, K; size_t estride; };

template <bool GATHER> struct OrderT {
    int nM, nN, nwg, G, c; const PG8_LAS int* texp; const PG8_LAS int* rowtab;
    __device__ __forceinline__ void init(int nM_, int nN_, int G_, int c_, const PG8_LAS int* texp_, const PG8_LAS int* rowtab_) { nM = nM_; nN = nN_; nwg = nM * nN; G = G_; c = c_; texp = texp_; rowtab = rowtab_; }
    __device__ __forceinline__ bool next(int i, Unit& u) const {
        const long L = (long)i * G + c; if (L >= nwg) return false;
        int wgid = (int)L; { const int q = nwg / NXCD, r = nwg % NXCD, xcd = wgid % NXCD, off = wgid / NXCD; wgid = (xcd < r ? xcd * (q + 1) : r * (q + 1) + (xcd - r) * q) + off; }
        const int nig = WGM * nN, gid = wgid / nig, fm = gid * WGM, gsz = (nM - fm) < WGM ? (nM - fm) : WGM;
        u.pm = fm + ((wgid % nig) % gsz); u.pn = (wgid % nig) / gsz; u.e = texp ? texp[u.pm] : 0; u.ui = i; return true;
    }
    __device__ __forceinline__ int arow(const Unit& u, int r) const { if constexpr (GATHER) return rowtab[u.ui * 256 + r]; else return u.pm * 256 + r; }
};
typedef OrderT<false> Order;

__device__ __forceinline__ unsigned cvt_pk_bf16(float lo, float hi) { unsigned r; asm volatile("v_cvt_pk_bf16_f32 %0, %1, %2" : "=v"(r) : "v"(lo), "v"(hi)); return r; }
__device__ __forceinline__ unsigned pk4_fp8(float a, float b, float c, float d) { unsigned u = (unsigned)__builtin_amdgcn_cvt_pk_fp8_f32(a, b, 0, false); return (unsigned)__builtin_amdgcn_cvt_pk_fp8_f32(c, d, (int)u, true); }
__device__ __forceinline__ f32x4 shfl16(f32x4 v) { f32x4 o; o[0] = __shfl_xor(v[0], 16); o[1] = __shfl_xor(v[1], 16); o[2] = __shfl_xor(v[2], 16); o[3] = __shfl_xor(v[3], 16); return o; }

struct EpiRope {
    static constexpr bool PERM = true, AFTER_DRAIN = false;
    bf16_t* O; int ldc; int split_cols; size_t split_stride; int rope_cols, scale_cols; float qscale; const float* cosT; const float* sinT;
    int headmajor;
    __device__ __forceinline__ void operator()(const f32x4 (&acc)[2][2][4][2], const Unit& u, int wr, int wc, int fr, int fq) const {
        const int row0 = u.pm * BM + wr * 64 + fr; int colt = u.pn * BM; bf16_t* base = O;
        const bool do_rope = (colt < rope_cols) && ((wc & 1) == 0); const float sc = (colt < scale_cols) ? qscale : 1.f;
        if (split_cols) { const int t = colt / split_cols; base += (size_t)t * split_stride; colt -= t * split_cols; }
        const int col0 = colt + wc * 32 + 8 * fq;
#pragma unroll
        for (int ai = 0; ai < 2; ++ai)
#pragma unroll
            for (int m = 0; m < 4; ++m) { const int row = row0 + ai * HALF + m * 16; bf16_t* rowp = base + (size_t)row * ldc + col0;
                if (headmajor) { const int cc = col0; rowp = base + ((size_t)((((cc >> 10) * 16 + (row >> 11)) * 16 + ((cc >> 6) & 15))) * 2048 + (row & 2047)) * 64 + (cc & 63); }
                f32x4 c0 = (f32x4){1.f, 1.f, 1.f, 1.f}, c1 = c0, s0 = (f32x4){0.f, 0.f, 0.f, 0.f}, s1 = s0;
                if (do_rope) { const int t = row & 2047; c0 = *(const f32x4*)(cosT + t * 8); c1 = *(const f32x4*)(cosT + t * 8 + 4); s0 = *(const f32x4*)(sinT + t * 8); s1 = *(const f32x4*)(sinT + t * 8 + 4);
                    if (fq == 0) { s0 = -s0; s1 = -s1; } else if (fq >= 2) { c0 = (f32x4){1.f, 1.f, 1.f, 1.f}; c1 = c0; s0 = (f32x4){0.f, 0.f, 0.f, 0.f}; s1 = s0; } }
#pragma unroll
                for (int bj = 0; bj < 2; ++bj) { f32x4 v0 = acc[ai][bj][m][0], v1 = acc[ai][bj][m][1];
                    if (do_rope) { const f32x4 o0 = shfl16(v0), o1 = shfl16(v1); v0 = v0 * c0 + o0 * s0; v1 = v1 * c1 + o1 * s1; }
                    v0 = v0 * sc; v1 = v1 * sc; u32x4 w; w.x = cvt_pk_bf16(v0[0], v0[1]); w.y = cvt_pk_bf16(v0[2], v0[3]); w.z = cvt_pk_bf16(v1[0], v1[1]); w.w = cvt_pk_bf16(v1[2], v1[3]);
                    *(u32x4*)(rowp + (headmajor ? bj * (2 * 2048 * 64) : bj * HALF)) = w; } }
    }
};
struct EpiResid {
    static constexpr bool PERM = false, AFTER_DRAIN = false;
    const float* xin; float* xout; const float* gate; int gstride;
    __device__ __forceinline__ void operator()(const f32x4 (&acc)[2][2][4][2], const Unit& u, int wr, int wc, int fr, int fq) const {
        const int row0 = u.pm * BM + wr * 64 + fr, col0 = u.pn * BM + wc * 32 + 4 * fq; const float* gp = gate + (size_t)(u.pm >> 3) * gstride + col0;
        f32x4 gv[2][2];
#pragma unroll
        for (int bj = 0; bj < 2; ++bj)
#pragma unroll
            for (int n = 0; n < 2; ++n) gv[bj][n] = *(const f32x4*)(gp + bj * HALF + n * 16);
#pragma unroll
        for (int ai = 0; ai < 2; ++ai)
#pragma unroll
            for (int m = 0; m < 4; ++m) { const size_t off = (size_t)(row0 + ai * HALF + m * 16) * 1024 + col0;
#pragma unroll
                for (int bj = 0; bj < 2; ++bj)
#pragma unroll
                    for (int n = 0; n < 2; ++n) { const f32x4 xi = *(const f32x4*)(xin + off + bj * HALF + n * 16); *(f32x4*)(xout + off + bj * HALF + n * 16) = xi + gv[bj][n] * acc[ai][bj][m][n]; }
                if (m & 1) asm volatile("" ::: "memory"); }
    }
};
template <bool F8> struct EpiSwiglu {
    static constexpr bool PERM = true, AFTER_DRAIN = false;
    bf16_t* act; const float* bgu;
    __device__ __forceinline__ void operator()(const f32x4 (&acc)[2][2][4][2], const Unit& u, int wr, int wc, int fr, int fq) const {
        const int row0 = u.pm * BM + wr * 64 + fr, acol0 = u.pn * HALF + wc * 32 + 8 * fq; const float* bp = bgu + (size_t)u.e * 2048 + acol0;
        const f32x4 bg0 = *(const f32x4*)(bp), bg1 = *(const f32x4*)(bp + 4), bu0 = *(const f32x4*)(bp + 1024), bu1 = *(const f32x4*)(bp + 1028);
#pragma unroll
        for (int ai = 0; ai < 2; ++ai)
#pragma unroll
            for (int m = 0; m < 4; ++m) { const size_t eoff_ = (size_t)(row0 + ai * HALF + m * 16) * 1024 + acol0;
                f32x4 g0 = acc[ai][0][m][0] + bg0, g1 = acc[ai][0][m][1] + bg1, u0 = acc[ai][1][m][0] + bu0, u1 = acc[ai][1][m][1] + bu1; f32x4 r0, r1;
#pragma unroll
                for (int j = 0; j < 4; ++j) { const float ga = fminf(g0[j], 7.0f), gb = fminf(g1[j], 7.0f), ua = fminf(fmaxf(u0[j], -7.0f), 7.0f), ub = fminf(fmaxf(u1[j], -7.0f), 7.0f);
                    const float sa = __builtin_amdgcn_rcpf(1.0f + __builtin_amdgcn_exp2f(ga * (-1.702f * 1.4426950408889634f))), sb = __builtin_amdgcn_rcpf(1.0f + __builtin_amdgcn_exp2f(gb * (-1.702f * 1.4426950408889634f)));
                    r0[j] = (ua + 1.0f) * (ga * sa); r1[j] = (ub + 1.0f) * (gb * sb); }
                if constexpr (F8) { typedef unsigned u32x2_ __attribute__((ext_vector_type(2))); u32x2_ w; w.x = pk4_fp8(r0[0], r0[1], r0[2], r0[3]); w.y = pk4_fp8(r1[0], r1[1], r1[2], r1[3]); *(u32x2_*)((unsigned char*)act + eoff_) = w; }
                else { u32x4 w; w.x = cvt_pk_bf16(r0[0], r0[1]); w.y = cvt_pk_bf16(r0[2], r0[3]); w.z = cvt_pk_bf16(r1[0], r1[1]); w.w = cvt_pk_bf16(r1[2], r1[3]); *(u32x4*)(act + eoff_) = w; } }
    }
};
struct EpiDown {
    static constexpr bool PERM = true, AFTER_DRAIN = false;
    bf16_t* Y; const float* bd;
    __device__ __forceinline__ void operator()(const f32x4 (&acc)[2][2][4][2], const Unit& u, int wr, int wc, int fr, int fq) const {
        const int row0 = u.pm * BM + wr * 64 + fr, col0 = u.pn * BM + wc * 32 + 8 * fq; const float* bp = bd + (size_t)u.e * 1024 + col0;
        f32x4 bv[2][2];
#pragma unroll
        for (int bj = 0; bj < 2; ++bj)
#pragma unroll
            for (int n = 0; n < 2; ++n) bv[bj][n] = *(const f32x4*)(bp + bj * HALF + 4 * n);
#pragma unroll
        for (int ai = 0; ai < 2; ++ai)
#pragma unroll
            for (int m = 0; m < 4; ++m) { bf16_t* rowp = Y + (size_t)(row0 + ai * HALF + m * 16) * 1024 + col0;
#pragma unroll
                for (int bj = 0; bj < 2; ++bj) { const f32x4 v0 = acc[ai][bj][m][0] + bv[bj][0], v1 = acc[ai][bj][m][1] + bv[bj][1];
                    u32x4 w; w.x = cvt_pk_bf16(v0[0], v0[1]); w.y = cvt_pk_bf16(v0[2], v0[3]); w.z = cvt_pk_bf16(v1[0], v1[1]); w.w = cvt_pk_bf16(v1[2], v1[3]);
                    *(u32x4*)(rowp + bj * HALF) = w; } }
    }
};

typedef int v8i_t __attribute__((ext_vector_type(8)));
typedef int v4i_t __attribute__((ext_vector_type(4)));
template <class Epi, class Sched, bool F8>
__device__ __forceinline__ void gemm_phase(PG8_LAS unsigned char* lds, const Gemm g, const Sched& S, const Epi& E) {
    int tid_ = threadIdx.x; asm volatile("" : "+v"(tid_));
    const int tid = tid_, wid = __builtin_amdgcn_readfirstlane(tid >> 6), lane = tid & 63, wr = wid >> 2, wc = wid & 3, fr = lane & 15, fq = lane >> 4;
    constexpr int ROWB = F8 ? 1024 : 2048, nt = ROWB / 128;
    unsigned voffB[2], cvA0[2], cvA1[2];
#pragma unroll
    for (int i = 0; i < 2; ++i) { int R, C; stage_rc(tid * 16 + i * 8192, R, C); const int Rb = Epi::PERM ? ((R & ~31) + perm32(R & 31)) : R; voffB[i] = (unsigned)(Rb * ROWB) + (unsigned)C * 2u; }
    constexpr size_t kstep = 128;
    constexpr size_t hstep = (size_t)HALF * ROWB;
    constexpr size_t tstep = 2 * hstep;
    const unsigned ldsm0 = (unsigned)__builtin_amdgcn_readfirstlane((int)((unsigned)(uintptr_t)lds + (unsigned)wid * 1024u));
    unsigned abase_ = (unsigned)(uintptr_t)(lds + lds_byte(wr * 64 + fr, fq * 8)), bbase_ = (unsigned)(uintptr_t)(lds + 4 * HTB + lds_byte(wc * 32 + fr, fq * 8));
    asm volatile("" : "+v"(abase_), "+v"(bbase_));
    const PG8_LAS unsigned char* const abase = (const PG8_LAS unsigned char*)(uintptr_t)abase_; const PG8_LAS unsigned char* const bbase = (const PG8_LAS unsigned char*)(uintptr_t)bbase_;
#define PG8_SA(b, h) (((b) * 2 + (h)) * HTB)
#define PG8_SB(b, h) ((4 + (b) * 2 + (h)) * HTB)
#define PG8_STAGE(bufoff, gbase, voff) do { _Pragma("unroll") for (int _i = 0; _i < 2; ++_i) { unsigned keep_; \
        asm volatile("s_mov_b32 %0, m0\n\ts_mov_b32 m0, %3\n\ts_nop 0\n\tglobal_load_lds_dwordx4 %1, %2\n\ts_mov_b32 m0, %0" : "=&s"(keep_) : "v"((voff)[_i]), "s"((const char*)(gbase)), "s"(ldsm0 + (unsigned)((bufoff) + _i * 8192)) : "memory"); } } while (0)
#define PG8_RD(p) __builtin_bit_cast(v4i_t, *(const PG8_LAS bf16x8*)(p))
#define PG8_LDA(dst, b, h) do { _Pragma("unroll") for (int m = 0; m < 4; ++m) dst[m] = __builtin_shufflevector(PG8_RD(abase + PG8_SA(b, h) + m * 2048), PG8_RD(abase + PG8_SA(b, h) + m * 2048 + 1024), 0, 1, 2, 3, 4, 5, 6, 7); } while (0)
#define PG8_LDB(dst, b, h) do { _Pragma("unroll") for (int n = 0; n < 2; ++n) dst[n] = __builtin_shufflevector(PG8_RD(bbase + (PG8_SB(b, h) - 4 * HTB) + n * 2048), PG8_RD(bbase + (PG8_SB(b, h) - 4 * HTB) + n * 2048 + 1024), 0, 1, 2, 3, 4, 5, 6, 7); } while (0)
#define PG8_LO(x) __builtin_bit_cast(bf16x8, __builtin_shufflevector((x), (x), 0, 1, 2, 3))
#define PG8_HI(x) __builtin_bit_cast(bf16x8, __builtin_shufflevector((x), (x), 4, 5, 6, 7))
#define PG8_MMA(ai, bj, At, Bt) do { __builtin_amdgcn_s_setprio(1); \
        if constexpr (F8) { _Pragma("unroll") for (int m = 0; m < 4; ++m) _Pragma("unroll") for (int n = 0; n < 2; ++n) \
            acc[ai][bj][m][n] = __builtin_amdgcn_mfma_scale_f32_16x16x128_f8f6f4(Bt[n], At[m], acc[ai][bj][m][n], 0, 0, 0, 0x7b7b7b7b, 0, 0x7b7b7b7b);     } \
        else { _Pragma("unroll") for (int m = 0; m < 4; ++m) _Pragma("unroll") for (int n = 0; n < 2; ++n) { \
            acc[ai][bj][m][n] = __builtin_amdgcn_mfma_f32_16x16x32_bf16(PG8_LO(Bt[n]), PG8_LO(At[m]), acc[ai][bj][m][n], 0, 0, 0); \
            acc[ai][bj][m][n] = __builtin_amdgcn_mfma_f32_16x16x32_bf16(PG8_HI(Bt[n]), PG8_HI(At[m]), acc[ai][bj][m][n], 0, 0, 0); } } \
        __builtin_amdgcn_s_setprio(0); } while (0)
#define PG8_WAIT_V(n) asm volatile("s_waitcnt vmcnt(" #n ")" ::: "memory")
#define PG8_WAIT_L(n) asm volatile("s_waitcnt lgkmcnt(" #n ")" ::: "memory")
#define PG8_BAR __builtin_amdgcn_s_barrier()
#define PG8_SCHED __builtin_amdgcn_sched_barrier(0)
    Unit cur, nxt; int ui = 0;
    if (!S.next(0, cur)) return;
    f32x4 acc[2][2][4][2];
#pragma unroll
    for (int a = 0; a < 2; ++a)
#pragma unroll
        for (int b = 0; b < 2; ++b)
#pragma unroll
            for (int m = 0; m < 4; ++m)
#pragma unroll
                for (int n = 0; n < 2; ++n) acc[a][b][m][n] = (f32x4){0.f, 0.f, 0.f, 0.f};
    v8i_t At[4], B0[2], B1[2];
    const char* const Ab = (const char*)g.A;
#pragma unroll
    for (int i = 0; i < 2; ++i) { int R, C; stage_rc(tid * 16 + i * 8192, R, C); cvA0[i] = (unsigned)S.arow(cur, R) * (unsigned)ROWB + (unsigned)C * 2u; cvA1[i] = (unsigned)S.arow(cur, HALF + R) * (unsigned)ROWB + (unsigned)C * 2u; }
    const char* cB = (const char*)g.Bt + (size_t)cur.pn * tstep + (size_t)cur.e * g.estride;
    PG8_STAGE(PG8_SB(0, 0), cB, voffB); PG8_STAGE(PG8_SB(0, 1), cB + hstep, voffB); PG8_STAGE(PG8_SA(0, 0), Ab, cvA0); PG8_STAGE(PG8_SA(0, 1), Ab, cvA1);
    if (wr == 1) PG8_BAR;
    PG8_WAIT_V(2); PG8_BAR;
    PG8_STAGE(PG8_SB(1, 0), cB + kstep, voffB); PG8_STAGE(PG8_SA(1, 0), Ab + kstep, cvA0); PG8_STAGE(PG8_SB(1, 1), cB + hstep + kstep, voffB);
    PG8_WAIT_V(6); PG8_BAR;
    for (;;) {
        const bool has_next = S.next(ui + 1, nxt);
        const char* nB = has_next ? (const char*)g.Bt + (size_t)nxt.pn * tstep + (size_t)nxt.e * g.estride : cB;
#pragma clang loop unroll(disable)
        for (int t = 0; t < nt; t += 2) {
            const bool last = (t == nt - 2);
            const char* a1 = Ab + (size_t)(t + 1) * kstep;
            const char* a2 = last ? Ab : Ab + (size_t)(t + 2) * kstep; const char* b2 = last ? nB : cB + (size_t)(t + 2) * kstep;
            const char* a3 = a2 + kstep; const char* b3 = b2 + kstep;
            PG8_LDB(B0, 0, 0); PG8_LDB(B1, 0, 1); PG8_SCHED; PG8_LDA(At, 0, 0); PG8_STAGE(PG8_SA(1, 1), a1, cvA1);
            if (last && has_next) {
                int t2_ = tid; asm volatile("" : "+v"(t2_));
#pragma unroll
                for (int i = 0; i < 2; ++i) { int R, C; stage_rc(t2_ * 16 + i * 8192, R, C); cvA0[i] = (unsigned)S.arow(nxt, R) * (unsigned)ROWB + (unsigned)C * 2u; cvA1[i] = (unsigned)S.arow(nxt, HALF + R) * (unsigned)ROWB + (unsigned)C * 2u; }
            }
            PG8_WAIT_V(8); PG8_WAIT_L(0); PG8_BAR; PG8_MMA(0, 0, At, B0); PG8_MMA(0, 1, At, B1); PG8_BAR; PG8_SCHED;
            PG8_LDA(At, 0, 1); PG8_STAGE(PG8_SB(0, 0), b2, voffB); PG8_STAGE(PG8_SB(0, 1), b2 + hstep, voffB); PG8_STAGE(PG8_SA(0, 0), a2, cvA0);
            PG8_WAIT_V(8); PG8_WAIT_L(0); PG8_BAR; PG8_MMA(1, 0, At, B0); PG8_MMA(1, 1, At, B1); PG8_BAR; PG8_SCHED;
            PG8_LDB(B0, 1, 0); PG8_LDB(B1, 1, 1); PG8_SCHED; PG8_LDA(At, 1, 0); PG8_STAGE(PG8_SA(0, 1), a2, cvA1);
            PG8_WAIT_V(8); PG8_WAIT_L(0); PG8_BAR; PG8_MMA(0, 0, At, B0); PG8_MMA(0, 1, At, B1); PG8_BAR; PG8_SCHED;
            PG8_LDA(At, 1, 1); PG8_STAGE(PG8_SB(1, 0), b3, voffB); PG8_STAGE(PG8_SB(1, 1), b3 + hstep, voffB); PG8_STAGE(PG8_SA(1, 0), a3, cvA0);
            PG8_WAIT_V(8); PG8_WAIT_L(0); PG8_BAR; PG8_MMA(1, 0, At, B0); PG8_MMA(1, 1, At, B1); PG8_BAR; PG8_SCHED;
        }
        if (wr == 0) PG8_BAR;
        E(acc, cur, wr, wc, fr, fq);
        if (!has_next) break;
#pragma unroll
        for (int a = 0; a < 2; ++a)
#pragma unroll
            for (int b = 0; b < 2; ++b)
#pragma unroll
                for (int m = 0; m < 4; ++m)
#pragma unroll
                    for (int n = 0; n < 2; ++n) acc[a][b][m][n] = (f32x4){0.f, 0.f, 0.f, 0.f};
        cur = nxt; cB = nB; ++ui;
        if (wr == 1) PG8_BAR;
    }
    PG8_WAIT_V(0);
    PG8_BAR;
#undef PG8_SA
#undef PG8_SB
#undef PG8_STAGE
#undef PG8_LDA
#undef PG8_LDB
#undef PG8_RD
#undef PG8_LO
#undef PG8_HI
#undef PG8_MMA
#undef PG8_WAIT_V
#undef PG8_WAIT_L
#undef PG8_BAR
#undef PG8_SCHED
}
}
namespace attn_body {
using bf16=__hip_bfloat16;
using bf16x8=__attribute__((ext_vector_type(8)))short;
using s16x4=__attribute__((ext_vector_type(4)))short;
using f32x16=__attribute__((ext_vector_type(16)))float;
using u32x4=__attribute__((ext_vector_type(4)))unsigned;
constexpr int BATCH=16,NHEAD=16,SEQ=2048,D=64,DM=NHEAD*D;
constexpr int NW=8,QBLK=32,QB=QBLK*NW,KVBLK=64,NQB=SEQ/QB;
constexpr int ATTN_PITCH=DM, ATTN_UNIT_ROWS=QB;
__device__ __forceinline__ int crow(int r,int hi){return (r&3)+8*(r>>2)+4*hi;}
#define SBAR() __builtin_amdgcn_sched_barrier(0)
__device__ __forceinline__ void cmask(f32x16&p0,f32x16&p1,int jb,int qrel,int hi){
  const float NEG=-INFINITY; int kb=64*jb+4*hi;
  #pragma unroll
  for(int r=0;r<16;++r){int kv=kb+(r&3)+8*(r>>2); if(kv>qrel)p0[r]=NEG; if(kv+32>qrel)p1[r]=NEG;}
}

constexpr int NSLOT=3, SLOTB=8192;
constexpr int LDS_K=0, LDS_V=NSLOT*SLOTB, LDS_WS=2*NSLOT*SLOTB, LDS_OST=LDS_WS+NW*64*4, LDS_BYTES=LDS_OST+NW*4096;
constexpr float C2=0.125f*1.4426950408889634f;
__device__ __forceinline__ void glds16(const void*gsrc,unsigned lds_dst){unsigned keep;
  asm volatile("s_mov_b32 %0, m0\n\ts_mov_b32 m0, %2\n\ts_nop 0\n\tglobal_load_lds_dwordx4 %1, off\n\ts_mov_b32 m0, %0":"=&s"(keep):"v"(gsrc),"s"(lds_dst):"memory");}
__device__ __forceinline__ float max3f(float a,float b,float c){float r;asm("v_max3_f32 %0, %1, %2, %3":"=v"(r):"v"(a),"v"(b),"v"(c));return r;}
__device__ __forceinline__ float max2f(float a,float b){float r;asm("v_max_f32_e32 %0, %1, %2":"=v"(r):"v"(a),"v"(b));return r;}
__device__ __forceinline__ float fadd_s(float a,float b){float r;asm("v_add_f32_e32 %0, %1, %2":"=v"(r):"v"(a),"v"(b));return r;}
__device__ __forceinline__ float fsub_s(float a,float b){float r;asm("v_sub_f32_e32 %0, %1, %2":"=v"(r):"v"(a),"v"(b));return r;}
typedef float f32x2_t __attribute__((ext_vector_type(2))); typedef __bf16 bf16x2_t __attribute__((ext_vector_type(2)));
__device__ __forceinline__ unsigned cvtpk_s(float lo,float hi){f32x2_t v={lo,hi};bf16x2_t b=__builtin_convertvector(v,bf16x2_t);return __builtin_bit_cast(unsigned,b);}
#define WAIT_BAR(N) asm volatile("s_waitcnt vmcnt(" #N ") lgkmcnt(0)\n\ts_barrier":::"memory")

__device__ __forceinline__ void qkt(f32x16&p0,f32x16&p1,const char*Kslot,const bf16x8*qr,const f32x16&negm,int r32,int hi){
  const char*kb=Kslot+hi*1024+r32*16;
  #pragma unroll
  for(int d0=0;d0<4;++d0){
    const bf16x8 b0=*reinterpret_cast<const bf16x8*>(kb+d0*2048);
    const bf16x8 b1=*reinterpret_cast<const bf16x8*>(kb+d0*2048+512);
    if(d0==0){p0=__builtin_amdgcn_mfma_f32_32x32x16_bf16(b0,qr[0],negm,0,0,0);p1=__builtin_amdgcn_mfma_f32_32x32x16_bf16(b1,qr[0],negm,0,0,0);}
    else{p0=__builtin_amdgcn_mfma_f32_32x32x16_bf16(b0,qr[d0],p0,0,0,0);p1=__builtin_amdgcn_mfma_f32_32x32x16_bf16(b1,qr[d0],p1,0,0,0);}}
}
typedef __attribute__((address_space(3))) const char* lds_cptr;
typedef short v4i16_t __attribute__((ext_vector_type(4)));
__device__ __forceinline__ void kload8(bf16x8*kf,lds_cptr kp){
  kf[0]=*(const __attribute__((address_space(3))) bf16x8*)(kp);      kf[1]=*(const __attribute__((address_space(3))) bf16x8*)(kp+512);
  kf[2]=*(const __attribute__((address_space(3))) bf16x8*)(kp+2048); kf[3]=*(const __attribute__((address_space(3))) bf16x8*)(kp+2560);
  kf[4]=*(const __attribute__((address_space(3))) bf16x8*)(kp+4096); kf[5]=*(const __attribute__((address_space(3))) bf16x8*)(kp+4608);
  kf[6]=*(const __attribute__((address_space(3))) bf16x8*)(kp+6144); kf[7]=*(const __attribute__((address_space(3))) bf16x8*)(kp+6656);
}
__device__ __forceinline__ void kload2(bf16x8*kf,lds_cptr kp,int j){ kf[2*j]=*(const __attribute__((address_space(3))) bf16x8*)(kp+j*2048); kf[2*j+1]=*(const __attribute__((address_space(3))) bf16x8*)(kp+j*2048+512); }
__device__ __forceinline__ s16x4 vtr(lds_cptr p){ return __builtin_bit_cast(s16x4,__builtin_amdgcn_ds_read_tr16_b64_v4i16((__attribute__((address_space(3))) v4i16_t*)p)); }
__device__ __forceinline__ float rowmax(const f32x16&p0,const f32x16&p1){
  float a=max3f(p0[0],p0[1],p1[0]),b=max3f(p0[2],p0[3],p1[1]);a=max3f(a,p1[2],p1[3]);
  #pragma unroll
  for(int r=4;r<16;r+=4){a=max3f(a,p0[r],p0[r+1]);b=max3f(b,p0[r+2],p0[r+3]);a=max3f(a,p1[r],p1[r+1]);b=max3f(b,p1[r+2],p1[r+3]);}
  const float m=max2f(a,b);
  auto rr=__builtin_amdgcn_permlane32_swap(__float_as_uint(m),__float_as_uint(m),false,false);
  return max2f(__uint_as_float(rr[0]),__uint_as_float(rr[1]));
}
__device__ __forceinline__ void pv(f32x16*o,int vb,bf16x8 pa0,bf16x8 pa1,bf16x8 pa2,bf16x8 pa3){
  #pragma unroll
  for(int d0=0;d0<2;++d0){s16x4 lo[4],hi[4];
    #pragma unroll
    for(int ks=0;ks<4;++ks){
      asm volatile("ds_read_b64_tr_b16 %0,%1 offset:%c2":"=&v"(lo[ks]):"v"(vb),"i"(d0*4096+ks*1024):"memory");
      asm volatile("ds_read_b64_tr_b16 %0,%1 offset:%c2":"=&v"(hi[ks]):"v"(vb),"i"(d0*4096+ks*1024+512):"memory");}
    asm volatile("s_waitcnt lgkmcnt(0)":::"memory");SBAR();
    #define PK(k) (bf16x8){lo[k][0],lo[k][1],lo[k][2],lo[k][3],hi[k][0],hi[k][1],hi[k][2],hi[k][3]}
    o[d0]=__builtin_amdgcn_mfma_f32_32x32x16_bf16(pa0,PK(0),o[d0],0,0,0);
    o[d0]=__builtin_amdgcn_mfma_f32_32x32x16_bf16(pa1,PK(1),o[d0],0,0,0);
    o[d0]=__builtin_amdgcn_mfma_f32_32x32x16_bf16(pa2,PK(2),o[d0],0,0,0);
    o[d0]=__builtin_amdgcn_mfma_f32_32x32x16_bf16(pa3,PK(3),o[d0],0,0,0);
    #undef PK
  }
}

#ifndef ATTN_STORE16
#define ATTN_STORE16(p,v) (*(u32x4*)(p)=(v))
#endif
template<int THRL> __device__ __forceinline__ void attn_unit(int b,int qb,const bf16*Q,const bf16*__restrict__ K,const bf16*__restrict__ V,bf16*O,char*shm){
  int tid_=threadIdx.x; asm volatile("":"+v"(tid_)); const int tid=tid_,lane=tid&63,r32=lane&31,hi=lane>>5; const int wid=__builtin_amdgcn_readfirstlane(tid>>6);
  const long rowbase=(long)b*SEQ; const int q0=qb*QB;
  const bf16*Qw=Q+(rowbase+q0+wid*QBLK)*DM;
  const bf16*Kh=K+rowbase*DM,*Vh=V+rowbase*DM;
  const unsigned lds0=(unsigned)(uintptr_t)shm;
  float*wsf=(float*)(shm+LDS_WS)+wid*64;
  const bf16*ksrc=Kh+(long)lane*DM+wid*8;
  const bf16*vsrc=Vh+(long)(16*(wid&3)+(lane>>2))*DM+(wid>>2)*32+(lane&3)*8;
  const unsigned kdst=lds0+LDS_K+wid*1024, vdst=lds0+LDS_V+wid*1024;
  #define DMA_K(t,slot) glds16(ksrc+(long)(t)*KVBLK*DM,(unsigned)__builtin_amdgcn_readfirstlane(kdst+(slot)))
  #define DMA_V(t,slot) glds16(vsrc+(long)(t)*KVBLK*DM,(unsigned)__builtin_amdgcn_readfirstlane(vdst+(slot)))
  const int vb0=(int)(lds0+LDS_V)+((lane>>4)&1)*32+(lane&3)*8+(4*hi+((lane&15)>>2))*64;
  const char*Kbase=shm+LDS_K; bf16x8 kf[8];
  const lds_cptr shm3=(lds_cptr)shm; const lds_cptr kp0=shm3+LDS_K+hi*1024+r32*16; const lds_cptr vp0=shm3+LDS_V+((lane>>4)&1)*32+(lane&3)*8+(4*hi+((lane&15)>>2))*64;
  const int NT=(q0+QB)/KVBLK;
  DMA_K(0,0);DMA_V(0,0);DMA_K(1,SLOTB);
  bf16x8 qr[4];
  #pragma unroll
  for(int d0=0;d0<4;++d0)qr[d0]=*reinterpret_cast<const bf16x8*>(&Qw[(long)r32*DM+d0*16+hi*8]);
  float mhat=0.f,l_reg=0.f;f32x16 o[2];o[0]=f32x16{};o[1]=f32x16{};f32x16 negm=f32x16{};asm volatile("":"+v"(negm));
  const int qrel=wid*QBLK+r32;
  #define CMASK(P0,P1,t) do{int jb_=(t)-(NT-4); if(jb_>=0)cmask(P0,P1,jb_,qrel,hi);}while(0)
  bool resc=false;
  #define START(P0,P1) do{ const float rm=rowmax(P0,P1); resc=false; \
    { const float dl=rm; mhat=fadd_s(mhat,dl); \
      _Pragma("unroll") for(int r=0;r<16;++r){P0[r]=fsub_s(P0[r],dl);P1[r]=fsub_s(P1[r],dl);} \
      _Pragma("unroll") for(int r=0;r<16;++r)negm[r]=-mhat; asm volatile("":"+v"(negm)); } \
    _Pragma("unroll") for(int r=0;r<16;++r)P0[r]=__builtin_amdgcn_exp2f(P0[r]); }while(0)
  #define RESC() do{ if(resc){ asm volatile("s_waitcnt lgkmcnt(0)":::"memory"); \
      _Pragma("unroll") for(int d_=0;d_<2;++d_) _Pragma("unroll") for(int r=0;r<16;++r)o[d_][r]*=wsf[crow(r,hi)]; } }while(0)
  f32x16 pA0,pA1,pB0,pB1;
  int sl_prev=0,sl_cur=0,sl_next=SLOTB;
  #define ROT() do{sl_prev=sl_cur;sl_cur=sl_next;sl_next=(sl_next==(NSLOT-1)*SLOTB)?0:sl_next+SLOTB;}while(0)
  DMA_K(2,2*SLOTB);
  WAIT_BAR(3);
  qkt(pA0,pA1,Kbase,qr,negm,r32,hi);asm volatile("s_nop 15\n\ts_nop 7":"+v"(pA0),"+v"(pA1));CMASK(pA0,pA1,0);
  START(pA0,pA1);
  _Pragma("unroll") for(int r=0;r<16;++r)pA1[r]=__builtin_amdgcn_exp2f(pA1[r]);
  WAIT_BAR(0);
  DMA_K(3,0);DMA_V(1,SLOTB);
  ROT();
  kload8(kf,kp0+sl_cur);
  WAIT_BAR(2);
  s16x4 vlo[8],vhi[8]; u32x4 pw0,pw1,pw2,pw3;
  #define PKW(P,B) cvtpk_s(P[B],P[B+1])
  #define PAF(k) __builtin_bit_cast(bf16x8,pw##k)
  #define VFR(i) (bf16x8){vlo[i][0],vlo[i][1],vlo[i][2],vlo[i][3],vhi[i][0],vhi[i][1],vhi[i][2],vhi[i][3]}
  #define PIN(x) asm volatile("":"+v"(x))
  #define MX3(a,b,c) __builtin_fmaxf(__builtin_fmaxf((a),(b)),(c))
  #define GAPA(MF,A0,A1,A2,A3,W0,W1,PW) do{ MF; sacc+=A0; sacc+=A1; sacc+=A2; sacc+=A3; PIN(sacc); W0; W1; PIN(PW); SBAR(); }while(0)
  #define EX(v) __builtin_amdgcn_exp2f(v)
  #define GAPB(MF,X,B) do{ MF; X[B]=EX(X[B]); X[B+1]=EX(X[B+1]); X[B+2]=EX(X[B+2]); X[B+3]=EX(X[B+3]); PIN(X); SBAR(); }while(0)
  #define VRD(i) do{ vlo[i]=vtr(vp_+(((i)>>2)*4096+((i)&3)*1024)); vhi[i]=vtr(vp_+(((i)>>2)*4096+((i)&3)*1024+512)); }while(0)
  #define KRD(G,j) do{ if(G){ kload2(kf,kp0+sl_next,j); SBAR(); } }while(0)
  #define STEP(C0,C1,P0,P1,t,GK,GV,GL) do{ SBAR(); \
    const lds_cptr vp_=vp0+sl_prev; \
    VRD(0); SBAR(); float sacc=(P0[0]+P0[1]); \
    GAPA(C0=__builtin_amdgcn_mfma_f32_32x32x16_bf16(kf[0],qr[0],negm,0,0,0), P0[2],P0[3],P0[4],P0[5],     pw0[0]=PKW(P0,0), pw0[1]=PKW(P0,2), pw0); \
    VRD(4); SBAR(); GAPA(C1=__builtin_amdgcn_mfma_f32_32x32x16_bf16(kf[1],qr[0],negm,0,0,0), P0[6],P0[7],P0[8],P0[9],     pw0[2]=PKW(P0,4), pw0[3]=PKW(P0,6), pw0); \
    VRD(1); SBAR(); GAPA(C0=__builtin_amdgcn_mfma_f32_32x32x16_bf16(kf[2],qr[1],C0,0,0,0),   P0[10],P0[11],P0[12],P0[13], pw1[0]=PKW(P0,8), pw1[1]=PKW(P0,10), pw1); \
    VRD(5); SBAR(); GAPA(C1=__builtin_amdgcn_mfma_f32_32x32x16_bf16(kf[3],qr[1],C1,0,0,0),   P0[14],P0[15],P1[0],P1[1],   pw1[2]=PKW(P0,12),pw1[3]=PKW(P0,14), pw1); \
    VRD(2); SBAR(); GAPA(C0=__builtin_amdgcn_mfma_f32_32x32x16_bf16(kf[4],qr[2],C0,0,0,0),   P1[2],P1[3],P1[4],P1[5],     pw2[0]=PKW(P1,0), pw2[1]=PKW(P1,2), pw2); \
    VRD(6); SBAR(); GAPA(C1=__builtin_amdgcn_mfma_f32_32x32x16_bf16(kf[5],qr[2],C1,0,0,0),   P1[6],P1[7],P1[8],P1[9],     pw2[2]=PKW(P1,4), pw2[3]=PKW(P1,6), pw2); \
    VRD(3); SBAR(); GAPA(C0=__builtin_amdgcn_mfma_f32_32x32x16_bf16(kf[6],qr[3],C0,0,0,0),   P1[10],P1[11],P1[12],P1[13], pw3[0]=PKW(P1,8), pw3[1]=PKW(P1,10), pw3); \
    VRD(7); SBAR(); GAPA(C1=__builtin_amdgcn_mfma_f32_32x32x16_bf16(kf[7],qr[3],C1,0,0,0),   P1[14],P1[15],0.f,0.f,       pw3[2]=PKW(P1,12),pw3[3]=PKW(P1,14), pw3); \
    l_reg+=sacc; \
    if(GK){DMA_K((t)+3,sl_cur);} if(GV){DMA_V((t)+1,sl_next);} \
    CMASK(C0,C1,t); \
    { float a=MX3(C0[0],C0[1],C1[0]),b=MX3(C0[2],C0[3],C1[1]); a=MX3(a,C1[2],C1[3]); \
      _Pragma("unroll") for(int r=4;r<16;r+=4){a=MX3(a,C0[r],C0[r+1]);b=MX3(b,C0[r+2],C0[r+3]);a=MX3(a,C1[r],C1[r+1]);b=MX3(b,C1[r+2],C1[r+3]);} \
      float rm=__builtin_fmaxf(a,b); { auto rr=__builtin_amdgcn_permlane32_swap(__float_as_uint(rm),__float_as_uint(rm),false,false); rm=__builtin_fmaxf(__uint_as_float(rr[0]),__uint_as_float(rr[1])); } \
      resc=false; \
      if(__builtin_expect(__any(rm>(float)THRL),0)){ const float dl=__builtin_fmaxf(rm,0.f); mhat+=dl; \
        _Pragma("unroll") for(int r=0;r<16;++r){C0[r]-=dl;C1[r]-=dl;} \
        _Pragma("unroll") for(int r=0;r<16;++r)negm[r]=-mhat; asm volatile("":"+v"(negm)); \
        const float f=__builtin_amdgcn_exp2f(-dl); l_reg*=f; if(hi==0)wsf[r32]=f; resc=true; } } \
    SBAR(); \
    GAPB(o[0]=__builtin_amdgcn_mfma_f32_32x32x16_bf16(PAF(0),VFR(0),o[0],0,0,0), C0,0); \
    GAPB(o[1]=__builtin_amdgcn_mfma_f32_32x32x16_bf16(PAF(0),VFR(4),o[1],0,0,0), C0,4); \
    KRD(GL,0); GAPB(o[0]=__builtin_amdgcn_mfma_f32_32x32x16_bf16(PAF(1),VFR(1),o[0],0,0,0), C0,8); \
    KRD(GL,1); GAPB(o[1]=__builtin_amdgcn_mfma_f32_32x32x16_bf16(PAF(1),VFR(5),o[1],0,0,0), C0,12); \
    KRD(GL,2); GAPB(o[0]=__builtin_amdgcn_mfma_f32_32x32x16_bf16(PAF(2),VFR(2),o[0],0,0,0), C1,0); \
    KRD(GL,3); GAPB(o[1]=__builtin_amdgcn_mfma_f32_32x32x16_bf16(PAF(2),VFR(6),o[1],0,0,0), C1,4); \
    GAPB(o[0]=__builtin_amdgcn_mfma_f32_32x32x16_bf16(PAF(3),VFR(3),o[0],0,0,0), C1,8); \
    GAPB(o[1]=__builtin_amdgcn_mfma_f32_32x32x16_bf16(PAF(3),VFR(7),o[1],0,0,0), C1,12); \
    }while(0)
  int t=1;
  #undef CMASK
  #define CMASK(P0,P1,t) do{}while(0)
  for(;t+5<NT;t+=2){
    STEP(pB0,pB1,pA0,pA1,t,true,true,true);     WAIT_BAR(2); RESC(); ROT();
    STEP(pA0,pA1,pB0,pB1,t+1,true,true,true);   WAIT_BAR(2); RESC(); ROT();
  }
  #undef CMASK
  #define CMASK(P0,P1,t) do{int jb_=(t)-(NT-4); if(jb_>=0)cmask(P0,P1,jb_,qrel,hi);}while(0)
  #define ENDW(tt) do{ if((tt)+3<NT){WAIT_BAR(2);} else if((tt)+2<NT){WAIT_BAR(1);} else {WAIT_BAR(0);} }while(0)
  for(;t+1<NT;t+=2){
    STEP(pB0,pB1,pA0,pA1,t,(t+3<NT),(t+1<NT),(t+1<NT));       ENDW(t);   RESC(); ROT();
    STEP(pA0,pA1,pB0,pB1,t+1,(t+4<NT),(t+2<NT),(t+2<NT));     ENDW(t+1); RESC(); ROT();
  }
  STEP(pB0,pB1,pA0,pA1,NT-1,false,false,false); RESC();
  { float sacc=pB0[0]+pB0[1]; _Pragma("unroll") for(int r=2;r<16;++r)sacc+=pB0[r]; _Pragma("unroll") for(int r=0;r<16;++r)sacc+=pB1[r]; l_reg+=sacc;
    pw0=(u32x4){PKW(pB0,0),PKW(pB0,2),PKW(pB0,4),PKW(pB0,6)};pw1=(u32x4){PKW(pB0,8),PKW(pB0,10),PKW(pB0,12),PKW(pB0,14)};pw2=(u32x4){PKW(pB1,0),PKW(pB1,2),PKW(pB1,4),PKW(pB1,6)};pw3=(u32x4){PKW(pB1,8),PKW(pB1,10),PKW(pB1,12),PKW(pB1,14)};
    SBAR(); pv(o,vb0+sl_cur,PAF(0),PAF(1),PAF(2),PAF(3)); }
  #undef PKW
  #undef PAF
  #undef VFR
  #undef PIN
  #undef MX3
  #undef GAPA
  #undef GAPB
  #undef EX
  #undef VRD
  #undef KRD
  #undef STEP
  #undef ENDW
  {auto rr=__builtin_amdgcn_permlane32_swap(__float_as_uint(l_reg),__float_as_uint(l_reg),false,false);l_reg=__uint_as_float(rr[0])+__uint_as_float(rr[1]);}
  if(hi==0)wsf[32+r32]=l_reg;asm volatile("s_waitcnt lgkmcnt(0)":::"memory");
  float rli[16];
  #pragma unroll
  for(int r=0;r<16;++r)rli[r]=__builtin_amdgcn_rcpf(wsf[32+crow(r,hi)]);
  bf16*Ow=O+(rowbase+q0+wid*QBLK)*DM;
  { bf16*stg=(bf16*)(shm+LDS_OST)+wid*2048;
    #pragma unroll
    for(int r=0;r<16;++r){const int orow=crow(r,hi);
      #pragma unroll
      for(int d0=0;d0<2;++d0)stg[orow*64+d0*32+r32]=__float2bfloat16(o[d0][r]*rli[r]);}
    asm volatile("s_waitcnt lgkmcnt(0)":::"memory");
    #pragma unroll
    for(int i=0;i<4;++i){const int row=i*8+(lane>>3),ch=lane&7; const u32x4 v=*(const u32x4*)(stg+row*64+ch*8); ATTN_STORE16(Ow+(long)row*DM+ch*8,v);} }
  asm volatile("s_waitcnt lgkmcnt(0)\n\ts_barrier":::"memory");
  #undef DMA_K
  #undef DMA_V
  #undef CMASK
  #undef START
  #undef RESC
  #undef ROT
}
constexpr int ATTN_LDS_BYTES=LDS_BYTES;
#undef SBAR
#undef WAIT_BAR
}


#ifndef MOE_F8
#define MOE_F8 1
#endif
constexpr int NWAVES = 8;
constexpr int NB = 16, S = 2048, D = 1024, T = NB * S;
constexpr int NL = 4, NE = 32, TOPK = 4;
constexpr int SLOT_ROWS = T * TOPK + NE * 256;
constexpr int MODC = 6 * D * NL + 2 * D + 2 * D;
constexpr int MOD_KV = 6 * D * NL, MOD_FIN = MOD_KV + 2 * D;
constexpr float EPS = 1e-5f;
constexpr float QSCALE = 0.125f * 1.4426950408889634f;
constexpr size_t MiB = 1u << 20;
constexpr size_t WS_CTL = 0, CTL_ZERO_BYTES = 1 * MiB;
constexpr size_t WS_MOD = 4 * MiB;
constexpr size_t WS_ROPE = 6 * MiB;
constexpr size_t WS_RFRAG = 7 * MiB;
constexpr size_t WS_TKE = 8 * MiB, WS_TKW = WS_TKE + 512 * 1024, WS_TKL = WS_TKW + 512 * 1024, WS_SLOT = WS_TKL + 512 * 1024;
constexpr size_t WS_WGCNT = 10 * MiB, WS_TEXP = WS_WGCNT + 64 * 1024, WS_NT = WS_TEXP + 64 * 1024;
constexpr size_t WS_ROWTOK = 11 * MiB;
constexpr size_t WS_WQKV = 16 * MiB, WS_AWO = 28 * MiB, WS_KVW = 32 * MiB, WS_BWQ = 36 * MiB, WS_BWO = 48 * MiB;
constexpr size_t WS_WGU = 64 * MiB, WS_WDN = 576 * MiB;
constexpr size_t WS_X = 832 * MiB, WS_H = 960 * MiB, WS_Q = 1024 * MiB, WS_KVSH = 1216 * MiB, WS_O = 1344 * MiB, WS_OP = 1408 * MiB, WS_LSE = 1600 * MiB, WS_HKV = 1608 * MiB;
constexpr size_t WS_HS = 1672 * MiB, WS_ACT = 1944 * MiB, WS_Y = 2216 * MiB, WS_END = 2488 * MiB;
constexpr int CW_BAR = 4096;
constexpr int RING_BYTES = 131072;
constexpr int MISC_OFF = RING_BYTES;
constexpr int HIST_OFF = MISC_OFF + 256, TEXP_OFF = MISC_OFF + 1024, ROWTAB_OFF = MISC_OFF + 8192;
constexpr int LDS_BYTES = 163840;

#define GAS __attribute__((address_space(1)))
#define LAS __attribute__((address_space(3)))
typedef unsigned short bf16;
typedef unsigned v4u __attribute__((ext_vector_type(4)));
typedef unsigned v2u __attribute__((ext_vector_type(2)));
typedef float f32x4 __attribute__((ext_vector_type(4)));
typedef float f32x16 __attribute__((ext_vector_type(16)));
typedef short bf16x8 __attribute__((ext_vector_type(8)));
typedef short s16x4 __attribute__((ext_vector_type(4)));
#define RLX_AGENT __ATOMIC_RELAXED, __HIP_MEMORY_SCOPE_AGENT
#define LDS_WAIT() asm volatile("s_waitcnt lgkmcnt(0)" ::: "memory")
#define VM_WAIT() asm volatile("s_waitcnt vmcnt(0)" ::: "memory")
__device__ __forceinline__ unsigned f2bf(float f) { unsigned u = __builtin_bit_cast(unsigned, f); return (u + 0x7fffu + ((u >> 16) & 1u)) >> 16; }
__device__ __forceinline__ float bf2f(unsigned b) { return __builtin_bit_cast(float, b << 16); }
__device__ __forceinline__ unsigned pk2(float lo, float hi) { return pg8::cvt_pk_bf16(lo, hi); }
__device__ __forceinline__ f32x4 unpack4(v2u r) { return (f32x4){bf2f(r.x & 0xffffu), bf2f(r.x >> 16), bf2f(r.y & 0xffffu), bf2f(r.y >> 16)}; }
__device__ __forceinline__ float wave_sum(float v) {
#pragma unroll
    for (int o = 1; o < 64; o <<= 1) v += __shfl_xor(v, o);
    return v;
}
__device__ __forceinline__ float dot4(f32x4 a) { return (a.x * a.x + a.y * a.y) + (a.z * a.z + a.w * a.w); }
#define XB_TMO      128
#define XB_XCNT(j)  (256  + 64 * (j))
#define XB_XSUB(j)  (1280 + 64 * (j))
#define XB_XGEN(j)  (2304 + 64 * (j))
#define XB_TOP      3328
#define XB_TOPGEN   3392
#define XCD_BAR_WORDS 3456
#define XB_SPIN_CAP (1u << 22)

__device__ __forceinline__ unsigned xb_ld(unsigned* p)              { return __hip_atomic_load(p, __ATOMIC_RELAXED, __HIP_MEMORY_SCOPE_AGENT); }
__device__ __forceinline__ unsigned xb_add(unsigned* p, unsigned v) { return __hip_atomic_fetch_add(p, v, __ATOMIC_RELAXED, __HIP_MEMORY_SCOPE_AGENT); }
__device__ __forceinline__ unsigned xb_xcc_id() { return (unsigned)__builtin_amdgcn_s_getreg((3 << 11) | 20) & 0xFu; }
#define XB_SPIN(cond, bar) do { unsigned _sp = 0; while (cond) { __builtin_amdgcn_s_sleep(1); \
    if ((++_sp & 255u) == 0u) { if (xb_ld(&(bar)[XB_TMO])) break; if (_sp > XB_SPIN_CAP) { atomicAdd(&(bar)[XB_TMO], 1u); break; } } } } while (0)

struct XcdBarrier {
    unsigned* bar; unsigned x;
    volatile LAS unsigned* st;
};

__device__ __forceinline__ XcdBarrier xcd_barrier_post(unsigned* bar, volatile LAS unsigned* st) {
    XcdBarrier b; b.bar = bar; b.x = xb_xcc_id(); b.st = st;
    if (threadIdx.x == 0) (void)xb_add(&bar[XB_XCNT(b.x)], 1u);
    return b;
}
__device__ __forceinline__ void xcd_barrier_complete(unsigned* bar, unsigned x, unsigned& nloc, unsigned& nx) {
    const unsigned G = gridDim.x * gridDim.y * gridDim.z;
    unsigned sum, cnt, mine, sp = 0u;
    for (;;) {
        sum = 0u; cnt = 0u; mine = 0u;
#pragma unroll
        for (unsigned j = 0; j < 16; ++j) { const unsigned c = xb_ld(&bar[XB_XCNT(j)]); sum += c; cnt += (c > 0u) ? 1u : 0u; mine = (j == x) ? c : mine; }
        if (sum == G) break;
        __builtin_amdgcn_s_sleep(1);
        if ((++sp & 255u) == 0u) { if (xb_ld(&bar[XB_TMO])) break; if (sp > XB_SPIN_CAP) { atomicAdd(&bar[XB_TMO], 1u); break; } }
    }
    nloc = mine > 0u ? mine : 1u; nx = cnt > 0u ? cnt : 1u;
}

__device__ __forceinline__ void xcd_barrier(const XcdBarrier& b) {
    asm volatile("s_waitcnt vmcnt(0)" ::: "memory");
    __syncthreads();
    if (threadIdx.x == 0) {
        unsigned* bar = b.bar;
        __builtin_amdgcn_s_waitcnt(0);
        unsigned nloc = b.st[0], nx = b.st[1];
        if (nloc == 0u) { xcd_barrier_complete(bar, b.x, nloc, nx); b.st[0] = nloc; b.st[1] = nx; }
        const unsigned old = xb_add(&bar[XB_XSUB(b.x)], 1u);
        const unsigned gen = old / nloc;
        if (old + 1u == (gen + 1u) * nloc) {
            __builtin_amdgcn_fence(__ATOMIC_RELEASE, "agent");
            asm volatile("s_waitcnt vmcnt(0)" ::: "memory");
            const unsigned og = xb_add(&bar[XB_TOP], 1u);
            const unsigned tg = og / nx;
            if (og + 1u == (tg + 1u) * nx) xb_add(&bar[XB_TOPGEN], 1u);
            else XB_SPIN(xb_ld(&bar[XB_TOPGEN]) == tg, bar);
            __builtin_amdgcn_fence(__ATOMIC_ACQUIRE, "agent");
            xb_add(&bar[XB_XGEN(b.x)], 1u);
            asm volatile("s_waitcnt vmcnt(0)" ::: "memory");
        } else {
            XB_SPIN(xb_ld(&bar[XB_XGEN(b.x)]) == gen, bar);
            __builtin_amdgcn_fence(__ATOMIC_ACQUIRE, "agent");
            asm volatile("s_waitcnt vmcnt(0)" ::: "memory");
        }
    }
    __syncthreads();
}

struct Args { const float* in[25]; float* out; unsigned char* ws; float invf[8]; float lam_init[2]; int ph_lo, ph_hi, use_bar, pad; };
enum { I_X = 0, I_C, I_MODW, I_MODB, I_MIXN, I_FFNN, I_AWQKV, I_AWO, I_ALAM, I_ASUBLN, I_KVN, I_KVMODW, I_KVMODB, I_KVW, I_BWQ, I_BWO, I_RW, I_RB, I_WGU, I_BGU, I_WDN, I_BDN, I_FINN, I_FINMODW, I_FINMODB };
struct Frame { LAS unsigned char* lds; int tid, lane, wave, G, gw, NGW, bid; };
typedef const __attribute__((address_space(4))) Args* ArgsP;

__device__ __forceinline__ void p0_transpose_item(const float* W, int N, int K, bf16* WT, int dst_row0, LAS float* scr, int k0, int n0, int lane) {
    float v_[32];
#pragma unroll
    for (int i = 0; i < 32; ++i) v_[i] = W[(size_t)(k0 + 2 * i + (lane >> 5)) * N + n0 + (lane & 31)];
#pragma unroll
    for (int i = 0; i < 32; ++i) scr[(2 * i + (lane >> 5)) * 33 + (lane & 31)] = v_[i];
    LDS_WAIT(); asm volatile("" ::: "memory");
    const int c = lane & 7;
#pragma unroll
    for (int j = 0; j < 4; ++j) { const int n = (lane >> 3) + 8 * j; const LAS float* s = scr + (8 * c) * 33 + n;
        v4u o; o.x = pk2(s[0 * 33], s[1 * 33]); o.y = pk2(s[2 * 33], s[3 * 33]); o.z = pk2(s[4 * 33], s[5 * 33]); o.w = pk2(s[6 * 33], s[7 * 33]);
        *(GAS v4u*)(WT + (size_t)(dst_row0 + n) * K + k0 + 8 * c) = o; }
    LDS_WAIT(); asm volatile("" ::: "memory");
}
__device__ __forceinline__ void p0_transpose_item_f8(const float* W, int N, int K, unsigned char* WT, int dst_row0, LAS float* scr, int k0, int n0, int lane) {
    float v_[32];
#pragma unroll
    for (int i = 0; i < 32; ++i) v_[i] = W[(size_t)(k0 + 2 * i + (lane >> 5)) * N + n0 + (lane & 31)];
#pragma unroll
    for (int i = 0; i < 32; ++i) scr[(2 * i + (lane >> 5)) * 33 + (lane & 31)] = v_[i];
    LDS_WAIT(); asm volatile("" ::: "memory");
    const int c = lane & 3;
#pragma unroll
    for (int j = 0; j < 2; ++j) { const int n = (lane >> 2) + 16 * j; const LAS float* s = scr + (16 * c) * 33 + n; v4u o;
        o.x = pg8::pk4_fp8(s[0 * 33] * 256.f, s[1 * 33] * 256.f, s[2 * 33] * 256.f, s[3 * 33] * 256.f); o.y = pg8::pk4_fp8(s[4 * 33] * 256.f, s[5 * 33] * 256.f, s[6 * 33] * 256.f, s[7 * 33] * 256.f);
        o.z = pg8::pk4_fp8(s[8 * 33] * 256.f, s[9 * 33] * 256.f, s[10 * 33] * 256.f, s[11 * 33] * 256.f); o.w = pg8::pk4_fp8(s[12 * 33] * 256.f, s[13 * 33] * 256.f, s[14 * 33] * 256.f, s[15 * 33] * 256.f);
        *(GAS v4u*)(WT + (size_t)(dst_row0 + n) * K + k0 + 16 * c) = o; }
    LDS_WAIT(); asm volatile("" ::: "memory");
}
__device__ __forceinline__ void p0_prologue(const Frame& F, ArgsP ap) {
    unsigned char* ws = ap->ws;
    {
        LAS float* cT = (LAS float*)F.lds;
        LAS float* red = (LAS float*)(F.lds + 65536);
        const float* c = ap->in[I_C];
        for (int idx = F.tid; idx < NB * D; idx += NWAVES * 64) { const int b = idx >> 10, k = idx & 1023; const float v = c[idx]; cT[k * 16 + b] = v / (1.0f + __expf(-v)); }
        __syncthreads();
        float* modall = (float*)(ws + WS_MOD);
        for (int g = F.bid; g < MODC / 64; g += F.G) {
            const int cg0 = g * 64; const float* W; const float* bias; int N, col0;
            if (cg0 < MOD_KV) { const int l = cg0 / (6 * D); col0 = cg0 % (6 * D); W = ap->in[I_MODW] + (size_t)l * D * 6 * D; N = 6 * D; bias = ap->in[I_MODB] + l * 6 * D + col0; }
            else if (cg0 < MOD_FIN) { col0 = cg0 - MOD_KV; W = ap->in[I_KVMODW]; N = 2 * D; bias = ap->in[I_KVMODB] + col0; }
            else { col0 = cg0 - MOD_FIN; W = ap->in[I_FINMODW]; N = 2 * D; bias = ap->in[I_FINMODB] + col0; }
            float acc[16];
#pragma unroll
            for (int b = 0; b < 16; ++b) acc[b] = 0.f;
            const float* wp = W + (size_t)(F.wave * 128) * N + col0 + F.lane;
#pragma unroll 8
            for (int kk = 0; kk < 128; ++kk) { const float w = wp[(size_t)kk * N]; const LAS f32x4* cv = (const LAS f32x4*)(cT + (F.wave * 128 + kk) * 16);
                const f32x4 c0 = cv[0], c1 = cv[1], c2 = cv[2], c3 = cv[3];
                acc[0] += w * c0.x; acc[1] += w * c0.y; acc[2] += w * c0.z; acc[3] += w * c0.w; acc[4] += w * c1.x; acc[5] += w * c1.y; acc[6] += w * c1.z; acc[7] += w * c1.w;
                acc[8] += w * c2.x; acc[9] += w * c2.y; acc[10] += w * c2.z; acc[11] += w * c2.w; acc[12] += w * c3.x; acc[13] += w * c3.y; acc[14] += w * c3.z; acc[15] += w * c3.w; }
#pragma unroll
            for (int b = 0; b < 16; ++b) red[(F.wave * 16 + b) * 64 + F.lane] = acc[b];
            __syncthreads();
            for (int o = F.tid; o < 1024; o += NWAVES * 64) { const int b = o >> 6, ln = o & 63; float s = bias[ln];
#pragma unroll
                for (int w = 0; w < 8; ++w) s += red[(w * 16 + b) * 64 + ln];
                modall[(size_t)b * MODC + cg0 + ln] = s; }
            __syncthreads();
        }
        __syncthreads();
    }
    {
        const int gt = F.bid * (NWAVES * 64) + F.tid, NT_ = F.G * NWAVES * 64;
        float* cosT = (float*)(ws + WS_ROPE); float* sinT = cosT + S * 8;
        for (int idx = gt; idx < S * 8; idx += NT_) { const int pos = idx >> 3, i = idx & 7; float inv = ap->invf[0];
#pragma unroll
            for (int q = 1; q < 8; ++q) inv = (i == q) ? ap->invf[q] : inv;
            const float angf = (float)pos * inv; const double x = (double)angf; const double n = __builtin_rint(x * 0.15915494309189533577); const double r = x - n * 6.283185307179586476925; const double r2 = r * r;
            double sn = 1.0, cs = 1.0;
#pragma unroll
            for (int q = 14; q >= 1; --q) { sn = 1.0 - sn * r2 / (double)((2 * q) * (2 * q + 1)); cs = 1.0 - cs * r2 / (double)((2 * q - 1) * (2 * q)); }
            sn *= r; cosT[idx] = (float)cs; sinT[idx] = (float)sn; }
        bf16* rfrag = (bf16*)(ws + WS_RFRAG); const float* rw = ap->in[I_RW];
        for (int idx = gt; idx < NL * 32 * 2 * 64 * 8; idx += NT_) { const int j = idx & 7, lane = (idx >> 3) & 63, nb = (idx >> 9) & 1, s = (idx >> 10) & 31, l = idx >> 15;
            const float w = rw[((size_t)l * D + 32 * s + 8 * (lane >> 4) + j) * NE + 16 * nb + (lane & 15)]; const unsigned hi = f2bf(w), lo = f2bf(w - bf2f(hi));
            const size_t base = ((((size_t)l * 32 + s) * 2 + nb) * 2) * 512 + lane * 8 + j; rfrag[base] = (bf16)hi; rfrag[base + 512] = (bf16)lo; }
    }
    {
        LAS float* scr = (LAS float*)(F.lds + F.wave * 16384);
        constexpr int I_QKV = 16 * 96, I_SQ = 16 * 32, I_KV = 16 * 64, I_GU = 16 * 64, I_DN = 16 * 32;
        constexpr int E0 = 2 * I_QKV, E1 = E0 + 2 * I_SQ, E2 = E1 + I_KV, E3 = E2 + 2 * I_QKV, E4 = E3 + 2 * I_SQ, E5 = E4 + NL * NE * I_GU, E6 = E5 + NL * NE * I_DN;
        for (int it = F.gw; it < E6; it += F.NGW) {
            const float* W; bf16* WT; int N, r, per; bool gu = false;
            if (it < E0) { r = it; per = I_QKV; N = 3 * D; W = ap->in[I_AWQKV]; WT = (bf16*)(ws + WS_WQKV); }
            else if (it < E1) { r = it - E0; per = I_SQ; N = D; W = ap->in[I_AWO]; WT = (bf16*)(ws + WS_AWO); }
            else if (it < E2) { r = it - E1; per = I_KV; N = 2 * D; W = ap->in[I_KVW]; WT = (bf16*)(ws + WS_KVW); }
            else if (it < E3) { r = it - E2; per = I_QKV; N = 3 * D; W = ap->in[I_BWQ]; WT = (bf16*)(ws + WS_BWQ); }
            else if (it < E4) { r = it - E3; per = I_SQ; N = D; W = ap->in[I_BWO]; WT = (bf16*)(ws + WS_BWO); }
            else if (it < E5) { r = it - E4; per = I_GU; N = 2 * D; W = ap->in[I_WGU]; WT = (bf16*)(ws + WS_WGU); gu = true; }
            else { r = it - E5; per = I_DN; N = D; W = ap->in[I_WDN]; WT = (bf16*)(ws + WS_WDN); }
            const int mat = r / per, item = r % per, nblk = N / 32, kb = item / nblk, nb = item % nblk, n0 = 32 * nb;
            int drow = n0; if (gu) { const int half = n0 >> 10, rem = n0 & 1023; drow = (rem >> 7) * 256 + half * 128 + (rem & 127); }
            if (MOE_F8 && it >= E4) p0_transpose_item_f8(W + (size_t)mat * D * N, N, D, (unsigned char*)WT + (size_t)mat * N * D, drow, scr, 64 * kb, n0, F.lane);
            else p0_transpose_item(W + (size_t)mat * D * N, N, D, WT + (size_t)mat * N * D, drow, scr, 64 * kb, n0, F.lane);
        }
    }
}

struct ModVec { f32x4 a[4], b[4]; };
__device__ __forceinline__ void load_modvec(ModVec& mv, const float* gain, const float* scale, const float* shift, int lane) {
#pragma unroll
    for (int j = 0; j < 4; ++j) { const int c = 4 * lane + 256 * j; const f32x4 g = *(const f32x4*)(gain + c), sc = *(const f32x4*)(scale + c); mv.a[j] = g * (sc + 1.0f); mv.b[j] = *(const f32x4*)(shift + c); }
}
__device__ __forceinline__ void store_bf16_row(bf16* orow, const f32x4 (&v)[4], int lane) {
#pragma unroll
    for (int j = 0; j < 4; ++j) { v2u w; w.x = pk2(v[j].x, v[j].y); w.y = pk2(v[j].z, v[j].w); *(v2u*)(orow + 4 * lane + 256 * j) = w; }
}
__device__ __forceinline__ void phase_modulate0(const Frame& F, const float* x, const float* gain, const float* modall, int sh_col, int sc_col, bf16* h) {
    for (int task = F.gw; task < T / 16; task += F.NGW) {
        const int r0 = task * 16, b = r0 >> 11; ModVec mv; load_modvec(mv, gain, modall + (size_t)b * MODC + sc_col, modall + (size_t)b * MODC + sh_col, F.lane);
        f32x4 nx[4];
#pragma unroll
        for (int j = 0; j < 4; ++j) nx[j] = *(const f32x4*)(x + (size_t)r0 * D + 4 * F.lane + 256 * j);
        for (int i = 0; i < 16; ++i) { f32x4 v[4]; float ss = 0.f;
#pragma unroll
            for (int j = 0; j < 4; ++j) { v[j] = nx[j]; ss += dot4(v[j]); }
            if (i + 1 < 16) {
#pragma unroll
                for (int j = 0; j < 4; ++j) nx[j] = *(const f32x4*)(x + (size_t)(r0 + i + 1) * D + 4 * F.lane + 256 * j); }
            const float rstd = 1.0f / sqrtf(wave_sum(ss) * (1.0f / D) + EPS);
#pragma unroll
            for (int j = 0; j < 4; ++j) v[j] = v[j] * rstd * mv.a[j] + mv.b[j];
            store_bf16_row(h + (size_t)(r0 + i) * D, v, F.lane); }
    }
}
__device__ __forceinline__ void phase_subln(const Frame& F, const bf16* OP, const float* lamv  , const float* subln  , float lam_init, bf16* O) {
    float lam; { const float p1 = wave_sum(lamv[F.lane] * lamv[64 + F.lane]), p2 = wave_sum(lamv[128 + F.lane] * lamv[192 + F.lane]); lam = __expf(p1) - __expf(p2) + lam_init; }
    const f32x4 gsub = *(const f32x4*)(subln + ((4 * F.lane) & 127)) * (1.0f - lam_init);
    for (int task = F.gw; task < T / 16; task += F.NGW) {
        v2u n0[4], n1[4];
#pragma unroll
        for (int j = 0; j < 4; ++j) { const size_t o_ = (size_t)(task * 16) * D + 4 * F.lane + 256 * j; n0[j] = *(const v2u*)(OP + o_); n1[j] = *(const v2u*)(OP + (size_t)T * D + o_); }
        for (int i = 0; i < 16; ++i) { const size_t ro = (size_t)(task * 16 + i) * D; f32x4 v[4]; v2u c0[4], c1[4];
#pragma unroll
            for (int j = 0; j < 4; ++j) { c0[j] = n0[j]; c1[j] = n1[j]; }
            if (i + 1 < 16) {
#pragma unroll
                for (int j = 0; j < 4; ++j) { const size_t o_ = ro + D + 4 * F.lane + 256 * j; n0[j] = *(const v2u*)(OP + o_); n1[j] = *(const v2u*)(OP + (size_t)T * D + o_); } }
#pragma unroll
            for (int j = 0; j < 4; ++j) { v[j] = unpack4(c0[j]) - unpack4(c1[j]) * lam; float ss = dot4(v[j]);
#pragma unroll
                for (int o = 1; o < 32; o <<= 1) ss += __shfl_xor(ss, o);
                v[j] = v[j] * (1.0f / sqrtf(ss * (1.0f / 128.0f) + EPS)) * gsub; }
            store_bf16_row(O + ro, v, F.lane); }
    }
}
__device__ __forceinline__ void phase_merge(const Frame& F, const bf16* OG, const float* LSE, bf16* O) {
    for (int task = F.gw; task < T / 16; task += F.NGW) {
        v2u n0[4], n1[4], n2[4]; float nl0[4], nl1[4], nl2[4];
#define MRG_LOAD(row_) do { _Pragma("unroll") for (int j = 0; j < 4; ++j) { const int c = 4 * F.lane + 256 * j, head = c >> 6; const size_t o_ = (size_t)(row_) * D + c, l_ = (size_t)(row_) * 16 + head; \
            n0[j] = *(const v2u*)(OG + o_); n1[j] = *(const v2u*)(OG + (size_t)T * D + o_); n2[j] = *(const v2u*)(OG + (size_t)2 * T * D + o_); nl0[j] = LSE[l_]; nl1[j] = LSE[(size_t)T * 16 + l_]; nl2[j] = LSE[(size_t)2 * T * 16 + l_]; } } while (0)
        MRG_LOAD(task * 16);
        for (int i = 0; i < 16; ++i) { const int row = task * 16 + i; f32x4 v[4]; v2u c0[4], c1[4], c2[4]; float l0[4], l1[4], l2[4];
#pragma unroll
            for (int j = 0; j < 4; ++j) { c0[j] = n0[j]; c1[j] = n1[j]; c2[j] = n2[j]; l0[j] = nl0[j]; l1[j] = nl1[j]; l2[j] = nl2[j]; }
            if (i + 1 < 16) MRG_LOAD(row + 1);
#pragma unroll
            for (int j = 0; j < 4; ++j) {
                const float mx = fmaxf(l0[j], fmaxf(l1[j], l2[j])); const float a0 = __builtin_amdgcn_exp2f(l0[j] - mx), a1 = __builtin_amdgcn_exp2f(l1[j] - mx), a2 = __builtin_amdgcn_exp2f(l2[j] - mx); const float inv = 1.0f / (a0 + a1 + a2);
                v[j] = (unpack4(c0[j]) * a0 + unpack4(c1[j]) * a1 + unpack4(c2[j]) * a2) * inv; }
            store_bf16_row(O + (size_t)row * D, v, F.lane); }
#undef MRG_LOAD
    }
}
__device__ __forceinline__ void phase_mod2_router(const Frame& F, const float* x, const float* gain, const float* modall, int sh_col, int sc_col, const bf16* rfrag, const float* rb,
                                                  bf16* h2, int* tk_e, float* tk_w, int* tk_l, int* wgcnt) {
    LAS int* hist = (LAS int*)(F.lds + HIST_OFF);
    if (F.tid < NE) hist[F.tid] = 0;
    __syncthreads();
    const int r = F.lane & 15, kq = F.lane >> 4;
    for (int task = F.gw; task < T / 16; task += F.NGW) {
        const int r0 = task * 16, b = r0 >> 11; const float* xr = x + (size_t)(r0 + r) * D + 8 * kq;
        float ss = 0.f;
#pragma unroll 16
        for (int s = 0; s < 32; ++s) ss += dot4(*(const f32x4*)(xr + 32 * s)) + dot4(*(const f32x4*)(xr + 32 * s + 4));
        ss += __shfl_xor(ss, 16); ss += __shfl_xor(ss, 32);
        const float rstd = 1.0f / sqrtf(ss * (1.0f / D) + EPS);
        const float* gp = gain + 8 * kq; const float* scp = modall + (size_t)b * MODC + sc_col + 8 * kq; const float* shp = modall + (size_t)b * MODC + sh_col + 8 * kq;
        bf16* hr = h2 + (size_t)(r0 + r) * D + 8 * kq;
        f32x4 acc0 = (f32x4){0.f, 0.f, 0.f, 0.f}, acc1 = acc0;
#pragma unroll 8
        for (int s = 0; s < 32; ++s) {
            const f32x4 xa = *(const f32x4*)(xr + 32 * s), xb = *(const f32x4*)(xr + 32 * s + 4);
            const f32x4 ga = *(const f32x4*)(gp + 32 * s), gb = *(const f32x4*)(gp + 32 * s + 4), sa = *(const f32x4*)(scp + 32 * s), sb = *(const f32x4*)(scp + 32 * s + 4), ha = *(const f32x4*)(shp + 32 * s), hb = *(const f32x4*)(shp + 32 * s + 4);
            const f32x4 va = xa * rstd * ga * (sa + 1.0f) + ha, vb = xb * rstd * gb * (sb + 1.0f) + hb;
            bf16x8 Ahi, Alo;
#pragma unroll
            for (int j = 0; j < 4; ++j) { const unsigned h0 = f2bf(va[j]), h1 = f2bf(vb[j]); Ahi[j] = (short)h0; Ahi[4 + j] = (short)h1; Alo[j] = (short)f2bf(va[j] - bf2f(h0)); Alo[4 + j] = (short)f2bf(vb[j] - bf2f(h1)); }
            if (MOE_F8) { v2u w8; w8.x = pg8::pk4_fp8(va[0], va[1], va[2], va[3]); w8.y = pg8::pk4_fp8(vb[0], vb[1], vb[2], vb[3]); *(v2u*)((unsigned char*)h2 + (size_t)(r0 + r) * D + 8 * kq + 32 * s) = w8; }
            else *(bf16x8*)(hr + 32 * s) = Ahi;
            const bf16* fp = rfrag + (size_t)s * 2048 + F.lane * 8;
            const bf16x8 Bh0 = *(const bf16x8*)(fp), Bl0 = *(const bf16x8*)(fp + 512), Bh1 = *(const bf16x8*)(fp + 1024), Bl1 = *(const bf16x8*)(fp + 1536);
            acc0 = __builtin_amdgcn_mfma_f32_16x16x32_bf16(Ahi, Bh0, acc0, 0, 0, 0); acc0 = __builtin_amdgcn_mfma_f32_16x16x32_bf16(Alo, Bh0, acc0, 0, 0, 0); acc0 = __builtin_amdgcn_mfma_f32_16x16x32_bf16(Ahi, Bl0, acc0, 0, 0, 0);
            acc1 = __builtin_amdgcn_mfma_f32_16x16x32_bf16(Ahi, Bh1, acc1, 0, 0, 0); acc1 = __builtin_amdgcn_mfma_f32_16x16x32_bf16(Alo, Bh1, acc1, 0, 0, 0); acc1 = __builtin_amdgcn_mfma_f32_16x16x32_bf16(Ahi, Bl1, acc1, 0, 0, 0);
        }
        const float b0 = rb[r], b1 = rb[16 + r];
#pragma unroll
        for (int reg = 0; reg < 4; ++reg) {
            float v0 = acc0[reg] + b0, v1 = acc1[reg] + b1; float tv[4]; int te[4];
#pragma unroll
            for (int k = 0; k < 4; ++k) {
                float bv = (v0 >= v1) ? v0 : v1; int be = (v0 >= v1) ? r : 16 + r;
#pragma unroll
                for (int o = 1; o < 16; o <<= 1) { const float ov = __shfl_xor(bv, o); const int oe = __shfl_xor(be, o); if (ov > bv || (ov == bv && oe < be)) { bv = ov; be = oe; } }
                tv[k] = bv; te[k] = be; if (be == r) v0 = -INFINITY; if (be == 16 + r) v1 = -INFINITY;
            }
            const float p1 = __expf(tv[1] - tv[0]), p2 = __expf(tv[2] - tv[0]), p3 = __expf(tv[3] - tv[0]); const float inv = 1.0f / (1.0f + p1 + p2 + p3);
            if (r == 0) { const int row = r0 + 4 * kq + reg; const float pw[4] = {inv, p1 * inv, p2 * inv, p3 * inv};
#pragma unroll
                for (int k = 0; k < 4; ++k) { tk_e[row * 4 + k] = te[k]; tk_w[row * 4 + k] = pw[k]; tk_l[row * 4 + k] = __hip_atomic_fetch_add(hist + te[k], 1, __ATOMIC_RELAXED, __HIP_MEMORY_SCOPE_WORKGROUP); } }
        }
    }
    __syncthreads();
    if (F.tid < NE) wgcnt[F.bid * NE + F.tid] = hist[F.tid];
}
__device__ __forceinline__ void phase_scatter(const Frame& F, const int* wgcnt, const int* tk_e, const int* tk_l, int* slot_of, int* rowtok, int* texp, unsigned* ntiles) {
    LAS int* cnt = (LAS int*)F.lds; LAS int* tot = (LAS int*)(F.lds + 65536); LAS int* bas = tot + 32; LAS int* eoff = tot + 64;
    for (int i = F.tid; i < F.G * NE; i += NWAVES * 64) cnt[i] = wgcnt[i];
    __syncthreads();
    if (F.tid < NE) { int t = 0, bs = 0; for (int w = 0; w < F.G; ++w) { const int c = cnt[w * NE + F.tid]; bs += (w < F.bid) ? c : 0; t += c; } tot[F.tid] = t; bas[F.tid] = bs; }
    __syncthreads();
    if (F.tid == 0) { int off = 0; for (int e = 0; e < NE; ++e) { eoff[e] = off; off += (tot[e] + 255) & ~255; } eoff[NE] = off; }
    __syncthreads();
    if (F.bid == 0) { if (F.tid < NE) { for (int pm = eoff[F.tid] >> 8; pm < (eoff[F.tid + 1] >> 8); ++pm) texp[pm] = F.tid; } if (F.tid == 0) __hip_atomic_store(ntiles, (unsigned)(eoff[NE] >> 8), RLX_AGENT);
        for (int e = 0; e < NE; ++e) for (int sl = eoff[e] + tot[e] + F.tid; sl < eoff[e + 1]; sl += NWAVES * 64) rowtok[sl] = 0; }
    for (int task = F.gw; task < T / 16; task += F.NGW) {
        const int r0 = task * 16, row = r0 + (F.lane >> 2); const int idx = row * 4 + (F.lane & 3);
        const int e = tk_e[idx], slot = eoff[e] + bas[e] + tk_l[idx]; slot_of[idx] = slot; rowtok[slot] = row;
    }
}
__device__ __forceinline__ void phase_combine(const Frame& F, float* x, const bf16* Y, const int* slot_of, const float* tk_w, const float* g2base  , int mode,
                                              const float* gainA, const float* modall, int shA, int scA, bf16* h, const float* gainB, int shB, int scB, bf16* hkv, float* out) {
    for (int task = F.gw; task < T / 16; task += F.NGW) {
        const int r0 = task * 16, b = r0 >> 11; ModVec mv, mk; f32x4 g2[4];
        load_modvec(mv, gainA, modall + (size_t)b * MODC + scA, modall + (size_t)b * MODC + shA, F.lane);
        if (mode == 1) load_modvec(mk, gainB, modall + (size_t)b * MODC + scB, modall + (size_t)b * MODC + shB, F.lane);
#pragma unroll
        for (int j = 0; j < 4; ++j) g2[j] = *(const f32x4*)(g2base + (size_t)b * MODC + 4 * F.lane + 256 * j);
        const int myslot = slot_of[r0 * 4 + F.lane]; const float myw = tk_w[r0 * 4 + F.lane];
        v2u ny[4][4]; f32x4 nx[4];
#define CMB_LOAD(i_) do { _Pragma("unroll") for (int k = 0; k < 4; ++k) { const bf16* yr = Y + (size_t)__shfl(myslot, (i_) * 4 + k) * D; _Pragma("unroll") for (int j = 0; j < 4; ++j) ny[k][j] = *(const v2u*)(yr + 4 * F.lane + 256 * j); } \
            _Pragma("unroll") for (int j = 0; j < 4; ++j) nx[j] = *(const f32x4*)(x + (size_t)(r0 + (i_)) * D + 4 * F.lane + 256 * j); } while (0)
        CMB_LOAD(0);
        for (int i = 0; i < 16; ++i) { const size_t ro = (size_t)(r0 + i) * D; f32x4 acc[4]; v2u cy[4][4]; f32x4 cx[4];
#pragma unroll
            for (int j = 0; j < 4; ++j) { acc[j] = (f32x4){0.f, 0.f, 0.f, 0.f}; cx[j] = nx[j];
#pragma unroll
                for (int k = 0; k < 4; ++k) cy[k][j] = ny[k][j]; }
            if (i + 1 < 16) CMB_LOAD(i + 1);
#pragma unroll
            for (int k = 0; k < 4; ++k) { const float w = __shfl(myw, i * 4 + k);
#pragma unroll
                for (int j = 0; j < 4; ++j) acc[j] += unpack4(cy[k][j]) * w; }
            f32x4 v[4]; float ss = 0.f;
#pragma unroll
            for (int j = 0; j < 4; ++j) { v[j] = cx[j] + g2[j] * acc[j]; ss += dot4(v[j]); }
            if (mode != 2) {
#pragma unroll
                for (int j = 0; j < 4; ++j) *(f32x4*)(x + ro + 4 * F.lane + 256 * j) = v[j]; }
            const float rstd = 1.0f / sqrtf(wave_sum(ss) * (1.0f / D) + EPS);
            if (mode == 2) {
#pragma unroll
                for (int j = 0; j < 4; ++j) *(f32x4*)(out + ro + 4 * F.lane + 256 * j) = v[j] * rstd * mv.a[j] + mv.b[j];
            } else {
                f32x4 o[4];
#pragma unroll
                for (int j = 0; j < 4; ++j) o[j] = v[j] * rstd * mv.a[j] + mv.b[j];
                store_bf16_row(h + ro, o, F.lane);
                if (mode == 1) {
#pragma unroll
                    for (int j = 0; j < 4; ++j) o[j] = v[j] * rstd * mk.a[j] + mk.b[j];
                    store_bf16_row(hkv + ro, o, F.lane); }
            }
        }
#undef CMB_LOAD
    }
}

__device__ __forceinline__ int crow16(int i, int h) { return (i & 3) + 8 * (i >> 2) + 4 * h; }
constexpr int DIL_KIMG = 0, DIL_VIMG = 384 * 128, DIL_NKEY = 384;
struct DilUnit { int p, g, res_u, V0, dsh; };
__device__ __forceinline__ bool dil_unit(int n, int vcu, int G, DilUnit& U) {
    const int pi = n / 24, u = n - pi * 24; U.p = vcu + pi * G; if (U.p >= NB * 16) return false;
    const int g = u >> 3, uu = u & 7; U.g = g; U.dsh = 2 * g;
    if (g == 0) { U.res_u = 0; U.V0 = uu * 256; } else if (g == 1) { U.res_u = uu >> 1; U.V0 = (uu & 1) * 256; } else { U.res_u = 2 * uu; U.V0 = 0; }
    return true;
}
__device__ __forceinline__ void dil_glds(const void* gsrc, unsigned lds_dst) { unsigned keep;
    asm volatile("s_mov_b32 %0, m0\n\ts_mov_b32 m0, %2\n\ts_nop 0\n\tglobal_load_lds_dwordx4 %1, off\n\ts_mov_b32 m0, %0" : "=&s"(keep) : "v"(gsrc), "s"(lds_dst) : "memory"); }
__device__ __forceinline__ int dil_keyrow(const DilUnit& U, int slot) { int rs, vk; if (U.g == 2) { rs = U.res_u + ((slot >> 7) & 1); vk = slot & 127; } else { rs = U.res_u; vk = U.V0 - 128 + slot; vk = vk < 0 ? 0 : vk; } return rs + (vk << U.dsh); }
__device__ __forceinline__ void dil_stage_k(const DilUnit& U, const bf16* KV, unsigned ldsb, int wave, int lane) {
    const bf16* Kg = KV + (size_t)U.p * S * 64;
#pragma unroll
    for (int it = 0; it < 6; ++it) { const int wi = it * 8 + wave, slot = wi * 8 + (lane >> 3), ch = (lane & 7) ^ ((slot >> 1) & 7);
        dil_glds(Kg + (size_t)dil_keyrow(U, slot) * 64 + ch * 8, (unsigned)__builtin_amdgcn_readfirstlane((int)(ldsb + DIL_KIMG + wi * 1024))); }
}
__device__ __forceinline__ void dil_stage_v(const DilUnit& U, const bf16* KV, unsigned ldsb, int wave, int lane) {
    const bf16* Vg = KV + (size_t)T * D + (size_t)U.p * S * 64;
#pragma unroll
    for (int it = 0; it < 6; ++it) { const int w2 = it * 8 + wave, dh = w2 / 24, blk16 = w2 - dh * 24, slot = blk16 * 16 + (lane >> 2);
        dil_glds(Vg + (size_t)dil_keyrow(U, slot) * 64 + dh * 32 + (lane & 3) * 8, (unsigned)__builtin_amdgcn_readfirstlane((int)(ldsb + DIL_VIMG + dh * (DIL_NKEY * 64) + blk16 * 1024))); }
}
__device__ __forceinline__ void phase_dilated(const Frame& F, const bf16* Q3, const bf16* KV, bf16* OG, float* LSE) {
    const int lane = F.lane, r = lane & 31, h = lane >> 5, wave = F.wave;
    const int vcu = (F.G % 8 == 0) ? (F.bid % 8) * (F.G / 8) + F.bid / 8 : F.bid;
    const unsigned ldsb = (unsigned)(uintptr_t)F.lds;
    DilUnit U, Un;
    if (!dil_unit(0, vcu, F.G, U)) return;
    dil_stage_k(U, KV, ldsb, wave, lane); dil_stage_v(U, KV, ldsb, wave, lane);
    bf16x8 qf[4], qn[4];
    { const int resw = (U.g == 2) ? U.res_u + (wave >> 2) : U.res_u, v0 = (U.g == 2) ? (wave & 3) * 32 : U.V0 + wave * 32; const int qrow = (U.p >> 4) * S + resw + ((v0 + r) << U.dsh);
      const bf16* qp = Q3 + (size_t)qrow * (3 * D) + U.g * D + (U.p & 15) * 64 + 8 * h;
#pragma unroll
      for (int ds = 0; ds < 4; ++ds) qf[ds] = *(const bf16x8*)(qp + 16 * ds); }
    asm volatile("s_waitcnt vmcnt(0)" ::: "memory"); __builtin_amdgcn_s_barrier(); asm volatile("" ::: "memory");
    for (int n = 0;; ++n) {
        const bool has_next = dil_unit(n + 1, vcu, F.G, Un);
        const int g = U.g, dsh = U.dsh, head = U.p & 15, rowbase = (U.p >> 4) * S;
        const int resw = (g == 2) ? U.res_u + (wave >> 2) : U.res_u, v0 = (g == 2) ? (wave & 3) * 32 : U.V0 + wave * 32, kbase = (g == 2) ? (wave >> 2) * 128 : 128 - U.V0;
        const int qrow = rowbase + resw + ((v0 + r) << dsh);
        const int jstart = (v0 >= 128) ? 0 : ((128 - v0) >> 5);
        f32x16 sc[5]; float m = -INFINITY;
#pragma unroll
        for (int j = 0; j < 5; ++j) {
#pragma unroll
            for (int i = 0; i < 16; ++i) sc[j][i] = -INFINITY;
            if (j >= jstart) {
                const int kr = kbase + v0 - 128 + 32 * j + r; const LAS unsigned char* krow = F.lds + DIL_KIMG + kr * 128; const int sw = (kr >> 1) & 7;
                f32x16 pacc;
#pragma unroll
                for (int i = 0; i < 16; ++i) pacc[i] = 0.f;
#pragma unroll
                for (int ds = 0; ds < 4; ++ds) { const bf16x8 kf = *(const LAS bf16x8*)(krow + (((2 * ds + h) ^ sw) << 4)); pacc = __builtin_amdgcn_mfma_f32_32x32x16_bf16(kf, qf[ds], pacc, 0, 0, 0); }
                if (j == 0) {
#pragma unroll
                    for (int i = 0; i < 16; ++i) if (crow16(i, h) < r) pacc[i] = -INFINITY;
                }
                if (j == 4) {
#pragma unroll
                    for (int i = 0; i < 16; ++i) if (crow16(i, h) > r) pacc[i] = -INFINITY;
                }
                sc[j] = pacc;
#pragma unroll
                for (int i = 0; i < 16; i += 2) m = fmaxf(m, fmaxf(pacc[i], pacc[i + 1]));
            }
        }
        m = fmaxf(m, __shfl_xor(m, 32));
        asm volatile("s_waitcnt lgkmcnt(0)" ::: "memory"); __builtin_amdgcn_s_barrier(); asm volatile("" ::: "memory");
        if (has_next) {
            const int resn = (Un.g == 2) ? Un.res_u + (wave >> 2) : Un.res_u, v0n = (Un.g == 2) ? (wave & 3) * 32 : Un.V0 + wave * 32; const int qrn = (Un.p >> 4) * S + resn + ((v0n + r) << Un.dsh);
            const bf16* qp = Q3 + (size_t)qrn * (3 * D) + Un.g * D + (Un.p & 15) * 64 + 8 * h;
#pragma unroll
            for (int ds = 0; ds < 4; ++ds) qn[ds] = *(const bf16x8*)(qp + 16 * ds);
            asm volatile("" ::: "memory");
            dil_stage_k(Un, KV, ldsb, wave, lane);
        }
        float l = 0.f; bf16x8 pf[5][2];
#pragma unroll
        for (int j = 0; j < 5; ++j) {
            float rs = 0.f;
#pragma unroll
            for (int i = 0; i < 16; ++i) { sc[j][i] = __builtin_amdgcn_exp2f(sc[j][i] - m); rs += sc[j][i]; }
            l += rs;
#pragma unroll
            for (int s2 = 0; s2 < 2; ++s2) { v4u w; w.x = pg8::cvt_pk_bf16(sc[j][8 * s2], sc[j][8 * s2 + 1]); w.y = pg8::cvt_pk_bf16(sc[j][8 * s2 + 2], sc[j][8 * s2 + 3]); w.z = pg8::cvt_pk_bf16(sc[j][8 * s2 + 4], sc[j][8 * s2 + 5]); w.w = pg8::cvt_pk_bf16(sc[j][8 * s2 + 6], sc[j][8 * s2 + 7]); pf[j][s2] = __builtin_bit_cast(bf16x8, w); }
        }
        if (has_next) asm volatile("s_waitcnt vmcnt(6)" ::: "memory"); else asm volatile("s_waitcnt vmcnt(0)" ::: "memory");
        __builtin_amdgcn_s_barrier(); asm volatile("" ::: "memory");
        f32x16 o0, o1;
#pragma unroll
        for (int i = 0; i < 16; ++i) { o0[i] = 0.f; o1[i] = 0.f; }
        const int i16 = lane & 15, q4 = i16 >> 2, p4 = i16 & 3, blk = (lane >> 4) & 1;
#pragma unroll
        for (int j = 0; j < 5; ++j) {
            if (j >= jstart) {
                const int ks0 = kbase + v0 - 128 + 32 * j;
#pragma unroll
                for (int s2 = 0; s2 < 2; ++s2) {
#pragma unroll
                    for (int db = 0; db < 2; ++db) {
                        const LAS unsigned char* a0 = F.lds + DIL_VIMG + db * (DIL_NKEY * 64) + (ks0 + 16 * s2 + 4 * h + q4) * 64 + blk * 32 + p4 * 8;
                        const s16x4 lo = __builtin_bit_cast(s16x4, __builtin_amdgcn_ds_read_tr16_b64_v4i16((LAS s16x4*)a0));
                        const s16x4 hi = __builtin_bit_cast(s16x4, __builtin_amdgcn_ds_read_tr16_b64_v4i16((LAS s16x4*)(a0 + 8 * 64)));
                        const bf16x8 vf = (bf16x8){lo[0], lo[1], lo[2], lo[3], hi[0], hi[1], hi[2], hi[3]};
                        if (db == 0) o0 = __builtin_amdgcn_mfma_f32_32x32x16_bf16(vf, pf[j][s2], o0, 0, 0, 0); else o1 = __builtin_amdgcn_mfma_f32_32x32x16_bf16(vf, pf[j][s2], o1, 0, 0, 0);
                    }
                }
            }
        }
        asm volatile("s_waitcnt vmcnt(0) lgkmcnt(0)" ::: "memory"); __builtin_amdgcn_s_barrier(); asm volatile("" ::: "memory");
        const float lt = l + __shfl_xor(l, 32), inv = 1.0f / lt;
        bf16* op = OG + (size_t)g * T * D + (size_t)qrow * D + head * 64 + 4 * h;
#pragma unroll
        for (int ig = 0; ig < 4; ++ig) { v2u w0, w1; w0.x = pg8::cvt_pk_bf16(o0[4 * ig] * inv, o0[4 * ig + 1] * inv); w0.y = pg8::cvt_pk_bf16(o0[4 * ig + 2] * inv, o0[4 * ig + 3] * inv); w1.x = pg8::cvt_pk_bf16(o1[4 * ig] * inv, o1[4 * ig + 1] * inv); w1.y = pg8::cvt_pk_bf16(o1[4 * ig + 2] * inv, o1[4 * ig + 3] * inv);
            *(v2u*)(op + 8 * ig) = w0; *(v2u*)(op + 32 + 8 * ig) = w1; }
        if (h == 0) LSE[(size_t)g * T * 16 + (size_t)qrow * 16 + head] = m + __builtin_amdgcn_logf(lt);
        if (!has_next) break;
        asm volatile("" ::: "memory");
        dil_stage_v(Un, KV, ldsb, wave, lane);
        U = Un;
#pragma unroll
        for (int ds = 0; ds < 4; ++ds) qf[ds] = qn[ds];
    }
    asm volatile("s_waitcnt vmcnt(0)" ::: "memory");
}

#ifndef REP_P0
#define REP_P0 1
#endif
#ifndef REP_QKV
#define REP_QKV 1
#endif
#ifndef REP_ATTN
#define REP_ATTN 1
#endif
#ifndef REP_SUBLN
#define REP_SUBLN 1
#endif
#ifndef REP_DIL
#define REP_DIL 1
#endif
#ifndef REP_MERGE
#define REP_MERGE 1
#endif
#ifndef REP_M2R
#define REP_M2R 1
#endif
#ifndef REP_SCAT
#define REP_SCAT 1
#endif
#ifndef REP_GU
#define REP_GU 1
#endif
#ifndef REP_DN
#define REP_DN 1
#endif
__global__ void __launch_bounds__(NWAVES * 64, 2) yoco_fwd(Args a_unused) {
    extern __shared__ __attribute__((aligned(16))) unsigned char lds_raw[];
    int ph_lo, ph_hi; unsigned barx = 0;
    {
        ArgsP ap = (ArgsP)__builtin_amdgcn_kernarg_segment_ptr(); ph_lo = ap->ph_lo; ph_hi = ap->ph_hi;
        LAS unsigned char* l0 = (LAS unsigned char*)lds_raw;
        for (int u = threadIdx.x; u < (LDS_BYTES - MISC_OFF) / 4; u += NWAVES * 64) ((LAS unsigned*)(l0 + MISC_OFF))[u] = 0u;
        __syncthreads();
        if (ap->use_bar) { XcdBarrier b0 = xcd_barrier_post((unsigned*)(ap->ws + WS_CTL) + CW_BAR, (volatile LAS unsigned*)(l0 + MISC_OFF)); barx = b0.x; }
    }
    int ph = 0;
#define PH_BEGIN PH_BEGIN_R(1)
#define PH_BEGIN_R(R) if (ph_lo <= ph && ph < ph_hi) { ArgsP ap = (ArgsP)__builtin_amdgcn_kernarg_segment_ptr(); asm volatile("" : "+s"(ap)); unsigned char* ws = ap->ws; Frame F; { int t_ = threadIdx.x; asm volatile("" : "+v"(t_)); \
        unsigned lb_ = 0; asm volatile("" : "+s"(lb_)); F.lds = (LAS unsigned char*)lds_raw + lb_; F.tid = t_; F.lane = t_ & 63; F.wave = __builtin_amdgcn_readfirstlane(t_ >> 6); int g_ = gridDim.x, b_ = blockIdx.x; asm volatile("" : "+s"(g_), "+s"(b_)); F.G = g_; F.bid = b_; F.gw = b_ * NWAVES + F.wave; F.NGW = g_ * NWAVES; } \
        for (int rep_ = 0; rep_ < (R); ++rep_) { if (rep_ > 0) MK_BARRIER();
#define MK_BARRIER() do { XcdBarrier b_; b_.bar = (unsigned*)(ws + WS_CTL) + CW_BAR; b_.x = barx; b_.st = (volatile LAS unsigned*)(F.lds + MISC_OFF); xcd_barrier(b_); } while (0)
#define PH_END } if (ph + 1 < ph_hi) MK_BARRIER(); } ++ph;
#define P_MODALL ((float*)(ws + WS_MOD))
#define P_XRES ((float*)(ws + WS_X))
#define P_HBUF ((bf16*)(ws + WS_H))
#define P_HKV ((bf16*)(ws + WS_HKV))
#define P_QBUF ((bf16*)(ws + WS_Q))
#define P_KVSH ((bf16*)(ws + WS_KVSH))
#define P_OBUF ((bf16*)(ws + WS_O))
#define P_OPBUF ((bf16*)(ws + WS_OP))
#define P_LSE ((float*)(ws + WS_LSE))
#define P_HS ((bf16*)(ws + WS_HS))
#define P_ACT ((bf16*)(ws + WS_ACT))
#define P_Y ((bf16*)(ws + WS_Y))
#define P_TKE ((int*)(ws + WS_TKE))
#define P_TKW ((float*)(ws + WS_TKW))
#define P_TKL ((int*)(ws + WS_TKL))
#define P_SLOT ((int*)(ws + WS_SLOT))
#define P_WGCNT ((int*)(ws + WS_WGCNT))
#define P_TEXP ((int*)(ws + WS_TEXP))
#define P_NTW ((unsigned*)(ws + WS_NT))
#define P_ROWTOK ((int*)(ws + WS_ROWTOK))
#define P_COS ((const float*)(ws + WS_ROPE))
#define P_SIN ((const float*)(ws + WS_ROPE) + S * 8)

    PH_BEGIN_R(REP_P0) p0_prologue(F, ap); PH_END
    PH_BEGIN phase_modulate0(F, ap->in[I_X], ap->in[I_MIXN], P_MODALL, 0, D, P_HBUF); PH_END

    for (int st = 0; st < 5; ++st) {
        const int kind = (st < 2) ? 0 : (st == 2 ? 1 : 2);
        const int l = (st < 2) ? st : st - 1;
        const int j = l - 2;
        PH_BEGIN_R(REP_QKV) {
            pg8::Gemm g; pg8::EpiRope E; int nN;
            if (kind == 0) { g = pg8::Gemm{P_HBUF, (const bf16*)(ws + WS_WQKV) + (size_t)l * 3 * D * D, T, 3 * D, D, 0}; nN = 12; E = pg8::EpiRope{P_QBUF, D, D, (size_t)T * D, 2 * D, D, QSCALE, P_COS, P_SIN, 0}; }
            else if (kind == 1) { g = pg8::Gemm{P_HKV, (const bf16*)(ws + WS_KVW), T, 2 * D, D, 0}; nN = 8; E = pg8::EpiRope{P_KVSH, 2 * D, 0, 0, D, 0, 1.0f, P_COS, P_SIN, 1}; }
            else { g = pg8::Gemm{P_HBUF, (const bf16*)(ws + WS_BWQ) + (size_t)j * 3 * D * D, T, 3 * D, D, 0}; nN = 12; E = pg8::EpiRope{P_QBUF, 3 * D, 0, 0, 3 * D, 3 * D, QSCALE, P_COS, P_SIN, 0}; }
            pg8::Order O; O.init(T / 256, nN, F.G, F.bid, nullptr, nullptr);
            pg8::gemm_phase<pg8::EpiRope, pg8::Order, false>(F.lds, g, O, E);
        } PH_END
        if (kind == 1) continue;
        if (kind == 0) {
            PH_BEGIN_R(REP_ATTN) {
                const attn_body::bf16* Qp = (const attn_body::bf16*)P_QBUF; const attn_body::bf16* Kp = Qp + (size_t)T * D; const attn_body::bf16* Vp = Kp + (size_t)T * D; attn_body::bf16* Op = (attn_body::bf16*)P_OPBUF;
                const int vcu = (F.G % 8 == 0) ? (F.bid % 8) * (F.G / 8) + F.bid / 8 : F.bid;
                for (int p = vcu; p < NB * 16; p += F.G) { const int b = p >> 4, hh = p & 15, hq = hh >> 1, mm = hh & 1;
                    for (int half = 0; half < 2; ++half)
                        for (int qb = 0; qb < S / 256; ++qb)
                            attn_body::attn_unit<8>(b, qb, Qp + hh * 64, Kp + hh * 64, Vp + hq * 128 + half * 64, Op + (size_t)mm * T * D + hq * 128 + half * 64, (char*)F.lds); }
            } PH_END
            PH_BEGIN_R(REP_SUBLN) phase_subln(F, P_OPBUF, ap->in[I_ALAM] + l * 256, ap->in[I_ASUBLN] + l * 128, ap->lam_init[l & 1], P_OBUF); PH_END
        } else {
            PH_BEGIN_R(REP_DIL) phase_dilated(F, P_QBUF, P_KVSH, P_OPBUF, P_LSE); PH_END
            PH_BEGIN_R(REP_MERGE) phase_merge(F, P_OPBUF, P_LSE, P_OBUF); PH_END
        }
        PH_BEGIN {
            const bf16* wo = (kind == 0) ? (const bf16*)(ws + WS_AWO) + (size_t)l * D * D : (const bf16*)(ws + WS_BWO) + (size_t)j * D * D;
            pg8::Gemm g{P_OBUF, wo, T, D, D, 0}; pg8::Order O; O.init(T / 256, 4, F.G, F.bid, nullptr, nullptr);
            pg8::EpiResid E{(l == 0) ? ap->in[I_X] : P_XRES, P_XRES, P_MODALL + l * 6 * D + 2 * D, MODC};
            pg8::gemm_phase<pg8::EpiResid, pg8::Order, false>(F.lds, g, O, E);
        } PH_END
        PH_BEGIN_R(REP_M2R) phase_mod2_router(F, P_XRES, ap->in[I_FFNN] + l * D, P_MODALL, l * 6 * D + 3 * D, l * 6 * D + 4 * D, (const bf16*)(ws + WS_RFRAG) + (size_t)l * 65536, ap->in[I_RB] + l * NE, P_HBUF, P_TKE, P_TKW, P_TKL, P_WGCNT); PH_END
        PH_BEGIN_R(REP_SCAT) phase_scatter(F, P_WGCNT, P_TKE, P_TKL, P_SLOT, P_ROWTOK, P_TEXP, P_NTW); PH_END
        PH_BEGIN_R(REP_GU) {
            const int nt = (int)__hip_atomic_load(P_NTW, RLX_AGENT); LAS int* tl = (LAS int*)(F.lds + TEXP_OFF); LAS int* rt = (LAS int*)(F.lds + ROWTAB_OFF);
            for (int i = F.tid; i < nt; i += NWAVES * 64) tl[i] = P_TEXP[i];
            __syncthreads();
            constexpr size_t ESZ = MOE_F8 ? 1 : 2;
            pg8::Gemm g{(const bf16*)P_HBUF, (const bf16*)(ws + WS_WGU + (size_t)l * NE * 2 * D * D * ESZ), nt * 256, 2 * D, D, (size_t)2 * D * D * ESZ}; pg8::OrderT<true> O; O.init(nt, 8, F.G, F.bid, tl, rt);
            { pg8::Unit u_; const int* rtk = P_ROWTOK; for (int i = 0; O.next(i, u_); ++i) if (F.tid < 256) rt[i * 256 + F.tid] = rtk[u_.pm * 256 + F.tid]; }
            __syncthreads();
            pg8::EpiSwiglu<MOE_F8 != 0> E{P_ACT, ap->in[I_BGU] + (size_t)l * NE * 2 * D};
            pg8::gemm_phase<pg8::EpiSwiglu<MOE_F8 != 0>, pg8::OrderT<true>, MOE_F8 != 0>(F.lds, g, O, E);
        } PH_END
        PH_BEGIN_R(REP_DN) {
            const int nt = (int)__hip_atomic_load(P_NTW, RLX_AGENT); LAS int* tl = (LAS int*)(F.lds + TEXP_OFF);
            for (int i = F.tid; i < nt; i += NWAVES * 64) tl[i] = P_TEXP[i];
            __syncthreads();
            constexpr size_t ESZ = MOE_F8 ? 1 : 2;
            pg8::Gemm g{P_ACT, (const bf16*)(ws + WS_WDN + (size_t)l * NE * D * D * ESZ), nt * 256, D, D, (size_t)D * D * ESZ}; pg8::Order O; O.init(nt, 4, F.G, F.bid, tl, nullptr);
            pg8::EpiDown E{P_Y, ap->in[I_BDN] + (size_t)l * NE * D};
            pg8::gemm_phase<pg8::EpiDown, pg8::Order, MOE_F8 != 0>(F.lds, g, O, E);
        } PH_END
        PH_BEGIN {
            const int mode = (l == 3) ? 2 : (l == 1 ? 1 : 0);
            const float* gainA = (l == 3) ? ap->in[I_FINN] : ap->in[I_MIXN] + (l + 1) * D; const int shA = (l == 3) ? MOD_FIN : (l + 1) * 6 * D, scA = shA + D;
            phase_combine(F, P_XRES, P_Y, P_SLOT, P_TKW, P_MODALL + l * 6 * D + 5 * D, mode, gainA, P_MODALL, shA, scA, P_HBUF, ap->in[I_KVN], MOD_KV, MOD_KV + D, P_HKV, ap->out);
        } PH_END
    }
#undef PH_BEGIN
#undef PH_END
}
constexpr int N_PHASES = 2 + 9 + 9 + 1 + 9 + 9;

#ifndef MK_PER_PHASE
#define MK_PER_PHASE 0
#endif
extern "C" void kernel_launch(void* const* d_in, const int* in_sizes, int n_in, void* d_out, int out_size, void* d_ws, size_t ws_size, hipStream_t stream) {
    static int grid = 0;
    if (grid == 0) {
        if (n_in != 25 || in_sizes[0] != T * D || out_size != T * D || ws_size < WS_END) { fprintf(stderr, "kernel_launch: unexpected shapes / workspace (n_in %d, ws %zu)\n", n_in, ws_size); grid = -1; return; }
        int dev = 0, cus = 0, per_cu = 0;
        if (hipGetDevice(&dev) != hipSuccess || hipDeviceGetAttribute(&cus, hipDeviceAttributeMultiprocessorCount, dev) != hipSuccess) { grid = -1; return; }
        if (hipFuncSetAttribute((const void*)yoco_fwd, hipFuncAttributeMaxDynamicSharedMemorySize, LDS_BYTES) != hipSuccess) { fprintf(stderr, "kernel_launch: hipFuncSetAttribute failed\n"); grid = -1; return; }
        if (hipOccupancyMaxActiveBlocksPerMultiprocessor(&per_cu, (const void*)yoco_fwd, NWAVES * 64, LDS_BYTES) != hipSuccess || per_cu < 1) fprintf(stderr, "kernel_launch: occupancy query reports %d\n", per_cu);
        (void)hipGetLastError();
        grid = cus;
    }
    if (grid < 0) return;
    if (hipMemsetAsync((char*)d_ws + WS_CTL, 0, CTL_ZERO_BYTES, stream) != hipSuccess) return;
    Args a{};
    for (int i = 0; i < 25; ++i) a.in[i] = (const float*)d_in[i];
    a.out = (float*)d_out; a.ws = (unsigned char*)d_ws;
    for (int i = 0; i < 8; ++i) a.invf[i] = (float)pow(500000.0, -(double)(2 * i) / 16.0);
    a.lam_init[0] = (float)(0.8 - 0.6 * exp(-0.3 * 0.0)); a.lam_init[1] = (float)(0.8 - 0.6 * exp(-0.3 * 1.0));
#if MK_PER_PHASE
    for (int p = 0; p < N_PHASES; ++p) { a.ph_lo = p; a.ph_hi = p + 1; a.use_bar = 0; hipLaunchKernelGGL(yoco_fwd, dim3(grid), dim3(NWAVES * 64), LDS_BYTES, stream, a); }
#else
    a.ph_lo = 0; a.ph_hi = N_PHASES; a.use_bar = 1; hipLaunchKernelGGL(yoco_fwd, dim3(grid), dim3(NWAVES * 64), LDS_BYTES, stream, a);
#endif
}
```

```cpp
#include <hip/hip_runtime.h>
#include <hip/hip_bf16.h>
#include <cstdio>
#include <cstdint>
#include <cmath>
namespace pg8 {
#define PG8_LAS __attribute__((address_space(3)))
typedef unsigned short bf16_t;
typedef short bf16x8 __attribute__((ext_vector_type(8)));
typedef float f32x4 __attribute__((ext_vector_type(4)));
typedef unsigned u32x4 __attribute__((ext_vector_type(4)));
constexpr int BM = 256, BK = 64, HALF = 128, HTB = HALF * BK * 2  , STAGE_BYTES = 8 * HTB, NXCD = 8, WGM = 8;

__host__ __device__ __forceinline__ int lds_byte(int r, int c) { const int st = (r >> 4) * 2 + (c >> 5), rr = r & 15, cc = c & 31, ob = rr * 64 + cc * 2; return st * 1024 + (ob ^ (((ob >> 9) & 1) << 5)); }
__host__ __device__ __forceinline__ void stage_rc(int b, int& R, int& C) { const int st = b / 1024, sb = b % 1024, swz = sb ^ (((sb >> 9) & 1) << 5); R = (st >> 1) * 16 + swz / 64; C = (st & 1) * 32 + (swz % 64) / 2; }
__host__ __device__ __forceinline__ int perm32(int rho) { const int n = rho >> 4, i = rho & 15; return 8 * (i >> 2) + 4 * n + (i & 3); }

struct Unit { int pm, pn, e, ui; };
struct Gemm { const bf16_t* A; const bf16_t* Bt; int M, N, K; size_t estride; };

template <bool GATHER> struct OrderT {
    int nM, nN, nwg, G, c; const PG8_LAS int* texp; const PG8_LAS int* rowtab;
    __device__ __forceinline__ void init(int nM_, int nN_, int G_, int c_, const PG8_LAS int* texp_, const PG8_LAS int* rowtab_) { nM = nM_; nN = nN_; nwg = nM * nN; G = G_; c = c_; texp = texp_; rowtab = rowtab_; }
    __device__ __forceinline__ bool next(int i, Unit& u) const {
        const long L = (long)i * G + c; if (L >= nwg) return false;
        int wgid = (int)L; { const int q = nwg / NXCD, r = nwg % NXCD, xcd = wgid % NXCD, off = wgid / NXCD; wgid = (xcd < r ? xcd * (q + 1) : r * (q + 1) + (xcd - r) * q) + off; }
        const int nig = WGM * nN, gid = wgid / nig, fm = gid * WGM, gsz = (nM - fm) < WGM ? (nM - fm) : WGM;
        u.pm = fm + ((wgid % nig) % gsz); u.pn = (wgid % nig) / gsz; u.e = texp ? texp[u.pm] : 0; u.ui = i; return true;
    }
    __device__ __forceinline__ int arow(const Unit& u, int r) const { if constexpr (GATHER) return rowtab[u.ui * 256 + r]; else return u.pm * 256 + r; }
};
typedef OrderT<false> Order;

__device__ __forceinline__ unsigned cvt_pk_bf16(float lo, float hi) { unsigned r; asm volatile("v_cvt_pk_bf16_f32 %0, %1, %2" : "=v"(r) : "v"(lo), "v"(hi)); return r; }
__device__ __forceinline__ unsigned pk4_fp8(float a, float b, float c, float d) { unsigned u = (unsigned)__builtin_amdgcn_cvt_pk_fp8_f32(a, b, 0, false); return (unsigned)__builtin_amdgcn_cvt_pk_fp8_f32(c, d, (int)u, true); }
__device__ __forceinline__ f32x4 shfl16(f32x4 v) { f32x4 o; o[0] = __shfl_xor(v[0], 16); o[1] = __shfl_xor(v[1], 16); o[2] = __shfl_xor(v[2], 16); o[3] = __shfl_xor(v[3], 16); return o; }

struct EpiRope {
    static constexpr bool PERM = true, AFTER_DRAIN = false;
    bf16_t* O; int ldc; int split_cols; size_t split_stride; int rope_cols, scale_cols; float qscale; const float* cosT; const float* sinT;
    int headmajor;
    __device__ __forceinline__ void operator()(const f32x4 (&acc)[2][2][4][2], const Unit& u, int wr, int wc, int fr, int fq) const {
        const int row0 = u.pm * BM + wr * 64 + fr; int colt = u.pn * BM; bf16_t* base = O;
        const bool do_rope = (colt < rope_cols) && ((wc & 1) == 0); const float sc = (colt < scale_cols) ? qscale : 1.f;
        if (split_cols) { const int t = colt / split_cols; base += (size_t)t * split_stride; colt -= t * split_cols; }
        const int col0 = colt + wc * 32 + 8 * fq;
#pragma unroll
        for (int ai = 0; ai < 2; ++ai)
#pragma unroll
            for (int m = 0; m < 4; ++m) { const int row = row0 + ai * HALF + m * 16; bf16_t* rowp = base + (size_t)row * ldc + col0;
                if (headmajor) { const int cc = col0; rowp = base + ((size_t)((((cc >> 10) * 16 + (row >> 11)) * 16 + ((cc >> 6) & 15))) * 2048 + (row & 2047)) * 64 + (cc & 63); }
                f32x4 c0 = (f32x4){1.f, 1.f, 1.f, 1.f}, c1 = c0, s0 = (f32x4){0.f, 0.f, 0.f, 0.f}, s1 = s0;
                if (do_rope) { const int t = row & 2047; c0 = *(const f32x4*)(cosT + t * 8); c1 = *(const f32x4*)(cosT + t * 8 + 4); s0 = *(const f32x4*)(sinT + t * 8); s1 = *(const f32x4*)(sinT + t * 8 + 4);
                    if (fq == 0) { s0 = -s0; s1 = -s1; } else if (fq >= 2) { c0 = (f32x4){1.f, 1.f, 1.f, 1.f}; c1 = c0; s0 = (f32x4){0.f, 0.f, 0.f, 0.f}; s1 = s0; } }
#pragma unroll
                for (int bj = 0; bj < 2; ++bj) { f32x4 v0 = acc[ai][bj][m][0], v1 = acc[ai][bj][m][1];
                    if (do_rope) { const f32x4 o0 = shfl16(v0), o1 = shfl16(v1); v0 = v0 * c0 + o0 * s0; v1 = v1 * c1 + o1 * s1; }
                    v0 = v0 * sc; v1 = v1 * sc; u32x4 w; w.x = cvt_pk_bf16(v0[0], v0[1]); w.y = cvt_pk_bf16(v0[2], v0[3]); w.z = cvt_pk_bf16(v1[0], v1[1]); w.w = cvt_pk_bf16(v1[2], v1[3]);
                    *(u32x4*)(rowp + (headmajor ? bj * (2 * 2048 * 64) : bj * HALF)) = w; } }
    }
};
struct EpiResid {
    static constexpr bool PERM = false, AFTER_DRAIN = false;
    const float* xin; float* xout; const float* gate; int gstride;
    __device__ __forceinline__ void operator()(const f32x4 (&acc)[2][2][4][2], const Unit& u, int wr, int wc, int fr, int fq) const {
        const int row0 = u.pm * BM + wr * 64 + fr, col0 = u.pn * BM + wc * 32 + 4 * fq; const float* gp = gate + (size_t)(u.pm >> 3) * gstride + col0;
        f32x4 gv[2][2];
#pragma unroll
        for (int bj = 0; bj < 2; ++bj)
#pragma unroll
            for (int n = 0; n < 2; ++n) gv[bj][n] = *(const f32x4*)(gp + bj * HALF + n * 16);
#pragma unroll
        for (int ai = 0; ai < 2; ++ai)
#pragma unroll
            for (int m = 0; m < 4; ++m) { const size_t off = (size_t)(row0 + ai * HALF + m * 16) * 1024 + col0;
#pragma unroll
                for (int bj = 0; bj < 2; ++bj)
#pragma unroll
                    for (int n = 0; n < 2; ++n) { const f32x4 xi = *(const f32x4*)(xin + off + bj * HALF + n * 16); *(f32x4*)(xout + off + bj * HALF + n * 16) = xi + gv[bj][n] * acc[ai][bj][m][n]; }
                if (m & 1) asm volatile("" ::: "memory"); }
    }
};
template <bool F8> struct EpiSwiglu {
    static constexpr bool PERM = true, AFTER_DRAIN = false;
    bf16_t* act; const float* bgu;
    __device__ __forceinline__ void operator()(const f32x4 (&acc)[2][2][4][2], const Unit& u, int wr, int wc, int fr, int fq) const {
        const int row0 = u.pm * BM + wr * 64 + fr, acol0 = u.pn * HALF + wc * 32 + 8 * fq; const float* bp = bgu + (size_t)u.e * 2048 + acol0;
        const f32x4 bg0 = *(const f32x4*)(bp), bg1 = *(const f32x4*)(bp + 4), bu0 = *(const f32x4*)(bp + 1024), bu1 = *(const f32x4*)(bp + 1028);
#pragma unroll
        for (int ai = 0; ai < 2; ++ai)
#pragma unroll
            for (int m = 0; m < 4; ++m) { const size_t eoff_ = (size_t)(row0 + ai * HALF + m * 16) * 1024 + acol0;
                f32x4 g0 = acc[ai][0][m][0] + bg0, g1 = acc[ai][0][m][1] + bg1, u0 = acc[ai][1][m][0] + bu0, u1 = acc[ai][1][m][1] + bu1; f32x4 r0, r1;
#pragma unroll
                for (int j = 0; j < 4; ++j) { const float ga = fminf(g0[j], 7.0f), gb = fminf(g1[j], 7.0f), ua = fminf(fmaxf(u0[j], -7.0f), 7.0f), ub = fminf(fmaxf(u1[j], -7.0f), 7.0f);
                    const float sa = __builtin_amdgcn_rcpf(1.0f + __builtin_amdgcn_exp2f(ga * (-1.702f * 1.4426950408889634f))), sb = __builtin_amdgcn_rcpf(1.0f + __builtin_amdgcn_exp2f(gb * (-1.702f * 1.4426950408889634f)));
                    r0[j] = (ua + 1.0f) * (ga * sa); r1[j] = (ub + 1.0f) * (gb * sb); }
                if constexpr (F8) { typedef unsigned u32x2_ __attribute__((ext_vector_type(2))); u32x2_ w; w.x = pk4_fp8(r0[0], r0[1], r0[2], r0[3]); w.y = pk4_fp8(r1[0], r1[1], r1[2], r1[3]); *(u32x2_*)((unsigned char*)act + eoff_) = w; }
                else { u32x4 w; w.x = cvt_pk_bf16(r0[0], r0[1]); w.y = cvt_pk_bf16(r0[2], r0[3]); w.z = cvt_pk_bf16(r1[0], r1[1]); w.w = cvt_pk_bf16(r1[2], r1[3]); *(u32x4*)(act + eoff_) = w; } }
    }
};
struct EpiDown {
    static constexpr bool PERM = true, AFTER_DRAIN = false;
    bf16_t* Y; const float* bd;
    __device__ __forceinline__ void operator()(const f32x4 (&acc)[2][2][4][2], const Unit& u, int wr, int wc, int fr, int fq) const {
        const int row0 = u.pm * BM + wr * 64 + fr, col0 = u.pn * BM + wc * 32 + 8 * fq; const float* bp = bd + (size_t)u.e * 1024 + col0;
        f32x4 bv[2][2];
#pragma unroll
        for (int bj = 0; bj < 2; ++bj)
#pragma unroll
            for (int n = 0; n < 2; ++n) bv[bj][n] = *(const f32x4*)(bp + bj * HALF + 4 * n);
#pragma unroll
        for (int ai = 0; ai < 2; ++ai)
#pragma unroll
            for (int m = 0; m < 4; ++m) { bf16_t* rowp = Y + (size_t)(row0 + ai * HALF + m * 16) * 1024 + col0;
#pragma unroll
                for (int bj = 0; bj < 2; ++bj) { const f32x4 v0 = acc[ai][bj][m][0] + bv[bj][0], v1 = acc[ai][bj][m][1] + bv[bj][1];
                    u32x4 w; w.x = cvt_pk_bf16(v0[0], v0[1]); w.y = cvt_pk_bf16(v0[2], v0[3]); w.z = cvt_pk_bf16(v1[0], v1[1]); w.w = cvt_pk_bf16(v1[2], v1[3]);
                    *(u32x4*)(rowp + bj * HALF) = w; } }
    }
};

typedef int v8i_t __attribute__((ext_vector_type(8)));
typedef int v4i_t __attribute__((ext_vector_type(4)));
template <class Epi, class Sched, bool F8>
__device__ __forceinline__ void gemm_phase(PG8_LAS unsigned char* lds, const Gemm g, const Sched& S, const Epi& E) {
    int tid_ = threadIdx.x; asm volatile("" : "+v"(tid_));
    const int tid = tid_, wid = __builtin_amdgcn_readfirstlane(tid >> 6), lane = tid & 63, wr = wid >> 2, wc = wid & 3, fr = lane & 15, fq = lane >> 4;
    constexpr int ROWB = F8 ? 1024 : 2048, nt = ROWB / 128;
    unsigned voffB[2], cvA0[2], cvA1[2];
#pragma unroll
    for (int i = 0; i < 2; ++i) { int R, C; stage_rc(tid * 16 + i * 8192, R, C); const int Rb = Epi::PERM ? ((R & ~31) + perm32(R & 31)) : R; voffB[i] = (unsigned)(Rb * ROWB) + (unsigned)C * 2u; }
    constexpr size_t kstep = 128;
    constexpr size_t hstep = (size_t)HALF * ROWB;
    constexpr size_t tstep = 2 * hstep;
    const unsigned ldsm0 = (unsigned)__builtin_amdgcn_readfirstlane((int)((unsigned)(uintptr_t)lds + (unsigned)wid * 1024u));
    unsigned abase_ = (unsigned)(uintptr_t)(lds + lds_byte(wr * 64 + fr, fq * 8)), bbase_ = (unsigned)(uintptr_t)(lds + 4 * HTB + lds_byte(wc * 32 + fr, fq * 8));
    asm volatile("" : "+v"(abase_), "+v"(bbase_));
    const PG8_LAS unsigned char* const abase = (const PG8_LAS unsigned char*)(uintptr_t)abase_; const PG8_LAS unsigned char* const bbase = (const PG8_LAS unsigned char*)(uintptr_t)bbase_;
#define PG8_SA(b, h) (((b) * 2 + (h)) * HTB)
#define PG8_SB(b, h) ((4 + (b) * 2 + (h)) * HTB)
#define PG8_STAGE(bufoff, gbase, voff) do { _Pragma("unroll") for (int _i = 0; _i < 2; ++_i) { unsigned keep_; \
        asm volatile("s_mov_b32 %0, m0\n\ts_mov_b32 m0, %3\n\ts_nop 0\n\tglobal_load_lds_dwordx4 %1, %2\n\ts_mov_b32 m0, %0" : "=&s"(keep_) : "v"((voff)[_i]), "s"((const char*)(gbase)), "s"(ldsm0 + (unsigned)((bufoff) + _i * 8192)) : "memory"); } } while (0)
#define PG8_RD(p) __builtin_bit_cast(v4i_t, *(const PG8_LAS bf16x8*)(p))
#define PG8_LDA(dst, b, h) do { _Pragma("unroll") for (int m = 0; m < 4; ++m) dst[m] = __builtin_shufflevector(PG8_RD(abase + PG8_SA(b, h) + m * 2048), PG8_RD(abase + PG8_SA(b, h) + m * 2048 + 1024), 0, 1, 2, 3, 4, 5, 6, 7); } while (0)
#define PG8_LDB(dst, b, h) do { _Pragma("unroll") for (int n = 0; n < 2; ++n) dst[n] = __builtin_shufflevector(PG8_RD(bbase + (PG8_SB(b, h) - 4 * HTB) + n * 2048), PG8_RD(bbase + (PG8_SB(b, h) - 4 * HTB) + n * 2048 + 1024), 0, 1, 2, 3, 4, 5, 6, 7); } while (0)
#define PG8_LO(x) __builtin_bit_cast(bf16x8, __builtin_shufflevector((x), (x), 0, 1, 2, 3))
#define PG8_HI(x) __builtin_bit_cast(bf16x8, __builtin_shufflevector((x), (x), 4, 5, 6, 7))
#define PG8_MMA(ai, bj, At, Bt) do { __builtin_amdgcn_s_setprio(1); \
        if constexpr (F8) { _Pragma("unroll") for (int m = 0; m < 4; ++m) _Pragma("unroll") for (int n = 0; n < 2; ++n) \
            acc[ai][bj][m][n] = __builtin_amdgcn_mfma_scale_f32_16x16x128_f8f6f4(Bt[n], At[m], acc[ai][bj][m][n], 0, 0, 0, 0x7b7b7b7b, 0, 0x7b7b7b7b);     } \
        else { _Pragma("unroll") for (int m = 0; m < 4; ++m) _Pragma("unroll") for (int n = 0; n < 2; ++n) { \
            acc[ai][bj][m][n] = __builtin_amdgcn_mfma_f32_16x16x32_bf16(PG8_LO(Bt[n]), PG8_LO(At[m]), acc[ai][bj][m][n], 0, 0, 0); \
            acc[ai][bj][m][n] = __builtin_amdgcn_mfma_f32_16x16x32_bf16(PG8_HI(Bt[n]), PG8_HI(At[m]), acc[ai][bj][m][n], 0, 0, 0); } } \
        __builtin_amdgcn_s_setprio(0); } while (0)
#define PG8_WAIT_V(n) asm volatile("s_waitcnt vmcnt(" #n ")" ::: "memory")
#define PG8_WAIT_L(n) asm volatile("s_waitcnt lgkmcnt(" #n ")" ::: "memory")
#define PG8_BAR __builtin_amdgcn_s_barrier()
#define PG8_SCHED __builtin_amdgcn_sched_barrier(0)
    Unit cur, nxt; int ui = 0;
    if (!S.next(0, cur)) return;
    f32x4 acc[2][2][4][2];
#pragma unroll
    for (int a = 0; a < 2; ++a)
#pragma unroll
        for (int b = 0; b < 2; ++b)
#pragma unroll
            for (int m = 0; m < 4; ++m)
#pragma unroll
                for (int n = 0; n < 2; ++n) acc[a][b][m][n] = (f32x4){0.f, 0.f, 0.f, 0.f};
    v8i_t At[4], B0[2], B1[2];
    const char* const Ab = (const char*)g.A;
#pragma unroll
    for (int i = 0; i < 2; ++i) { int R, C; stage_rc(tid * 16 + i * 8192, R, C); cvA0[i] = (unsigned)S.arow(cur, R) * (unsigned)ROWB + (unsigned)C * 2u; cvA1[i] = (unsigned)S.arow(cur, HALF + R) * (unsigned)ROWB + (unsigned)C * 2u; }
    const char* cB = (const char*)g.Bt + (size_t)cur.pn * tstep + (size_t)cur.e * g.estride;
    PG8_STAGE(PG8_SB(0, 0), cB, voffB); PG8_STAGE(PG8_SB(0, 1), cB + hstep, voffB); PG8_STAGE(PG8_SA(0, 0), Ab, cvA0); PG8_STAGE(PG8_SA(0, 1), Ab, cvA1);
    if (wr == 1) PG8_BAR;
    PG8_WAIT_V(2); PG8_BAR;
    PG8_STAGE(PG8_SB(1, 0), cB + kstep, voffB); PG8_STAGE(PG8_SA(1, 0), Ab + kstep, cvA0); PG8_STAGE(PG8_SB(1, 1), cB + hstep + kstep, voffB);
    PG8_WAIT_V(6); PG8_BAR;
    for (;;) {
        const bool has_next = S.next(ui + 1, nxt);
        const char* nB = has_next ? (const char*)g.Bt + (size_t)nxt.pn * tstep + (size_t)nxt.e * g.estride : cB;
#pragma clang loop unroll(disable)
        for (int t = 0; t < nt; t += 2) {
            const bool last = (t == nt - 2);
            const char* a1 = Ab + (size_t)(t + 1) * kstep;
            const char* a2 = last ? Ab : Ab + (size_t)(t + 2) * kstep; const char* b2 = last ? nB : cB + (size_t)(t + 2) * kstep;
            const char* a3 = a2 + kstep; const char* b3 = b2 + kstep;
            PG8_LDB(B0, 0, 0); PG8_LDB(B1, 0, 1); PG8_SCHED; PG8_LDA(At, 0, 0); PG8_STAGE(PG8_SA(1, 1), a1, cvA1);
            if (last && has_next) {
                int t2_ = tid; asm volatile("" : "+v"(t2_));
#pragma unroll
                for (int i = 0; i < 2; ++i) { int R, C; stage_rc(t2_ * 16 + i * 8192, R, C); cvA0[i] = (unsigned)S.arow(nxt, R) * (unsigned)ROWB + (unsigned)C * 2u; cvA1[i] = (unsigned)S.arow(nxt, HALF + R) * (unsigned)ROWB + (unsigned)C * 2u; }
            }
            PG8_WAIT_V(8); PG8_WAIT_L(0); PG8_BAR; PG8_MMA(0, 0, At, B0); PG8_MMA(0, 1, At, B1); PG8_BAR; PG8_SCHED;
            PG8_LDA(At, 0, 1); PG8_STAGE(PG8_SB(0, 0), b2, voffB); PG8_STAGE(PG8_SB(0, 1), b2 + hstep, voffB); PG8_STAGE(PG8_SA(0, 0), a2, cvA0);
            PG8_WAIT_V(8); PG8_WAIT_L(0); PG8_BAR; PG8_MMA(1, 0, At, B0); PG8_MMA(1, 1, At, B1); PG8_BAR; PG8_SCHED;
            PG8_LDB(B0, 1, 0); PG8_LDB(B1, 1, 1); PG8_SCHED; PG8_LDA(At, 1, 0); PG8_STAGE(PG8_SA(0, 1), a2, cvA1);
            PG8_WAIT_V(8); PG8_WAIT_L(0); PG8_BAR; PG8_MMA(0, 0, At, B0); PG8_MMA(0, 1, At, B1); PG8_BAR; PG8_SCHED;
            PG8_LDA(At, 1, 1); PG8_STAGE(PG8_SB(1, 0), b3, voffB); PG8_STAGE(PG8_SB(1, 1), b3 + hstep, voffB); PG8_STAGE(PG8_SA(1, 0), a3, cvA0);
            PG8_WAIT_V(8); PG8_WAIT_L(0); PG8_BAR; PG8_MMA(1, 0, At, B0); PG8_MMA(1, 1, At, B1); PG8_BAR; PG8_SCHED;
        }
        if (wr == 0) PG8_BAR;
        E(acc, cur, wr, wc, fr, fq);
        if (!has_next) break;
#pragma unroll
        for (int a = 0; a < 2; ++a)
#pragma unroll
            for (int b = 0; b < 2; ++b)
#pragma unroll
                for (int m = 0; m < 4; ++m)
#pragma unroll
                    for (int n = 0; n < 2; ++n) acc[a][b][m][n] = (f32x4){0.f, 0.f, 0.f, 0.f};
        cur = nxt; cB = nB; ++ui;
        if (wr == 1) PG8_BAR;
    }
    PG8_WAIT_V(0);
    PG8_BAR;
#undef PG8_SA
#undef PG8_SB
#undef PG8_STAGE
#undef PG8_LDA
#undef PG8_LDB
#undef PG8_RD
#undef PG8_LO
#undef PG8_HI
#undef PG8_MMA
#undef PG8_WAIT_V
#undef PG8_WAIT_L
#undef PG8_BAR
#undef PG8_SCHED
}
}
namespace attn_body {
using bf16=__hip_bfloat16;
using bf16x8=__attribute__((ext_vector_type(8)))short;
using s16x4=__attribute__((ext_vector_type(4)))short;
using f32x16=__attribute__((ext_vector_type(16)))float;
using u32x4=__attribute__((ext_vector_type(4)))unsigned;
constexpr int BATCH=16,NHEAD=16,SEQ=2048,D=64,DM=NHEAD*D;
constexpr int NW=8,QBLK=32,QB=QBLK*NW,KVBLK=64,NQB=SEQ/QB;
constexpr int ATTN_PITCH=DM, ATTN_UNIT_ROWS=QB;
__device__ __forceinline__ int crow(int r,int hi){return (r&3)+8*(r>>2)+4*hi;}
#define SBAR() __builtin_amdgcn_sched_barrier(0)
__device__ __forceinline__ void cmask(f32x16&p0,f32x16&p1,int jb,int qrel,int hi){
  const float NEG=-INFINITY; int kb=64*jb+4*hi;
  #pragma unroll
  for(int r=0;r<16;++r){int kv=kb+(r&3)+8*(r>>2); if(kv>qrel)p0[r]=NEG; if(kv+32>qrel)p1[r]=NEG;}
}

constexpr int NSLOT=3, SLOTB=8192;
constexpr int LDS_K=0, LDS_V=NSLOT*SLOTB, LDS_WS=2*NSLOT*SLOTB, LDS_OST=LDS_WS+NW*64*4, LDS_BYTES=LDS_OST+NW*4096;
constexpr float C2=0.125f*1.4426950408889634f;
__device__ __forceinline__ void glds16(const void*gsrc,unsigned lds_dst){unsigned keep;
  asm volatile("s_mov_b32 %0, m0\n\ts_mov_b32 m0, %2\n\ts_nop 0\n\tglobal_load_lds_dwordx4 %1, off\n\ts_mov_b32 m0, %0":"=&s"(keep):"v"(gsrc),"s"(lds_dst):"memory");}
__device__ __forceinline__ float max3f(float a,float b,float c){float r;asm("v_max3_f32 %0, %1, %2, %3":"=v"(r):"v"(a),"v"(b),"v"(c));return r;}
__device__ __forceinline__ float max2f(float a,float b){float r;asm("v_max_f32_e32 %0, %1, %2":"=v"(r):"v"(a),"v"(b));return r;}
__device__ __forceinline__ float fadd_s(float a,float b){float r;asm("v_add_f32_e32 %0, %1, %2":"=v"(r):"v"(a),"v"(b));return r;}
__device__ __forceinline__ float fsub_s(float a,float b){float r;asm("v_sub_f32_e32 %0, %1, %2":"=v"(r):"v"(a),"v"(b));return r;}
typedef float f32x2_t __attribute__((ext_vector_type(2))); typedef __bf16 bf16x2_t __attribute__((ext_vector_type(2)));
__device__ __forceinline__ unsigned cvtpk_s(float lo,float hi){f32x2_t v={lo,hi};bf16x2_t b=__builtin_convertvector(v,bf16x2_t);return __builtin_bit_cast(unsigned,b);}
#define WAIT_BAR(N) asm volatile("s_waitcnt vmcnt(" #N ") lgkmcnt(0)\n\ts_barrier":::"memory")

__device__ __forceinline__ void qkt(f32x16&p0,f32x16&p1,const char*Kslot,const bf16x8*qr,const f32x16&negm,int r32,int hi){
  const char*kb=Kslot+hi*1024+r32*16;
  #pragma unroll
  for(int d0=0;d0<4;++d0){
    const bf16x8 b0=*reinterpret_cast<const bf16x8*>(kb+d0*2048);
    const bf16x8 b1=*reinterpret_cast<const bf16x8*>(kb+d0*2048+512);
    if(d0==0){p0=__builtin_amdgcn_mfma_f32_32x32x16_bf16(b0,qr[0],negm,0,0,0);p1=__builtin_amdgcn_mfma_f32_32x32x16_bf16(b1,qr[0],negm,0,0,0);}
    else{p0=__builtin_amdgcn_mfma_f32_32x32x16_bf16(b0,qr[d0],p0,0,0,0);p1=__builtin_amdgcn_mfma_f32_32x32x16_bf16(b1,qr[d0],p1,0,0,0);}}
}
typedef __attribute__((address_space(3))) const char* lds_cptr;
typedef short v4i16_t __attribute__((ext_vector_type(4)));
__device__ __forceinline__ void kload8(bf16x8*kf,lds_cptr kp){
  kf[0]=*(const __attribute__((address_space(3))) bf16x8*)(kp);      kf[1]=*(const __attribute__((address_space(3))) bf16x8*)(kp+512);
  kf[2]=*(const __attribute__((address_space(3))) bf16x8*)(kp+2048); kf[3]=*(const __attribute__((address_space(3))) bf16x8*)(kp+2560);
  kf[4]=*(const __attribute__((address_space(3))) bf16x8*)(kp+4096); kf[5]=*(const __attribute__((address_space(3))) bf16x8*)(kp+4608);
  kf[6]=*(const __attribute__((address_space(3))) bf16x8*)(kp+6144); kf[7]=*(const __attribute__((address_space(3))) bf16x8*)(kp+6656);
}
__device__ __forceinline__ void kload2(bf16x8*kf,lds_cptr kp,int j){ kf[2*j]=*(const __attribute__((address_space(3))) bf16x8*)(kp+j*2048); kf[2*j+1]=*(const __attribute__((address_space(3))) bf16x8*)(kp+j*2048+512); }
__device__ __forceinline__ s16x4 vtr(lds_cptr p){ return __builtin_bit_cast(s16x4,__builtin_amdgcn_ds_read_tr16_b64_v4i16((__attribute__((address_space(3))) v4i16_t*)p)); }
__device__ __forceinline__ float rowmax(const f32x16&p0,const f32x16&p1){
  float a=max3f(p0[0],p0[1],p1[0]),b=max3f(p0[2],p0[3],p1[1]);a=max3f(a,p1[2],p1[3]);
  #pragma unroll
  for(int r=4;r<16;r+=4){a=max3f(a,p0[r],p0[r+1]);b=max3f(b,p0[r+2],p0[r+3]);a=max3f(a,p1[r],p1[r+1]);b=max3f(b,p1[r+2],p1[r+3]);}
  const float m=max2f(a,b);
  auto rr=__builtin_amdgcn_permlane32_swap(__float_as_uint(m),__float_as_uint(m),false,false);
  return max2f(__uint_as_float(rr[0]),__uint_as_float(rr[1]));
}
__device__ __forceinline__ void pv(f32x16*o,int vb,bf16x8 pa0,bf16x8 pa1,bf16x8 pa2,bf16x8 pa3){
  #pragma unroll
  for(int d0=0;d0<2;++d0){s16x4 lo[4],hi[4];
    #pragma unroll
    for(int ks=0;ks<4;++ks){
      asm volatile("ds_read_b64_tr_b16 %0,%1 offset:%c2":"=&v"(lo[ks]):"v"(vb),"i"(d0*4096+ks*1024):"memory");
      asm volatile("ds_read_b64_tr_b16 %0,%1 offset:%c2":"=&v"(hi[ks]):"v"(vb),"i"(d0*4096+ks*1024+512):"memory");}
    asm volatile("s_waitcnt lgkmcnt(0)":::"memory");SBAR();
    #define PK(k) (bf16x8){lo[k][0],lo[k][1],lo[k][2],lo[k][3],hi[k][0],hi[k][1],hi[k][2],hi[k][3]}
    o[d0]=__builtin_amdgcn_mfma_f32_32x32x16_bf16(pa0,PK(0),o[d0],0,0,0);
    o[d0]=__builtin_amdgcn_mfma_f32_32x32x16_bf16(pa1,PK(1),o[d0],0,0,0);
    o[d0]=__builtin_amdgcn_mfma_f32_32x32x16_bf16(pa2,PK(2),o[d0],0,0,0);
    o[d0]=__builtin_amdgcn_mfma_f32_32x32x16_bf16(pa3,PK(3),o[d0],0,0,0);
    #undef PK
  }
}

#ifndef ATTN_STORE16
#define ATTN_STORE16(p,v) (*(u32x4*)(p)=(v))
#endif
template<int THRL> __device__ __forceinline__ void attn_unit(int b,int qb,const bf16*Q,const bf16*__restrict__ K,const bf16*__restrict__ V,bf16*O,char*shm){
  int tid_=threadIdx.x; asm volatile("":"+v"(tid_)); const int tid=tid_,lane=tid&63,r32=lane&31,hi=lane>>5; const int wid=__builtin_amdgcn_readfirstlane(tid>>6);
  const long rowbase=(long)b*SEQ; const int q0=qb*QB;
  const bf16*Qw=Q+(rowbase+q0+wid*QBLK)*DM;
  const bf16*Kh=K+rowbase*DM,*Vh=V+rowbase*DM;
  const unsigned lds0=(unsigned)(uintptr_t)shm;
  float*wsf=(float*)(shm+LDS_WS)+wid*64;
  const bf16*ksrc=Kh+(long)lane*DM+wid*8;
  const bf16*vsrc=Vh+(long)(16*(wid&3)+(lane>>2))*DM+(wid>>2)*32+(lane&3)*8;
  const unsigned kdst=lds0+LDS_K+wid*1024, vdst=lds0+LDS_V+wid*1024;
  #define DMA_K(t,slot) glds16(ksrc+(long)(t)*KVBLK*DM,(unsigned)__builtin_amdgcn_readfirstlane(kdst+(slot)))
  #define DMA_V(t,slot) glds16(vsrc+(long)(t)*KVBLK*DM,(unsigned)__builtin_amdgcn_readfirstlane(vdst+(slot)))
  const int vb0=(int)(lds0+LDS_V)+((lane>>4)&1)*32+(lane&3)*8+(4*hi+((lane&15)>>2))*64;
  const char*Kbase=shm+LDS_K; bf16x8 kf[8];
  const lds_cptr shm3=(lds_cptr)shm; const lds_cptr kp0=shm3+LDS_K+hi*1024+r32*16; const lds_cptr vp0=shm3+LDS_V+((lane>>4)&1)*32+(lane&3)*8+(4*hi+((lane&15)>>2))*64;
  const int NT=(q0+QB)/KVBLK;
  DMA_K(0,0);DMA_V(0,0);DMA_K(1,SLOTB);
  bf16x8 qr[4];
  #pragma unroll
  for(int d0=0;d0<4;++d0)qr[d0]=*reinterpret_cast<const bf16x8*>(&Qw[(long)r32*DM+d0*16+hi*8]);
  float mhat=0.f,l_reg=0.f;f32x16 o[2];o[0]=f32x16{};o[1]=f32x16{};f32x16 negm=f32x16{};asm volatile("":"+v"(negm));
  const int qrel=wid*QBLK+r32;
  #define CMASK(P0,P1,t) do{int jb_=(t)-(NT-4); if(jb_>=0)cmask(P0,P1,jb_,qrel,hi);}while(0)
  bool resc=false;
  #define START(P0,P1) do{ const float rm=rowmax(P0,P1); resc=false; \
    { const float dl=rm; mhat=fadd_s(mhat,dl); \
      _Pragma("unroll") for(int r=0;r<16;++r){P0[r]=fsub_s(P0[r],dl);P1[r]=fsub_s(P1[r],dl);} \
      _Pragma("unroll") for(int r=0;r<16;++r)negm[r]=-mhat; asm volatile("":"+v"(negm)); } \
    _Pragma("unroll") for(int r=0;r<16;++r)P0[r]=__builtin_amdgcn_exp2f(P0[r]); }while(0)
  #define RESC() do{ if(resc){ asm volatile("s_waitcnt lgkmcnt(0)":::"memory"); \
      _Pragma("unroll") for(int d_=0;d_<2;++d_) _Pragma("unroll") for(int r=0;r<16;++r)o[d_][r]*=wsf[crow(r,hi)]; } }while(0)
  f32x16 pA0,pA1,pB0,pB1;
  int sl_prev=0,sl_cur=0,sl_next=SLOTB;
  #define ROT() do{sl_prev=sl_cur;sl_cur=sl_next;sl_next=(sl_next==(NSLOT-1)*SLOTB)?0:sl_next+SLOTB;}while(0)
  DMA_K(2,2*SLOTB);
  WAIT_BAR(3);
  qkt(pA0,pA1,Kbase,qr,negm,r32,hi);asm volatile("s_nop 15\n\ts_nop 7":"+v"(pA0),"+v"(pA1));CMASK(pA0,pA1,0);
  START(pA0,pA1);
  _Pragma("unroll") for(int r=0;r<16;++r)pA1[r]=__builtin_amdgcn_exp2f(pA1[r]);
  WAIT_BAR(0);
  DMA_K(3,0);DMA_V(1,SLOTB);
  ROT();
  kload8(kf,kp0+sl_cur);
  WAIT_BAR(2);
  s16x4 vlo[8],vhi[8]; u32x4 pw0,pw1,pw2,pw3;
  #define PKW(P,B) cvtpk_s(P[B],P[B+1])
  #define PAF(k) __builtin_bit_cast(bf16x8,pw##k)
  #define VFR(i) (bf16x8){vlo[i][0],vlo[i][1],vlo[i][2],vlo[i][3],vhi[i][0],vhi[i][1],vhi[i][2],vhi[i][3]}
  #define PIN(x) asm volatile("":"+v"(x))
  #define MX3(a,b,c) __builtin_fmaxf(__builtin_fmaxf((a),(b)),(c))
  #define GAPA(MF,A0,A1,A2,A3,W0,W1,PW) do{ MF; sacc+=A0; sacc+=A1; sacc+=A2; sacc+=A3; PIN(sacc); W0; W1; PIN(PW); SBAR(); }while(0)
  #define EX(v) __builtin_amdgcn_exp2f(v)
  #define GAPB(MF,X,B) do{ MF; X[B]=EX(X[B]); X[B+1]=EX(X[B+1]); X[B+2]=EX(X[B+2]); X[B+3]=EX(X[B+3]); PIN(X); SBAR(); }while(0)
  #define VRD(i) do{ vlo[i]=vtr(vp_+(((i)>>2)*4096+((i)&3)*1024)); vhi[i]=vtr(vp_+(((i)>>2)*4096+((i)&3)*1024+512)); }while(0)
  #define KRD(G,j) do{ if(G){ kload2(kf,kp0+sl_next,j); SBAR(); } }while(0)
  #define STEP(C0,C1,P0,P1,t,GK,GV,GL) do{ SBAR(); \
    const lds_cptr vp_=vp0+sl_prev; \
    VRD(0); SBAR(); float sacc=(P0[0]+P0[1]); \
    GAPA(C0=__builtin_amdgcn_mfma_f32_32x32x16_bf16(kf[0],qr[0],negm,0,0,0), P0[2],P0[3],P0[4],P0[5],     pw0[0]=PKW(P0,0), pw0[1]=PKW(P0,2), pw0); \
    VRD(4); SBAR(); GAPA(C1=__builtin_amdgcn_mfma_f32_32x32x16_bf16(kf[1],qr[0],negm,0,0,0), P0[6],P0[7],P0[8],P0[9],     pw0[2]=PKW(P0,4), pw0[3]=PKW(P0,6), pw0); \
    VRD(1); SBAR(); GAPA(C0=__builtin_amdgcn_mfma_f32_32x32x16_bf16(kf[2],qr[1],C0,0,0,0),   P0[10],P0[11],P0[12],P0[13], pw1[0]=PKW(P0,8), pw1[1]=PKW(P0,10), pw1); \
    VRD(5); SBAR(); GAPA(C1=__builtin_amdgcn_mfma_f32_32x32x16_bf16(kf[3],qr[1],C1,0,0,0),   P0[14],P0[15],P1[0],P1[1],   pw1[2]=PKW(P0,12),pw1[3]=PKW(P0,14), pw1); \
    VRD(2); SBAR(); GAPA(C0=__builtin_amdgcn_mfma_f32_32x32x16_bf16(kf[4],qr[2],C0,0,0,0),   P1[2],P1[3],P1[4],P1[5],     pw2[0]=PKW(P1,0), pw2[1]=PKW(P1,2), pw2); \
    VRD(6); SBAR(); GAPA(C1=__builtin_amdgcn_mfma_f32_32x32x16_bf16(kf[5],qr[2],C1,0,0,0),   P1[6],P1[7],P1[8],P1[9],     pw2[2]=PKW(P1,4), pw2[3]=PKW(P1,6), pw2); \
    VRD(3); SBAR(); GAPA(C0=__builtin_amdgcn_mfma_f32_32x32x16_bf16(kf[6],qr[3],C0,0,0,0),   P1[10],P1[11],P1[12],P1[13], pw3[0]=PKW(P1,8), pw3[1]=PKW(P1,10), pw3); \
    VRD(7); SBAR(); GAPA(C1=__builtin_amdgcn_mfma_f32_32x32x16_bf16(kf[7],qr[3],C1,0,0,0),   P1[14],P1[15],0.f,0.f,       pw3[2]=PKW(P1,12),pw3[3]=PKW(P1,14), pw3); \
    l_reg+=sacc; \
    if(GK){DMA_K((t)+3,sl_cur);} if(GV){DMA_V((t)+1,sl_next);} \
    CMASK(C0,C1,t); \
    { float a=MX3(C0[0],C0[1],C1[0]),b=MX3(C0[2],C0[3],C1[1]); a=MX3(a,C1[2],C1[3]); \
      _Pragma("unroll") for(int r=4;r<16;r+=4){a=MX3(a,C0[r],C0[r+1]);b=MX3(b,C0[r+2],C0[r+3]);a=MX3(a,C1[r],C1[r+1]);b=MX3(b,C1[r+2],C1[r+3]);} \
      float rm=__builtin_fmaxf(a,b); { auto rr=__builtin_amdgcn_permlane32_swap(__float_as_uint(rm),__float_as_uint(rm),false,false); rm=__builtin_fmaxf(__uint_as_float(rr[0]),__uint_as_float(rr[1])); } \
      resc=false; \
      if(__builtin_expect(__any(rm>(float)THRL),0)){ const float dl=__builtin_fmaxf(rm,0.f); mhat+=dl; \
        _Pragma("unroll") for(int r=0;r<16;++r){C0[r]-=dl;C1[r]-=dl;} \
        _Pragma("unroll") for(int r=0;r<16;++r)negm[r]=-mhat; asm volatile("":"+v"(negm)); \
        const float f=__builtin_amdgcn_exp2f(-dl); l_reg*=f; if(hi==0)wsf[r32]=f; resc=true; } } \
    SBAR(); \
    GAPB(o[0]=__builtin_amdgcn_mfma_f32_32x32x16_bf16(PAF(0),VFR(0),o[0],0,0,0), C0,0); \
    GAPB(o[1]=__builtin_amdgcn_mfma_f32_32x32x16_bf16(PAF(0),VFR(4),o[1],0,0,0), C0,4); \
    KRD(GL,0); GAPB(o[0]=__builtin_amdgcn_mfma_f32_32x32x16_bf16(PAF(1),VFR(1),o[0],0,0,0), C0,8); \
    KRD(GL,1); GAPB(o[1]=__builtin_amdgcn_mfma_f32_32x32x16_bf16(PAF(1),VFR(5),o[1],0,0,0), C0,12); \
    KRD(GL,2); GAPB(o[0]=__builtin_amdgcn_mfma_f32_32x32x16_bf16(PAF(2),VFR(2),o[0],0,0,0), C1,0); \
    KRD(GL,3); GAPB(o[1]=__builtin_amdgcn_mfma_f32_32x32x16_bf16(PAF(2),VFR(6),o[1],0,0,0), C1,4); \
    GAPB(o[0]=__builtin_amdgcn_mfma_f32_32x32x16_bf16(PAF(3),VFR(3),o[0],0,0,0), C1,8); \
    GAPB(o[1]=__builtin_amdgcn_mfma_f32_32x32x16_bf16(PAF(3),VFR(7),o[1],0,0,0), C1,12); \
    }while(0)
  int t=1;
  #undef CMASK
  #define CMASK(P0,P1,t) do{}while(0)
  for(;t+5<NT;t+=2){
    STEP(pB0,pB1,pA0,pA1,t,true,true,true);     WAIT_BAR(2); RESC(); ROT();
    STEP(pA0,pA1,pB0,pB1,t+1,true,true,true);   WAIT_BAR(2); RESC(); ROT();
  }
  #undef CMASK
  #define CMASK(P0,P1,t) do{int jb_=(t)-(NT-4); if(jb_>=0)cmask(P0,P1,jb_,qrel,hi);}while(0)
  #define ENDW(tt) do{ if((tt)+3<NT){WAIT_BAR(2);} else if((tt)+2<NT){WAIT_BAR(1);} else {WAIT_BAR(0);} }while(0)
  for(;t+1<NT;t+=2){
    STEP(pB0,pB1,pA0,pA1,t,(t+3<NT),(t+1<NT),(t+1<NT));       ENDW(t);   RESC(); ROT();
    STEP(pA0,pA1,pB0,pB1,t+1,(t+4<NT),(t+2<NT),(t+2<NT));     ENDW(t+1); RESC(); ROT();
  }
  STEP(pB0,pB1,pA0,pA1,NT-1,false,false,false); RESC();
  { float sacc=pB0[0]+pB0[1]; _Pragma("unroll") for(int r=2;r<16;++r)sacc+=pB0[r]; _Pragma("unroll") for(int r=0;r<16;++r)sacc+=pB1[r]; l_reg+=sacc;
    pw0=(u32x4){PKW(pB0,0),PKW(pB0,2),PKW(pB0,4),PKW(pB0,6)};pw1=(u32x4){PKW(pB0,8),PKW(pB0,10),PKW(pB0,12),PKW(pB0,14)};pw2=(u32x4){PKW(pB1,0),PKW(pB1,2),PKW(pB1,4),PKW(pB1,6)};pw3=(u32x4){PKW(pB1,8),PKW(pB1,10),PKW(pB1,12),PKW(pB1,14)};
    SBAR(); pv(o,vb0+sl_cur,PAF(0),PAF(1),PAF(2),PAF(3)); }
  #undef PKW
  #undef PAF
  #undef VFR
  #undef PIN
  #undef MX3
  #undef GAPA
  #undef GAPB
  #undef EX
  #undef VRD
  #undef KRD
  #undef STEP
  #undef ENDW
  {auto rr=__builtin_amdgcn_permlane32_swap(__float_as_uint(l_reg),__float_as_uint(l_reg),false,false);l_reg=__uint_as_float(rr[0])+__uint_as_float(rr[1]);}
  if(hi==0)wsf[32+r32]=l_reg;asm volatile("s_waitcnt lgkmcnt(0)":::"memory");
  float rli[16];
  #pragma unroll
  for(int r=0;r<16;++r)rli[r]=__builtin_amdgcn_rcpf(wsf[32+crow(r,hi)]);
  bf16*Ow=O+(rowbase+q0+wid*QBLK)*DM;
  { bf16*stg=(bf16*)(shm+LDS_OST)+wid*2048;
    #pragma unroll
    for(int r=0;r<16;++r){const int orow=crow(r,hi);
      #pragma unroll
      for(int d0=0;d0<2;++d0)stg[orow*64+d0*32+r32]=__float2bfloat16(o[d0][r]*rli[r]);}
    asm volatile("s_waitcnt lgkmcnt(0)":::"memory");
    #pragma unroll
    for(int i=0;i<4;++i){const int row=i*8+(lane>>3),ch=lane&7; const u32x4 v=*(const u32x4*)(stg+row*64+ch*8); ATTN_STORE16(Ow+(long)row*DM+ch*8,v);} }
  asm volatile("s_waitcnt lgkmcnt(0)\n\ts_barrier":::"memory");
  #undef DMA_K
  #undef DMA_V
  #undef CMASK
  #undef START
  #undef RESC
  #undef ROT
}
constexpr int ATTN_LDS_BYTES=LDS_BYTES;
#undef SBAR
#undef WAIT_BAR
}


#ifndef MOE_F8
#define MOE_F8 1
#endif
constexpr int NWAVES = 8;
constexpr int NB = 16, S = 2048, D = 1024, T = NB * S;
constexpr int NL = 4, NE = 32, TOPK = 4;
constexpr int SLOT_ROWS = T * TOPK + NE * 256;
constexpr int MODC = 6 * D * NL + 2 * D + 2 * D;
constexpr int MOD_KV = 6 * D * NL, MOD_FIN = MOD_KV + 2 * D;
constexpr float EPS = 1e-5f;
constexpr float QSCALE = 0.125f * 1.4426950408889634f;
constexpr size_t MiB = 1u << 20;
constexpr size_t WS_CTL = 0, CTL_ZERO_BYTES = 1 * MiB;
constexpr size_t WS_MOD = 4 * MiB;
constexpr size_t WS_ROPE = 6 * MiB;
constexpr size_t WS_RFRAG = 7 * MiB;
constexpr size_t WS_TKE = 8 * MiB, WS_TKW = WS_TKE + 512 * 1024, WS_TKL = WS_TKW + 512 * 1024, WS_SLOT = WS_TKL + 512 * 1024;
constexpr size_t WS_WGCNT = 10 * MiB, WS_TEXP = WS_WGCNT + 64 * 1024, WS_NT = WS_TEXP + 64 * 1024;
constexpr size_t WS_ROWTOK = 11 * MiB;
constexpr size_t WS_WQKV = 16 * MiB, WS_AWO = 28 * MiB, WS_KVW = 32 * MiB, WS_BWQ = 36 * MiB, WS_BWO = 48 * MiB;
constexpr size_t WS_WGU = 64 * MiB, WS_WDN = 576 * MiB;
constexpr size_t WS_X = 832 * MiB, WS_H = 960 * MiB, WS_Q = 1024 * MiB, WS_KVSH = 1216 * MiB, WS_O = 1344 * MiB, WS_OP = 1408 * MiB, WS_LSE = 1600 * MiB, WS_HKV = 1608 * MiB;
constexpr size_t WS_HS = 1672 * MiB, WS_ACT = 1944 * MiB, WS_Y = 2216 * MiB, WS_END = 2488 * MiB;
constexpr int CW_BAR = 4096;
constexpr int RING_BYTES = 131072;
constexpr int MISC_OFF = RING_BYTES;
constexpr int HIST_OFF = MISC_OFF + 256, TEXP_OFF = MISC_OFF + 1024, ROWTAB_OFF = MISC_OFF + 5120;
constexpr int LDS_BYTES = 163840;

#define GAS __attribute__((address_space(1)))
#define LAS __attribute__((address_space(3)))
typedef unsigned short bf16;
typedef unsigned v4u __attribute__((ext_vector_type(4)));
typedef unsigned v2u __attribute__((ext_vector_type(2)));
typedef float f32x4 __attribute__((ext_vector_type(4)));
typedef float f32x16 __attribute__((ext_vector_type(16)));
typedef short bf16x8 __attribute__((ext_vector_type(8)));
typedef short s16x4 __attribute__((ext_vector_type(4)));
#define RLX_AGENT __ATOMIC_RELAXED, __HIP_MEMORY_SCOPE_AGENT
#define LDS_WAIT() asm volatile("s_waitcnt lgkmcnt(0)" ::: "memory")
#define VM_WAIT() asm volatile("s_waitcnt vmcnt(0)" ::: "memory")
__device__ __forceinline__ unsigned f2bf(float f) { unsigned u = __builtin_bit_cast(unsigned, f); return (u + 0x7fffu + ((u >> 16) & 1u)) >> 16; }
__device__ __forceinline__ float bf2f(unsigned b) { return __builtin_bit_cast(float, b << 16); }
__device__ __forceinline__ unsigned pk2(float lo, float hi) { return pg8::cvt_pk_bf16(lo, hi); }
__device__ __forceinline__ f32x4 unpack4(v2u r) { return (f32x4){bf2f(r.x & 0xffffu), bf2f(r.x >> 16), bf2f(r.y & 0xffffu), bf2f(r.y >> 16)}; }
__device__ __forceinline__ float wave_sum(float v) {
#pragma unroll
    for (int o = 1; o < 64; o <<= 1) v += __shfl_xor(v, o);
    return v;
}
__device__ __forceinline__ float dot4(f32x4 a) { return (a.x * a.x + a.y * a.y) + (a.z * a.z + a.w * a.w); }
#define XB_TMO      128
#define XB_XCNT(j)  (256  + 64 * (j))
#define XB_XSUB(j)  (1280 + 64 * (j))
#define XB_XGEN(j)  (2304 + 64 * (j))
#define XB_TOP      3328
#define XB_TOPGEN   3392
#define XCD_BAR_WORDS 3456
#define XB_SPIN_CAP (1u << 22)

__device__ __forceinline__ unsigned xb_ld(unsigned* p)              { return __hip_atomic_load(p, __ATOMIC_RELAXED, __HIP_MEMORY_SCOPE_AGENT); }
__device__ __forceinline__ unsigned xb_add(unsigned* p, unsigned v) { return __hip_atomic_fetch_add(p, v, __ATOMIC_RELAXED, __HIP_MEMORY_SCOPE_AGENT); }
__device__ __forceinline__ unsigned xb_xcc_id() { return (unsigned)__builtin_amdgcn_s_getreg((3 << 11) | 20) & 0xFu; }
#define XB_SPIN(cond, bar) do { unsigned _sp = 0; while (cond) { __builtin_amdgcn_s_sleep(1); \
    if ((++_sp & 255u) == 0u) { if (xb_ld(&(bar)[XB_TMO])) break; if (_sp > XB_SPIN_CAP) { atomicAdd(&(bar)[XB_TMO], 1u); break; } } } } while (0)

struct XcdBarrier {
    unsigned* bar; unsigned x;
    volatile LAS unsigned* st;
};

__device__ __forceinline__ XcdBarrier xcd_barrier_post(unsigned* bar, volatile LAS unsigned* st) {
    XcdBarrier b; b.bar = bar; b.x = xb_xcc_id(); b.st = st;
    if (threadIdx.x == 0) (void)xb_add(&bar[XB_XCNT(b.x)], 1u);
    return b;
}
__device__ __forceinline__ void xcd_barrier_complete(unsigned* bar, unsigned x, unsigned& nloc, unsigned& nx) {
    const unsigned G = gridDim.x * gridDim.y * gridDim.z;
    unsigned sum, cnt, mine, sp = 0u;
    for (;;) {
        sum = 0u; cnt = 0u; mine = 0u;
#pragma unroll
        for (unsigned j = 0; j < 16; ++j) { const unsigned c = xb_ld(&bar[XB_XCNT(j)]); sum += c; cnt += (c > 0u) ? 1u : 0u; mine = (j == x) ? c : mine; }
        if (sum == G) break;
        __builtin_amdgcn_s_sleep(1);
        if ((++sp & 255u) == 0u) { if (xb_ld(&bar[XB_TMO])) break; if (sp > XB_SPIN_CAP) { atomicAdd(&bar[XB_TMO], 1u); break; } }
    }
    nloc = mine > 0u ? mine : 1u; nx = cnt > 0u ? cnt : 1u;
}

__device__ __forceinline__ void xcd_barrier(const XcdBarrier& b) {
    asm volatile("s_waitcnt vmcnt(0)" ::: "memory");
    __syncthreads();
    if (threadIdx.x == 0) {
        unsigned* bar = b.bar;
        __builtin_amdgcn_s_waitcnt(0);
        unsigned nloc = b.st[0], nx = b.st[1];
        if (nloc == 0u) { xcd_barrier_complete(bar, b.x, nloc, nx); b.st[0] = nloc; b.st[1] = nx; }
        const unsigned old = xb_add(&bar[XB_XSUB(b.x)], 1u);
        const unsigned gen = old / nloc;
        if (old + 1u == (gen + 1u) * nloc) {
            __builtin_amdgcn_fence(__ATOMIC_RELEASE, "agent");
            asm volatile("s_waitcnt vmcnt(0)" ::: "memory");
            const unsigned og = xb_add(&bar[XB_TOP], 1u);
            const unsigned tg = og / nx;
            if (og + 1u == (tg + 1u) * nx) xb_add(&bar[XB_TOPGEN], 1u);
            else XB_SPIN(xb_ld(&bar[XB_TOPGEN]) == tg, bar);
            __builtin_amdgcn_fence(__ATOMIC_ACQUIRE, "agent");
            xb_add(&bar[XB_XGEN(b.x)], 1u);
            asm volatile("s_waitcnt vmcnt(0)" ::: "memory");
        } else {
            XB_SPIN(xb_ld(&bar[XB_XGEN(b.x)]) == gen, bar);
            __builtin_amdgcn_fence(__ATOMIC_ACQUIRE, "agent");
            asm volatile("s_waitcnt vmcnt(0)" ::: "memory");
        }
    }
    __syncthreads();
}

struct Args { const float* in[25]; float* out; unsigned char* ws; float invf[8]; float lam_init[2]; int ph_lo, ph_hi, use_bar, pad; };
enum { I_X = 0, I_C, I_MODW, I_MODB, I_MIXN, I_FFNN, I_AWQKV, I_AWO, I_ALAM, I_ASUBLN, I_KVN, I_KVMODW, I_KVMODB, I_KVW, I_BWQ, I_BWO, I_RW, I_RB, I_WGU, I_BGU, I_WDN, I_BDN, I_FINN, I_FINMODW, I_FINMODB };
struct Frame { LAS unsigned char* lds; int tid, lane, wave, G, gw, NGW, bid; };
typedef const __attribute__((address_space(4))) Args* ArgsP;

__device__ __forceinline__ void p0_transpose_item(const float* W, int N, int K, bf16* WT, int dst_row0, LAS float* scr, int k0, int n0, int lane) {
    float v_[32];
#pragma unroll
    for (int i = 0; i < 32; ++i) v_[i] = W[(size_t)(k0 + 2 * i + (lane >> 5)) * N + n0 + (lane & 31)];
#pragma unroll
    for (int i = 0; i < 32; ++i) scr[(2 * i + (lane >> 5)) * 33 + (lane & 31)] = v_[i];
    LDS_WAIT(); asm volatile("" ::: "memory");
    const int c = lane & 7;
#pragma unroll
    for (int j = 0; j < 4; ++j) { const int n = (lane >> 3) + 8 * j; const LAS float* s = scr + (8 * c) * 33 + n;
        v4u o; o.x = pk2(s[0 * 33], s[1 * 33]); o.y = pk2(s[2 * 33], s[3 * 33]); o.z = pk2(s[4 * 33], s[5 * 33]); o.w = pk2(s[6 * 33], s[7 * 33]);
        *(GAS v4u*)(WT + (size_t)(dst_row0 + n) * K + k0 + 8 * c) = o; }
    LDS_WAIT(); asm volatile("" ::: "memory");
}
__device__ __forceinline__ void p0_transpose_item_f8(const float* W, int N, int K, unsigned char* WT, int dst_row0, LAS float* scr, int k0, int n0, int lane) {
    float v_[32];
#pragma unroll
    for (int i = 0; i < 32; ++i) v_[i] = W[(size_t)(k0 + 2 * i + (lane >> 5)) * N + n0 + (lane & 31)];
#pragma unroll
    for (int i = 0; i < 32; ++i) scr[(2 * i + (lane >> 5)) * 33 + (lane & 31)] = v_[i];
    LDS_WAIT(); asm volatile("" ::: "memory");
    const int c = lane & 3;
#pragma unroll
    for (int j = 0; j < 2; ++j) { const int n = (lane >> 2) + 16 * j; const LAS float* s = scr + (16 * c) * 33 + n; v4u o;
        o.x = pg8::pk4_fp8(s[0 * 33] * 256.f, s[1 * 33] * 256.f, s[2 * 33] * 256.f, s[3 * 33] * 256.f); o.y = pg8::pk4_fp8(s[4 * 33] * 256.f, s[5 * 33] * 256.f, s[6 * 33] * 256.f, s[7 * 33] * 256.f);
        o.z = pg8::pk4_fp8(s[8 * 33] * 256.f, s[9 * 33] * 256.f, s[10 * 33] * 256.f, s[11 * 33] * 256.f); o.w = pg8::pk4_fp8(s[12 * 33] * 256.f, s[13 * 33] * 256.f, s[14 * 33] * 256.f, s[15 * 33] * 256.f);
        *(GAS v4u*)(WT + (size_t)(dst_row0 + n) * K + k0 + 16 * c) = o; }
    LDS_WAIT(); asm volatile("" ::: "memory");
}
__device__ __forceinline__ void p0_prologue(const Frame& F, ArgsP ap) {
    unsigned char* ws = ap->ws;
    {
        LAS float* cT = (LAS float*)F.lds;
        LAS float* red = (LAS float*)(F.lds + 65536);
        const float* c = ap->in[I_C];
        for (int idx = F.tid; idx < NB * D; idx += NWAVES * 64) { const int b = idx >> 10, k = idx & 1023; const float v = c[idx]; cT[k * 16 + b] = v / (1.0f + __expf(-v)); }
        __syncthreads();
        float* modall = (float*)(ws + WS_MOD);
        for (int g = F.bid; g < MODC / 64; g += F.G) {
            const int cg0 = g * 64; const float* W; const float* bias; int N, col0;
            if (cg0 < MOD_KV) { const int l = cg0 / (6 * D); col0 = cg0 % (6 * D); W = ap->in[I_MODW] + (size_t)l * D * 6 * D; N = 6 * D; bias = ap->in[I_MODB] + l * 6 * D + col0; }
            else if (cg0 < MOD_FIN) { col0 = cg0 - MOD_KV; W = ap->in[I_KVMODW]; N = 2 * D; bias = ap->in[I_KVMODB] + col0; }
            else { col0 = cg0 - MOD_FIN; W = ap->in[I_FINMODW]; N = 2 * D; bias = ap->in[I_FINMODB] + col0; }
            float acc[16];
#pragma unroll
            for (int b = 0; b < 16; ++b) acc[b] = 0.f;
            const float* wp = W + (size_t)(F.wave * 128) * N + col0 + F.lane;
#pragma unroll 8
            for (int kk = 0; kk < 128; ++kk) { const float w = wp[(size_t)kk * N]; const LAS f32x4* cv = (const LAS f32x4*)(cT + (F.wave * 128 + kk) * 16);
                const f32x4 c0 = cv[0], c1 = cv[1], c2 = cv[2], c3 = cv[3];
                acc[0] += w * c0.x; acc[1] += w * c0.y; acc[2] += w * c0.z; acc[3] += w * c0.w; acc[4] += w * c1.x; acc[5] += w * c1.y; acc[6] += w * c1.z; acc[7] += w * c1.w;
                acc[8] += w * c2.x; acc[9] += w * c2.y; acc[10] += w * c2.z; acc[11] += w * c2.w; acc[12] += w * c3.x; acc[13] += w * c3.y; acc[14] += w * c3.z; acc[15] += w * c3.w; }
#pragma unroll
            for (int b = 0; b < 16; ++b) red[(F.wave * 16 + b) * 64 + F.lane] = acc[b];
            __syncthreads();
            for (int o = F.tid; o < 1024; o += NWAVES * 64) { const int b = o >> 6, ln = o & 63; float s = bias[ln];
#pragma unroll
                for (int w = 0; w < 8; ++w) s += red[(w * 16 + b) * 64 + ln];
                modall[(size_t)b * MODC + cg0 + ln] = s; }
            __syncthreads();
        }
        __syncthreads();
    }
    {
        const int gt = F.bid * (NWAVES * 64) + F.tid, NT_ = F.G * NWAVES * 64;
        float* cosT = (float*)(ws + WS_ROPE); float* sinT = cosT + S * 8;
        for (int idx = gt; idx < S * 8; idx += NT_) { const int pos = idx >> 3, i = idx & 7; float inv = ap->invf[0];
#pragma unroll
            for (int q = 1; q < 8; ++q) inv = (i == q) ? ap->invf[q] : inv;
            const float angf = (float)pos * inv; const double x = (double)angf; const double n = __builtin_rint(x * 0.15915494309189533577); const double r = x - n * 6.283185307179586476925; const double r2 = r * r;
            double sn = 1.0, cs = 1.0;
#pragma unroll
            for (int q = 14; q >= 1; --q) { sn = 1.0 - sn * r2 / (double)((2 * q) * (2 * q + 1)); cs = 1.0 - cs * r2 / (double)((2 * q - 1) * (2 * q)); }
            sn *= r; cosT[idx] = (float)cs; sinT[idx] = (float)sn; }
        bf16* rfrag = (bf16*)(ws + WS_RFRAG); const float* rw = ap->in[I_RW];
        for (int idx = gt; idx < NL * 32 * 2 * 64 * 8; idx += NT_) { const int j = idx & 7, lane = (idx >> 3) & 63, nb = (idx >> 9) & 1, s = (idx >> 10) & 31, l = idx >> 15;
            const float w = rw[((size_t)l * D + 32 * s + 8 * (lane >> 4) + j) * NE + 16 * nb + (lane & 15)]; const unsigned hi = f2bf(w), lo = f2bf(w - bf2f(hi));
            const size_t base = ((((size_t)l * 32 + s) * 2 + nb) * 2) * 512 + lane * 8 + j; rfrag[base] = (bf16)hi; rfrag[base + 512] = (bf16)lo; }
    }
    {
        LAS float* scr = (LAS float*)(F.lds + F.wave * 16384);
        constexpr int I_QKV = 16 * 96, I_SQ = 16 * 32, I_KV = 16 * 64;
        constexpr int E0 = 2 * I_QKV, E1 = E0 + 2 * I_SQ, E2 = E1 + I_KV, E3 = E2 + 2 * I_QKV, E4 = E3 + 2 * I_SQ;
        for (int it = F.gw; it < E4; it += F.NGW) {
            const float* W; bf16* WT; int N, r, per;
            if (it < E0) { r = it; per = I_QKV; N = 3 * D; W = ap->in[I_AWQKV]; WT = (bf16*)(ws + WS_WQKV); }
            else if (it < E1) { r = it - E0; per = I_SQ; N = D; W = ap->in[I_AWO]; WT = (bf16*)(ws + WS_AWO); }
            else if (it < E2) { r = it - E1; per = I_KV; N = 2 * D; W = ap->in[I_KVW]; WT = (bf16*)(ws + WS_KVW); }
            else if (it < E3) { r = it - E2; per = I_QKV; N = 3 * D; W = ap->in[I_BWQ]; WT = (bf16*)(ws + WS_BWQ); }
            else { r = it - E3; per = I_SQ; N = D; W = ap->in[I_BWO]; WT = (bf16*)(ws + WS_BWO); }
            const int mat = r / per, item = r % per, nblk = N / 32, kb = item / nblk, nb = item % nblk, n0 = 32 * nb;
            p0_transpose_item(W + (size_t)mat * D * N, N, D, WT + (size_t)mat * N * D, n0, scr, 64 * kb, n0, F.lane);
        }
    }
}
__device__ __forceinline__ void convert_experts(const Frame& F, ArgsP ap, int l0, LAS float* scr) {
    unsigned char* ws = ap->ws;
    constexpr int I_GU = 16 * 64, I_DN = 16 * 32, PER_L = NE * (I_GU + I_DN);
    constexpr size_t ESZ = MOE_F8 ? 1 : 2;
    for (int it = F.gw; it < 2 * PER_L; it += F.NGW) {
        const int l = l0 + it / PER_L; int r = it % PER_L; const bool gu = r < NE * I_GU; if (!gu) r -= NE * I_GU;
        const int per = gu ? I_GU : I_DN, N = gu ? 2 * D : D, e = r / per, item = r % per, nblk = N / 32, kb = item / nblk, nb = item % nblk, n0 = 32 * nb;
        int drow = n0; if (gu) { const int half = n0 >> 10, rem = n0 & 1023; drow = (rem >> 7) * 256 + half * 128 + (rem & 127); }
        const float* W = (gu ? ap->in[I_WGU] : ap->in[I_WDN]) + ((size_t)l * NE + e) * D * N;
        unsigned char* WT = ws + (gu ? WS_WGU : WS_WDN) + ((size_t)l * NE + e) * N * D * ESZ;
        if (MOE_F8) p0_transpose_item_f8(W, N, D, WT, drow, scr, 64 * kb, n0, F.lane); else p0_transpose_item(W, N, D, (bf16*)WT, drow, scr, 64 * kb, n0, F.lane);
    }
}

struct ModVec { f32x4 a[4], b[4]; };
__device__ __forceinline__ void load_modvec(ModVec& mv, const float* gain, const float* scale, const float* shift, int lane) {
#pragma unroll
    for (int j = 0; j < 4; ++j) { const int c = 4 * lane + 256 * j; const f32x4 g = *(const f32x4*)(gain + c), sc = *(const f32x4*)(scale + c); mv.a[j] = g * (sc + 1.0f); mv.b[j] = *(const f32x4*)(shift + c); }
}
__device__ __forceinline__ void store_bf16_row(bf16* orow, const f32x4 (&v)[4], int lane) {
#pragma unroll
    for (int j = 0; j < 4; ++j) { v2u w; w.x = pk2(v[j].x, v[j].y); w.y = pk2(v[j].z, v[j].w); *(v2u*)(orow + 4 * lane + 256 * j) = w; }
}
__device__ __forceinline__ void phase_modulate0(const Frame& F, const float* x, const float* gain, const float* modall, int sh_col, int sc_col, bf16* h) {
    for (int task = F.gw; task < T / 16; task += F.NGW) {
        const int r0 = task * 16, b = r0 >> 11; ModVec mv; load_modvec(mv, gain, modall + (size_t)b * MODC + sc_col, modall + (size_t)b * MODC + sh_col, F.lane);
        f32x4 nx[4];
#pragma unroll
        for (int j = 0; j < 4; ++j) nx[j] = *(const f32x4*)(x + (size_t)r0 * D + 4 * F.lane + 256 * j);
        for (int i = 0; i < 16; ++i) { f32x4 v[4]; float ss = 0.f;
#pragma unroll
            for (int j = 0; j < 4; ++j) { v[j] = nx[j]; ss += dot4(v[j]); }
            if (i + 1 < 16) {
#pragma unroll
                for (int j = 0; j < 4; ++j) nx[j] = *(const f32x4*)(x + (size_t)(r0 + i + 1) * D + 4 * F.lane + 256 * j); }
            const float rstd = 1.0f / sqrtf(wave_sum(ss) * (1.0f / D) + EPS);
#pragma unroll
            for (int j = 0; j < 4; ++j) v[j] = v[j] * rstd * mv.a[j] + mv.b[j];
            store_bf16_row(h + (size_t)(r0 + i) * D, v, F.lane); }
    }
}
__device__ __forceinline__ void phase_subln(const Frame& F, const bf16* OP, const float* lamv  , const float* subln  , float lam_init, bf16* O) {
    float lam; { const float p1 = wave_sum(lamv[F.lane] * lamv[64 + F.lane]), p2 = wave_sum(lamv[128 + F.lane] * lamv[192 + F.lane]); lam = __expf(p1) - __expf(p2) + lam_init; }
    const f32x4 gsub = *(const f32x4*)(subln + ((4 * F.lane) & 127)) * (1.0f - lam_init);
    for (int task = F.gw; task < T / 16; task += F.NGW) {
        v2u n0[4], n1[4];
#pragma unroll
        for (int j = 0; j < 4; ++j) { const size_t o_ = (size_t)(task * 16) * D + 4 * F.lane + 256 * j; n0[j] = *(const v2u*)(OP + o_); n1[j] = *(const v2u*)(OP + (size_t)T * D + o_); }
        for (int i = 0; i < 16; ++i) { const size_t ro = (size_t)(task * 16 + i) * D; f32x4 v[4]; v2u c0[4], c1[4];
#pragma unroll
            for (int j = 0; j < 4; ++j) { c0[j] = n0[j]; c1[j] = n1[j]; }
            if (i + 1 < 16) {
#pragma unroll
                for (int j = 0; j < 4; ++j) { const size_t o_ = ro + D + 4 * F.lane + 256 * j; n0[j] = *(const v2u*)(OP + o_); n1[j] = *(const v2u*)(OP + (size_t)T * D + o_); } }
#pragma unroll
            for (int j = 0; j < 4; ++j) { v[j] = unpack4(c0[j]) - unpack4(c1[j]) * lam; float ss = dot4(v[j]);
#pragma unroll
                for (int o = 1; o < 32; o <<= 1) ss += __shfl_xor(ss, o);
                v[j] = v[j] * (1.0f / sqrtf(ss * (1.0f / 128.0f) + EPS)) * gsub; }
            store_bf16_row(O + ro, v, F.lane); }
    }
}
__device__ __forceinline__ void phase_merge(const Frame& F, const bf16* OG, const float* LSE, bf16* O) {
    for (int task = F.gw; task < T / 16; task += F.NGW) {
        v2u n0[4], n1[4], n2[4]; float nl0[4], nl1[4], nl2[4];
#define MRG_LOAD(row_) do { _Pragma("unroll") for (int j = 0; j < 4; ++j) { const int c = 4 * F.lane + 256 * j, head = c >> 6; const size_t o_ = (size_t)(row_) * D + c, l_ = (size_t)(row_) * 16 + head; \
            n0[j] = *(const v2u*)(OG + o_); n1[j] = *(const v2u*)(OG + (size_t)T * D + o_); n2[j] = *(const v2u*)(OG + (size_t)2 * T * D + o_); nl0[j] = LSE[l_]; nl1[j] = LSE[(size_t)T * 16 + l_]; nl2[j] = LSE[(size_t)2 * T * 16 + l_]; } } while (0)
        MRG_LOAD(task * 16);
        for (int i = 0; i < 16; ++i) { const int row = task * 16 + i; f32x4 v[4]; v2u c0[4], c1[4], c2[4]; float l0[4], l1[4], l2[4];
#pragma unroll
            for (int j = 0; j < 4; ++j) { c0[j] = n0[j]; c1[j] = n1[j]; c2[j] = n2[j]; l0[j] = nl0[j]; l1[j] = nl1[j]; l2[j] = nl2[j]; }
            if (i + 1 < 16) MRG_LOAD(row + 1);
#pragma unroll
            for (int j = 0; j < 4; ++j) {
                const float mx = fmaxf(l0[j], fmaxf(l1[j], l2[j])); const float a0 = __builtin_amdgcn_exp2f(l0[j] - mx), a1 = __builtin_amdgcn_exp2f(l1[j] - mx), a2 = __builtin_amdgcn_exp2f(l2[j] - mx); const float inv = 1.0f / (a0 + a1 + a2);
                v[j] = (unpack4(c0[j]) * a0 + unpack4(c1[j]) * a1 + unpack4(c2[j]) * a2) * inv; }
            store_bf16_row(O + (size_t)row * D, v, F.lane); }
#undef MRG_LOAD
    }
}
__device__ __forceinline__ void phase_mod2_router(const Frame& F, const float* x, const float* gain, const float* modall, int sh_col, int sc_col, const bf16* rfrag, const float* rb,
                                                  bf16* h2, int* tk_e, float* tk_w, int* tk_l, int* wgcnt) {
    LAS int* hist = (LAS int*)(F.lds + HIST_OFF);
    if (F.tid < NE) hist[F.tid] = 0;
    __syncthreads();
    const int r = F.lane & 15, kq = F.lane >> 4;
    for (int task = F.gw; task < T / 16; task += F.NGW) {
        const int r0 = task * 16, b = r0 >> 11; const float* xr = x + (size_t)(r0 + r) * D + 8 * kq;
        float ss = 0.f;
#pragma unroll 16
        for (int s = 0; s < 32; ++s) ss += dot4(*(const f32x4*)(xr + 32 * s)) + dot4(*(const f32x4*)(xr + 32 * s + 4));
        ss += __shfl_xor(ss, 16); ss += __shfl_xor(ss, 32);
        const float rstd = 1.0f / sqrtf(ss * (1.0f / D) + EPS);
        const float* gp = gain + 8 * kq; const float* scp = modall + (size_t)b * MODC + sc_col + 8 * kq; const float* shp = modall + (size_t)b * MODC + sh_col + 8 * kq;
        bf16* hr = h2 + (size_t)(r0 + r) * D + 8 * kq;
        f32x4 acc0 = (f32x4){0.f, 0.f, 0.f, 0.f}, acc1 = acc0;
#pragma unroll 8
        for (int s = 0; s < 32; ++s) {
            const f32x4 xa = *(const f32x4*)(xr + 32 * s), xb = *(const f32x4*)(xr + 32 * s + 4);
            const f32x4 ga = *(const f32x4*)(gp + 32 * s), gb = *(const f32x4*)(gp + 32 * s + 4), sa = *(const f32x4*)(scp + 32 * s), sb = *(const f32x4*)(scp + 32 * s + 4), ha = *(const f32x4*)(shp + 32 * s), hb = *(const f32x4*)(shp + 32 * s + 4);
            const f32x4 va = xa * rstd * ga * (sa + 1.0f) + ha, vb = xb * rstd * gb * (sb + 1.0f) + hb;
            bf16x8 Ahi, Alo;
#pragma unroll
            for (int j = 0; j < 4; ++j) { const unsigned h0 = f2bf(va[j]), h1 = f2bf(vb[j]); Ahi[j] = (short)h0; Ahi[4 + j] = (short)h1; Alo[j] = (short)f2bf(va[j] - bf2f(h0)); Alo[4 + j] = (short)f2bf(vb[j] - bf2f(h1)); }
            if (MOE_F8) { v2u w8; w8.x = pg8::pk4_fp8(va[0], va[1], va[2], va[3]); w8.y = pg8::pk4_fp8(vb[0], vb[1], vb[2], vb[3]); *(v2u*)((unsigned char*)h2 + (size_t)(r0 + r) * D + 8 * kq + 32 * s) = w8; }
            else *(bf16x8*)(hr + 32 * s) = Ahi;
            const bf16* fp = rfrag + (size_t)s * 2048 + F.lane * 8;
            const bf16x8 Bh0 = *(const bf16x8*)(fp), Bl0 = *(const bf16x8*)(fp + 512), Bh1 = *(const bf16x8*)(fp + 1024), Bl1 = *(const bf16x8*)(fp + 1536);
            acc0 = __builtin_amdgcn_mfma_f32_16x16x32_bf16(Ahi, Bh0, acc0, 0, 0, 0); acc0 = __builtin_amdgcn_mfma_f32_16x16x32_bf16(Alo, Bh0, acc0, 0, 0, 0); acc0 = __builtin_amdgcn_mfma_f32_16x16x32_bf16(Ahi, Bl0, acc0, 0, 0, 0);
            acc1 = __builtin_amdgcn_mfma_f32_16x16x32_bf16(Ahi, Bh1, acc1, 0, 0, 0); acc1 = __builtin_amdgcn_mfma_f32_16x16x32_bf16(Alo, Bh1, acc1, 0, 0, 0); acc1 = __builtin_amdgcn_mfma_f32_16x16x32_bf16(Ahi, Bl1, acc1, 0, 0, 0);
        }
        const float b0 = rb[r], b1 = rb[16 + r];
#pragma unroll
        for (int reg = 0; reg < 4; ++reg) {
            float v0 = acc0[reg] + b0, v1 = acc1[reg] + b1; float tv[4]; int te[4];
#pragma unroll
            for (int k = 0; k < 4; ++k) {
                float bv = (v0 >= v1) ? v0 : v1; int be = (v0 >= v1) ? r : 16 + r;
#pragma unroll
                for (int o = 1; o < 16; o <<= 1) { const float ov = __shfl_xor(bv, o); const int oe = __shfl_xor(be, o); if (ov > bv || (ov == bv && oe < be)) { bv = ov; be = oe; } }
                tv[k] = bv; te[k] = be; if (be == r) v0 = -INFINITY; if (be == 16 + r) v1 = -INFINITY;
            }
            const float p1 = __expf(tv[1] - tv[0]), p2 = __expf(tv[2] - tv[0]), p3 = __expf(tv[3] - tv[0]); const float inv = 1.0f / (1.0f + p1 + p2 + p3);
            if (r == 0) { const int row = r0 + 4 * kq + reg; const float pw[4] = {inv, p1 * inv, p2 * inv, p3 * inv};
#pragma unroll
                for (int k = 0; k < 4; ++k) { tk_e[row * 4 + k] = te[k]; tk_w[row * 4 + k] = pw[k]; tk_l[row * 4 + k] = __hip_atomic_fetch_add(hist + te[k], 1, __ATOMIC_RELAXED, __HIP_MEMORY_SCOPE_WORKGROUP); } }
        }
    }
    __syncthreads();
    if (F.tid < NE) wgcnt[F.bid * NE + F.tid] = hist[F.tid];
}
__device__ __forceinline__ void phase_scatter(const Frame& F, const int* wgcnt, const int* tk_e, const int* tk_l, int* slot_of, int* rowtok, int* texp, unsigned* ntiles) {
    LAS int* cnt = (LAS int*)F.lds; LAS int* tot = (LAS int*)(F.lds + 65536); LAS int* bas = tot + 32; LAS int* eoff = tot + 64;
    for (int i = F.tid; i < F.G * NE; i += NWAVES * 64) cnt[i] = wgcnt[i];
    __syncthreads();
    if (F.tid < NE) { int t = 0, bs = 0; for (int w = 0; w < F.G; ++w) { const int c = cnt[w * NE + F.tid]; bs += (w < F.bid) ? c : 0; t += c; } tot[F.tid] = t; bas[F.tid] = bs; }
    __syncthreads();
    if (F.tid == 0) { int off = 0; for (int e = 0; e < NE; ++e) { eoff[e] = off; off += (tot[e] + 255) & ~255; } eoff[NE] = off; }
    __syncthreads();
    if (F.bid == 0) { if (F.tid < NE) { for (int pm = eoff[F.tid] >> 8; pm < (eoff[F.tid + 1] >> 8); ++pm) texp[pm] = F.tid; } if (F.tid == 0) __hip_atomic_store(ntiles, (unsigned)(eoff[NE] >> 8), RLX_AGENT);
        for (int e = 0; e < NE; ++e) for (int sl = eoff[e] + tot[e] + F.tid; sl < eoff[e + 1]; sl += NWAVES * 64) rowtok[sl] = 0; }
    for (int task = F.gw; task < T / 16; task += F.NGW) {
        const int r0 = task * 16, row = r0 + (F.lane >> 2); const int idx = row * 4 + (F.lane & 3);
        const int e = tk_e[idx], slot = eoff[e] + bas[e] + tk_l[idx]; slot_of[idx] = slot; rowtok[slot] = row;
    }
}
__device__ __forceinline__ void phase_combine(const Frame& F, float* x, const bf16* Y, const int* slot_of, const float* tk_w, const float* g2base  , int mode,
                                              const float* gainA, const float* modall, int shA, int scA, bf16* h, const float* gainB, int shB, int scB, bf16* hkv, float* out) {
    for (int task = F.gw; task < T / 16; task += F.NGW) {
        const int r0 = task * 16, b = r0 >> 11; ModVec mv, mk; f32x4 g2[4];
        load_modvec(mv, gainA, modall + (size_t)b * MODC + scA, modall + (size_t)b * MODC + shA, F.lane);
        if (mode == 1) load_modvec(mk, gainB, modall + (size_t)b * MODC + scB, modall + (size_t)b * MODC + shB, F.lane);
#pragma unroll
        for (int j = 0; j < 4; ++j) g2[j] = *(const f32x4*)(g2base + (size_t)b * MODC + 4 * F.lane + 256 * j);
        const int myslot = slot_of[r0 * 4 + F.lane]; const float myw = tk_w[r0 * 4 + F.lane];
        v2u ny[4][4]; f32x4 nx[4];
#define CMB_LOAD(i_) do { _Pragma("unroll") for (int k = 0; k < 4; ++k) { const bf16* yr = Y + (size_t)__shfl(myslot, (i_) * 4 + k) * D; _Pragma("unroll") for (int j = 0; j < 4; ++j) ny[k][j] = *(const v2u*)(yr + 4 * F.lane + 256 * j); } \
            _Pragma("unroll") for (int j = 0; j < 4; ++j) nx[j] = *(const f32x4*)(x + (size_t)(r0 + (i_)) * D + 4 * F.lane + 256 * j); } while (0)
        CMB_LOAD(0);
        for (int i = 0; i < 16; ++i) { const size_t ro = (size_t)(r0 + i) * D; f32x4 acc[4]; v2u cy[4][4]; f32x4 cx[4];
#pragma unroll
            for (int j = 0; j < 4; ++j) { acc[j] = (f32x4){0.f, 0.f, 0.f, 0.f}; cx[j] = nx[j];
#pragma unroll
                for (int k = 0; k < 4; ++k) cy[k][j] = ny[k][j]; }
            if (i + 1 < 16) CMB_LOAD(i + 1);
#pragma unroll
            for (int k = 0; k < 4; ++k) { const float w = __shfl(myw, i * 4 + k);
#pragma unroll
                for (int j = 0; j < 4; ++j) acc[j] += unpack4(cy[k][j]) * w; }
            f32x4 v[4]; float ss = 0.f;
#pragma unroll
            for (int j = 0; j < 4; ++j) { v[j] = cx[j] + g2[j] * acc[j]; ss += dot4(v[j]); }
            if (mode != 2) {
#pragma unroll
                for (int j = 0; j < 4; ++j) *(f32x4*)(x + ro + 4 * F.lane + 256 * j) = v[j]; }
            const float rstd = 1.0f / sqrtf(wave_sum(ss) * (1.0f / D) + EPS);
            if (mode == 2) {
#pragma unroll
                for (int j = 0; j < 4; ++j) *(f32x4*)(out + ro + 4 * F.lane + 256 * j) = v[j] * rstd * mv.a[j] + mv.b[j];
            } else {
                f32x4 o[4];
#pragma unroll
                for (int j = 0; j < 4; ++j) o[j] = v[j] * rstd * mv.a[j] + mv.b[j];
                store_bf16_row(h + ro, o, F.lane);
                if (mode == 1) {
#pragma unroll
                    for (int j = 0; j < 4; ++j) o[j] = v[j] * rstd * mk.a[j] + mk.b[j];
                    store_bf16_row(hkv + ro, o, F.lane); }
            }
        }
#undef CMB_LOAD
    }
}

__device__ __forceinline__ int crow16(int i, int h) { return (i & 3) + 8 * (i >> 2) + 4 * h; }
constexpr int DIL_KIMG = 0, DIL_VIMG = 384 * 128, DIL_NKEY = 384;
struct DilUnit { int p, g, res_u, V0, dsh; };
__device__ __forceinline__ bool dil_unit(int n, int vcu, int G, DilUnit& U) {
    const int pi = n / 24, u = n - pi * 24; U.p = vcu + pi * G; if (U.p >= NB * 16) return false;
    const int g = u >> 3, uu = u & 7; U.g = g; U.dsh = 2 * g;
    if (g == 0) { U.res_u = 0; U.V0 = uu * 256; } else if (g == 1) { U.res_u = uu >> 1; U.V0 = (uu & 1) * 256; } else { U.res_u = 2 * uu; U.V0 = 0; }
    return true;
}
__device__ __forceinline__ void dil_glds(const void* gsrc, unsigned lds_dst) { unsigned keep;
    asm volatile("s_mov_b32 %0, m0\n\ts_mov_b32 m0, %2\n\ts_nop 0\n\tglobal_load_lds_dwordx4 %1, off\n\ts_mov_b32 m0, %0" : "=&s"(keep) : "v"(gsrc), "s"(lds_dst) : "memory"); }
__device__ __forceinline__ int dil_keyrow(const DilUnit& U, int slot) { int rs, vk; if (U.g == 2) { rs = U.res_u + ((slot >> 7) & 1); vk = slot & 127; } else { rs = U.res_u; vk = U.V0 - 128 + slot; vk = vk < 0 ? 0 : vk; } return rs + (vk << U.dsh); }
__device__ __forceinline__ void dil_stage_k(const DilUnit& U, const bf16* KV, unsigned ldsb, int wave, int lane) {
    const bf16* Kg = KV + (size_t)U.p * S * 64;
#pragma unroll
    for (int it = 0; it < 6; ++it) { const int wi = it * 8 + wave, slot = wi * 8 + (lane >> 3), ch = (lane & 7) ^ ((slot >> 1) & 7);
        dil_glds(Kg + (size_t)dil_keyrow(U, slot) * 64 + ch * 8, (unsigned)__builtin_amdgcn_readfirstlane((int)(ldsb + DIL_KIMG + wi * 1024))); }
}
__device__ __forceinline__ void dil_stage_v(const DilUnit& U, const bf16* KV, unsigned ldsb, int wave, int lane) {
    const bf16* Vg = KV + (size_t)T * D + (size_t)U.p * S * 64;
#pragma unroll
    for (int it = 0; it < 6; ++it) { const int w2 = it * 8 + wave, dh = w2 / 24, blk16 = w2 - dh * 24, slot = blk16 * 16 + (lane >> 2);
        dil_glds(Vg + (size_t)dil_keyrow(U, slot) * 64 + dh * 32 + (lane & 3) * 8, (unsigned)__builtin_amdgcn_readfirstlane((int)(ldsb + DIL_VIMG + dh * (DIL_NKEY * 64) + blk16 * 1024))); }
}
__device__ __forceinline__ void phase_dilated(const Frame& F, const bf16* Q3, const bf16* KV, bf16* OG, float* LSE) {
    const int lane = F.lane, r = lane & 31, h = lane >> 5, wave = F.wave;
    const int vcu = (F.G % 8 == 0) ? (F.bid % 8) * (F.G / 8) + F.bid / 8 : F.bid;
    const unsigned ldsb = (unsigned)(uintptr_t)F.lds;
    DilUnit U, Un;
    if (!dil_unit(0, vcu, F.G, U)) return;
    dil_stage_k(U, KV, ldsb, wave, lane); dil_stage_v(U, KV, ldsb, wave, lane);
    bf16x8 qf[4], qn[4];
    { const int resw = (U.g == 2) ? U.res_u + (wave >> 2) : U.res_u, v0 = (U.g == 2) ? (wave & 3) * 32 : U.V0 + wave * 32; const int qrow = (U.p >> 4) * S + resw + ((v0 + r) << U.dsh);
      const bf16* qp = Q3 + (size_t)qrow * (3 * D) + U.g * D + (U.p & 15) * 64 + 8 * h;
#pragma unroll
      for (int ds = 0; ds < 4; ++ds) qf[ds] = *(const bf16x8*)(qp + 16 * ds); }
    asm volatile("s_waitcnt vmcnt(0)" ::: "memory"); __builtin_amdgcn_s_barrier(); asm volatile("" ::: "memory");
    for (int n = 0;; ++n) {
        const bool has_next = dil_unit(n + 1, vcu, F.G, Un);
        const int g = U.g, dsh = U.dsh, head = U.p & 15, rowbase = (U.p >> 4) * S;
        const int resw = (g == 2) ? U.res_u + (wave >> 2) : U.res_u, v0 = (g == 2) ? (wave & 3) * 32 : U.V0 + wave * 32, kbase = (g == 2) ? (wave >> 2) * 128 : 128 - U.V0;
        const int qrow = rowbase + resw + ((v0 + r) << dsh);
        const int jstart = (v0 >= 128) ? 0 : ((128 - v0) >> 5);
        f32x16 sc[5]; float m = -INFINITY;
#pragma unroll
        for (int j = 0; j < 5; ++j) {
#pragma unroll
            for (int i = 0; i < 16; ++i) sc[j][i] = -INFINITY;
            if (j >= jstart) {
                const int kr = kbase + v0 - 128 + 32 * j + r; const LAS unsigned char* krow = F.lds + DIL_KIMG + kr * 128; const int sw = (kr >> 1) & 7;
                f32x16 pacc;
#pragma unroll
                for (int i = 0; i < 16; ++i) pacc[i] = 0.f;
#pragma unroll
                for (int ds = 0; ds < 4; ++ds) { const bf16x8 kf = *(const LAS bf16x8*)(krow + (((2 * ds + h) ^ sw) << 4)); pacc = __builtin_amdgcn_mfma_f32_32x32x16_bf16(kf, qf[ds], pacc, 0, 0, 0); }
                if (j == 0) {
#pragma unroll
                    for (int i = 0; i < 16; ++i) if (crow16(i, h) < r) pacc[i] = -INFINITY;
                }
                if (j == 4) {
#pragma unroll
                    for (int i = 0; i < 16; ++i) if (crow16(i, h) > r) pacc[i] = -INFINITY;
                }
                sc[j] = pacc;
#pragma unroll
                for (int i = 0; i < 16; i += 2) m = fmaxf(m, fmaxf(pacc[i], pacc[i + 1]));
            }
        }
        m = fmaxf(m, __shfl_xor(m, 32));
        asm volatile("s_waitcnt lgkmcnt(0)" ::: "memory"); __builtin_amdgcn_s_barrier(); asm volatile("" ::: "memory");
        if (has_next) {
            const int resn = (Un.g == 2) ? Un.res_u + (wave >> 2) : Un.res_u, v0n = (Un.g == 2) ? (wave & 3) * 32 : Un.V0 + wave * 32; const int qrn = (Un.p >> 4) * S + resn + ((v0n + r) << Un.dsh);
            const bf16* qp = Q3 + (size_t)qrn * (3 * D) + Un.g * D + (Un.p & 15) * 64 + 8 * h;
#pragma unroll
            for (int ds = 0; ds < 4; ++ds) qn[ds] = *(const bf16x8*)(qp + 16 * ds);
            asm volatile("" ::: "memory");
            dil_stage_k(Un, KV, ldsb, wave, lane);
        }
        float l = 0.f; bf16x8 pf[5][2];
#pragma unroll
        for (int j = 0; j < 5; ++j) {
            float rs = 0.f;
#pragma unroll
            for (int i = 0; i < 16; ++i) { sc[j][i] = __builtin_amdgcn_exp2f(sc[j][i] - m); rs += sc[j][i]; }
            l += rs;
#pragma unroll
            for (int s2 = 0; s2 < 2; ++s2) { v4u w; w.x = pg8::cvt_pk_bf16(sc[j][8 * s2], sc[j][8 * s2 + 1]); w.y = pg8::cvt_pk_bf16(sc[j][8 * s2 + 2], sc[j][8 * s2 + 3]); w.z = pg8::cvt_pk_bf16(sc[j][8 * s2 + 4], sc[j][8 * s2 + 5]); w.w = pg8::cvt_pk_bf16(sc[j][8 * s2 + 6], sc[j][8 * s2 + 7]); pf[j][s2] = __builtin_bit_cast(bf16x8, w); }
        }
        if (has_next) asm volatile("s_waitcnt vmcnt(6)" ::: "memory"); else asm volatile("s_waitcnt vmcnt(0)" ::: "memory");
        __builtin_amdgcn_s_barrier(); asm volatile("" ::: "memory");
        f32x16 o0, o1;
#pragma unroll
        for (int i = 0; i < 16; ++i) { o0[i] = 0.f; o1[i] = 0.f; }
        const int i16 = lane & 15, q4 = i16 >> 2, p4 = i16 & 3, blk = (lane >> 4) & 1;
#pragma unroll
        for (int j = 0; j < 5; ++j) {
            if (j >= jstart) {
                const int ks0 = kbase + v0 - 128 + 32 * j;
#pragma unroll
                for (int s2 = 0; s2 < 2; ++s2) {
#pragma unroll
                    for (int db = 0; db < 2; ++db) {
                        const LAS unsigned char* a0 = F.lds + DIL_VIMG + db * (DIL_NKEY * 64) + (ks0 + 16 * s2 + 4 * h + q4) * 64 + blk * 32 + p4 * 8;
                        const s16x4 lo = __builtin_bit_cast(s16x4, __builtin_amdgcn_ds_read_tr16_b64_v4i16((LAS s16x4*)a0));
                        const s16x4 hi = __builtin_bit_cast(s16x4, __builtin_amdgcn_ds_read_tr16_b64_v4i16((LAS s16x4*)(a0 + 8 * 64)));
                        const bf16x8 vf = (bf16x8){lo[0], lo[1], lo[2], lo[3], hi[0], hi[1], hi[2], hi[3]};
                        if (db == 0) o0 = __builtin_amdgcn_mfma_f32_32x32x16_bf16(vf, pf[j][s2], o0, 0, 0, 0); else o1 = __builtin_amdgcn_mfma_f32_32x32x16_bf16(vf, pf[j][s2], o1, 0, 0, 0);
                    }
                }
            }
        }
        asm volatile("s_waitcnt vmcnt(0) lgkmcnt(0)" ::: "memory"); __builtin_amdgcn_s_barrier(); asm volatile("" ::: "memory");
        const float lt = l + __shfl_xor(l, 32), inv = 1.0f / lt;
        bf16* op = OG + (size_t)g * T * D + (size_t)qrow * D + head * 64 + 4 * h;
#pragma unroll
        for (int ig = 0; ig < 4; ++ig) { v2u w0, w1; w0.x = pg8::cvt_pk_bf16(o0[4 * ig] * inv, o0[4 * ig + 1] * inv); w0.y = pg8::cvt_pk_bf16(o0[4 * ig + 2] * inv, o0[4 * ig + 3] * inv); w1.x = pg8::cvt_pk_bf16(o1[4 * ig] * inv, o1[4 * ig + 1] * inv); w1.y = pg8::cvt_pk_bf16(o1[4 * ig + 2] * inv, o1[4 * ig + 3] * inv);
            *(v2u*)(op + 8 * ig) = w0; *(v2u*)(op + 32 + 8 * ig) = w1; }
        if (h == 0) LSE[(size_t)g * T * 16 + (size_t)qrow * 16 + head] = m + __builtin_amdgcn_logf(lt);
        if (!has_next) break;
        asm volatile("" ::: "memory");
        dil_stage_v(Un, KV, ldsb, wave, lane);
        U = Un;
#pragma unroll
        for (int ds = 0; ds < 4; ++ds) qf[ds] = qn[ds];
    }
    asm volatile("s_waitcnt vmcnt(0)" ::: "memory");
}

#ifndef REP_P0
#define REP_P0 1
#endif
#ifndef REP_QKV
#define REP_QKV 1
#endif
#ifndef REP_ATTN
#define REP_ATTN 1
#endif
#ifndef REP_SUBLN
#define REP_SUBLN 1
#endif
#ifndef REP_DIL
#define REP_DIL 1
#endif
#ifndef REP_MERGE
#define REP_MERGE 1
#endif
#ifndef REP_M2R
#define REP_M2R 1
#endif
#ifndef REP_SCAT
#define REP_SCAT 1
#endif
#ifndef REP_GU
#define REP_GU 1
#endif
#ifndef REP_DN
#define REP_DN 1
#endif
__global__ void __launch_bounds__(NWAVES * 64, 2) yoco_fwd(Args a_unused) {
    extern __shared__ __attribute__((aligned(16))) unsigned char lds_raw[];
    int ph_lo, ph_hi; unsigned barx = 0;
    {
        ArgsP ap = (ArgsP)__builtin_amdgcn_kernarg_segment_ptr(); ph_lo = ap->ph_lo; ph_hi = ap->ph_hi;
        LAS unsigned char* l0 = (LAS unsigned char*)lds_raw;
        for (int u = threadIdx.x; u < (LDS_BYTES - MISC_OFF) / 4; u += NWAVES * 64) ((LAS unsigned*)(l0 + MISC_OFF))[u] = 0u;
        __syncthreads();
        if (ap->use_bar) { XcdBarrier b0 = xcd_barrier_post((unsigned*)(ap->ws + WS_CTL) + CW_BAR, (volatile LAS unsigned*)(l0 + MISC_OFF)); barx = b0.x; }
    }
    int ph = 0;
#define PH_BEGIN PH_BEGIN_R(1)
#define PH_BEGIN_R(R) if (ph_lo <= ph && ph < ph_hi) { ArgsP ap = (ArgsP)__builtin_amdgcn_kernarg_segment_ptr(); asm volatile("" : "+s"(ap)); unsigned char* ws = ap->ws; Frame F; { int t_ = threadIdx.x; asm volatile("" : "+v"(t_)); \
        unsigned lb_ = 0; asm volatile("" : "+s"(lb_)); F.lds = (LAS unsigned char*)lds_raw + lb_; F.tid = t_; F.lane = t_ & 63; F.wave = __builtin_amdgcn_readfirstlane(t_ >> 6); int g_ = gridDim.x, b_ = blockIdx.x; asm volatile("" : "+s"(g_), "+s"(b_)); F.G = g_; F.bid = b_; F.gw = b_ * NWAVES + F.wave; F.NGW = g_ * NWAVES; } \
        for (int rep_ = 0; rep_ < (R); ++rep_) { if (rep_ > 0) MK_BARRIER();
#define MK_BARRIER() do { XcdBarrier b_; b_.bar = (unsigned*)(ws + WS_CTL) + CW_BAR; b_.x = barx; b_.st = (volatile LAS unsigned*)(F.lds + MISC_OFF); xcd_barrier(b_); } while (0)
#define PH_END } if (ph + 1 < ph_hi) MK_BARRIER(); } ++ph;
#define P_MODALL ((float*)(ws + WS_MOD))
#define P_XRES ((float*)(ws + WS_X))
#define P_HBUF ((bf16*)(ws + WS_H))
#define P_HKV ((bf16*)(ws + WS_HKV))
#define P_QBUF ((bf16*)(ws + WS_Q))
#define P_KVSH ((bf16*)(ws + WS_KVSH))
#define P_OBUF ((bf16*)(ws + WS_O))
#define P_OPBUF ((bf16*)(ws + WS_OP))
#define P_LSE ((float*)(ws + WS_LSE))
#define P_HS ((bf16*)(ws + WS_HS))
#define P_ACT ((bf16*)(ws + WS_ACT))
#define P_Y ((bf16*)(ws + WS_Y))
#define P_TKE ((int*)(ws + WS_TKE))
#define P_TKW ((float*)(ws + WS_TKW))
#define P_TKL ((int*)(ws + WS_TKL))
#define P_SLOT ((int*)(ws + WS_SLOT))
#define P_WGCNT ((int*)(ws + WS_WGCNT))
#define P_TEXP ((int*)(ws + WS_TEXP))
#define P_NTW ((unsigned*)(ws + WS_NT))
#define P_ROWTOK ((int*)(ws + WS_ROWTOK))
#define P_COS ((const float*)(ws + WS_ROPE))
#define P_SIN ((const float*)(ws + WS_ROPE) + S * 8)

    PH_BEGIN_R(REP_P0) p0_prologue(F, ap); PH_END
    PH_BEGIN phase_modulate0(F, ap->in[I_X], ap->in[I_MIXN], P_MODALL, 0, D, P_HBUF); PH_END

    for (int st = 0; st < 5; ++st) {
        const int kind = (st < 2) ? 0 : (st == 2 ? 1 : 2);
        const int l = (st < 2) ? st : st - 1;
        const int j = l - 2;
        PH_BEGIN_R(REP_QKV) {
            pg8::Gemm g; pg8::EpiRope E; int nN;
            if (kind == 0) { g = pg8::Gemm{P_HBUF, (const bf16*)(ws + WS_WQKV) + (size_t)l * 3 * D * D, T, 3 * D, D, 0}; nN = 12; E = pg8::EpiRope{P_QBUF, D, D, (size_t)T * D, 2 * D, D, QSCALE, P_COS, P_SIN, 0}; }
            else if (kind == 1) { g = pg8::Gemm{P_HKV, (const bf16*)(ws + WS_KVW), T, 2 * D, D, 0}; nN = 8; E = pg8::EpiRope{P_KVSH, 2 * D, 0, 0, D, 0, 1.0f, P_COS, P_SIN, 1}; }
            else { g = pg8::Gemm{P_HBUF, (const bf16*)(ws + WS_BWQ) + (size_t)j * 3 * D * D, T, 3 * D, D, 0}; nN = 12; E = pg8::EpiRope{P_QBUF, 3 * D, 0, 0, 3 * D, 3 * D, QSCALE, P_COS, P_SIN, 0}; }
            pg8::Order O; O.init(T / 256, nN, F.G, F.bid, nullptr, nullptr);
            pg8::gemm_phase<pg8::EpiRope, pg8::Order, false>(F.lds, g, O, E);
        } PH_END
        if (kind == 1) continue;
        if (kind == 0) {
            PH_BEGIN_R(REP_ATTN) {
                const attn_body::bf16* Qp = (const attn_body::bf16*)P_QBUF; const attn_body::bf16* Kp = Qp + (size_t)T * D; const attn_body::bf16* Vp = Kp + (size_t)T * D; attn_body::bf16* Op = (attn_body::bf16*)P_OPBUF;
                const int vcu = (F.G % 8 == 0) ? (F.bid % 8) * (F.G / 8) + F.bid / 8 : F.bid;
                LAS float* cscr = (LAS float*)(F.wave < 5 ? F.lds + attn_body::ATTN_LDS_BYTES + F.wave * 8448 : F.lds + ROWTAB_OFF + (F.wave - 5) * 8448);
                const int myslot = vcu & 15;
                for (int p = vcu; p < NB * 16; p += F.G) { const int b = p >> 4, hh = p & 15, hq = hh >> 1, mm = hh & 1;
                    for (int half = 0; half < 2; ++half)
                        for (int qb = 0; qb < S / 256; ++qb) {
                            attn_body::attn_unit<8>(b, qb, Qp + hh * 64, Kp + hh * 64, Vp + hq * 128 + half * 64, Op + (size_t)mm * T * D + hq * 128 + half * 64, (char*)F.lds);
                            if (p == vcu && rep_ == 0 && half * 8 + qb == myslot) convert_experts(F, ap, 2 * l, cscr); } }
            } PH_END
            PH_BEGIN_R(REP_SUBLN) phase_subln(F, P_OPBUF, ap->in[I_ALAM] + l * 256, ap->in[I_ASUBLN] + l * 128, ap->lam_init[l & 1], P_OBUF); PH_END
        } else {
            PH_BEGIN_R(REP_DIL) phase_dilated(F, P_QBUF, P_KVSH, P_OPBUF, P_LSE); PH_END
            PH_BEGIN_R(REP_MERGE) phase_merge(F, P_OPBUF, P_LSE, P_OBUF); PH_END
        }
        PH_BEGIN {
            const bf16* wo = (kind == 0) ? (const bf16*)(ws + WS_AWO) + (size_t)l * D * D : (const bf16*)(ws + WS_BWO) + (size_t)j * D * D;
            pg8::Gemm g{P_OBUF, wo, T, D, D, 0}; pg8::Order O; O.init(T / 256, 4, F.G, F.bid, nullptr, nullptr);
            pg8::EpiResid E{(l == 0) ? ap->in[I_X] : P_XRES, P_XRES, P_MODALL + l * 6 * D + 2 * D, MODC};
            pg8::gemm_phase<pg8::EpiResid, pg8::Order, false>(F.lds, g, O, E);
        } PH_END
        PH_BEGIN_R(REP_M2R) phase_mod2_router(F, P_XRES, ap->in[I_FFNN] + l * D, P_MODALL, l * 6 * D + 3 * D, l * 6 * D + 4 * D, (const bf16*)(ws + WS_RFRAG) + (size_t)l * 65536, ap->in[I_RB] + l * NE, P_HBUF, P_TKE, P_TKW, P_TKL, P_WGCNT); PH_END
        PH_BEGIN_R(REP_SCAT) phase_scatter(F, P_WGCNT, P_TKE, P_TKL, P_SLOT, P_ROWTOK, P_TEXP, P_NTW); PH_END
        PH_BEGIN_R(REP_GU) {
            const int nt = (int)__hip_atomic_load(P_NTW, RLX_AGENT); LAS int* tl = (LAS int*)(F.lds + TEXP_OFF); LAS int* rt = (LAS int*)(F.lds + ROWTAB_OFF);
            for (int i = F.tid; i < nt; i += NWAVES * 64) tl[i] = P_TEXP[i];
            __syncthreads();
            constexpr size_t ESZ = MOE_F8 ? 1 : 2;
            pg8::Gemm g{(const bf16*)P_HBUF, (const bf16*)(ws + WS_WGU + (size_t)l * NE * 2 * D * D * ESZ), nt * 256, 2 * D, D, (size_t)2 * D * D * ESZ}; pg8::OrderT<true> O; O.init(nt, 8, F.G, F.bid, tl, rt);
            { pg8::Unit u_; const int* rtk = P_ROWTOK; for (int i = 0; O.next(i, u_); ++i) if (F.tid < 256) rt[i * 256 + F.tid] = rtk[u_.pm * 256 + F.tid]; }
            __syncthreads();
            pg8::EpiSwiglu<MOE_F8 != 0> E{P_ACT, ap->in[I_BGU] + (size_t)l * NE * 2 * D};
            pg8::gemm_phase<pg8::EpiSwiglu<MOE_F8 != 0>, pg8::OrderT<true>, MOE_F8 != 0>(F.lds, g, O, E);
        } PH_END
        PH_BEGIN_R(REP_DN) {
            const int nt = (int)__hip_atomic_load(P_NTW, RLX_AGENT); LAS int* tl = (LAS int*)(F.lds + TEXP_OFF);
            for (int i = F.tid; i < nt; i += NWAVES * 64) tl[i] = P_TEXP[i];
            __syncthreads();
            constexpr size_t ESZ = MOE_F8 ? 1 : 2;
            pg8::Gemm g{P_ACT, (const bf16*)(ws + WS_WDN + (size_t)l * NE * D * D * ESZ), nt * 256, D, D, (size_t)D * D * ESZ}; pg8::Order O; O.init(nt, 4, F.G, F.bid, tl, nullptr);
            pg8::EpiDown E{P_Y, ap->in[I_BDN] + (size_t)l * NE * D};
            pg8::gemm_phase<pg8::EpiDown, pg8::Order, MOE_F8 != 0>(F.lds, g, O, E);
        } PH_END
        PH_BEGIN {
            const int mode = (l == 3) ? 2 : (l == 1 ? 1 : 0);
            const float* gainA = (l == 3) ? ap->in[I_FINN] : ap->in[I_MIXN] + (l + 1) * D; const int shA = (l == 3) ? MOD_FIN : (l + 1) * 6 * D, scA = shA + D;
            phase_combine(F, P_XRES, P_Y, P_SLOT, P_TKW, P_MODALL + l * 6 * D + 5 * D, mode, gainA, P_MODALL, shA, scA, P_HBUF, ap->in[I_KVN], MOD_KV, MOD_KV + D, P_HKV, ap->out);
        } PH_END
    }
#undef PH_BEGIN
#undef PH_END
}
constexpr int N_PHASES = 2 + 9 + 9 + 1 + 9 + 9;

#ifndef MK_PER_PHASE
#define MK_PER_PHASE 0
#endif
extern "C" void kernel_launch(void* const* d_in, const int* in_sizes, int n_in, void* d_out, int out_size, void* d_ws, size_t ws_size, hipStream_t stream) {
    static int grid = 0;
    if (grid == 0) {
        if (n_in != 25 || in_sizes[0] != T * D || out_size != T * D || ws_size < WS_END) { fprintf(stderr, "kernel_launch: unexpected shapes / workspace (n_in %d, ws %zu)\n", n_in, ws_size); grid = -1; return; }
        int dev = 0, cus = 0, per_cu = 0;
        if (hipGetDevice(&dev) != hipSuccess || hipDeviceGetAttribute(&cus, hipDeviceAttributeMultiprocessorCount, dev) != hipSuccess) { grid = -1; return; }
        if (hipFuncSetAttribute((const void*)yoco_fwd, hipFuncAttributeMaxDynamicSharedMemorySize, LDS_BYTES) != hipSuccess) { fprintf(stderr, "kernel_launch: hipFuncSetAttribute failed\n"); grid = -1; return; }
        if (hipOccupancyMaxActiveBlocksPerMultiprocessor(&per_cu, (const void*)yoco_fwd, NWAVES * 64, LDS_BYTES) != hipSuccess || per_cu < 1) fprintf(stderr, "kernel_launch: occupancy query reports %d\n", per_cu);
        (void)hipGetLastError();
        grid = cus;
    }
    if (grid < 0) return;
    if (hipMemsetAsync((char*)d_ws + WS_CTL, 0, CTL_ZERO_BYTES, stream) != hipSuccess) return;
    Args a{};
    for (int i = 0; i < 25; ++i) a.in[i] = (const float*)d_in[i];
    a.out = (float*)d_out; a.ws = (unsigned char*)d_ws;
    for (int i = 0; i < 8; ++i) a.invf[i] = (float)pow(500000.0, -(double)(2 * i) / 16.0);
    a.lam_init[0] = (float)(0.8 - 0.6 * exp(-0.3 * 0.0)); a.lam_init[1] = (float)(0.8 - 0.6 * exp(-0.3 * 1.0));
#if MK_PER_PHASE
    for (int p = 0; p < N_PHASES; ++p) { a.ph_lo = p; a.ph_hi = p + 1; a.use_bar = 0; hipLaunchKernelGGL(yoco_fwd, dim3(grid), dim3(NWAVES * 64), LDS_BYTES, stream, a); }
#else
    a.ph_lo = 0; a.ph_hi = N_PHASES; a.use_bar = 1; hipLaunchKernelGGL(yoco_fwd, dim3(grid), dim3(NWAVES * 64), LDS_BYTES, stream, a);
#endif
}
```

```cpp
#include <hip/hip_runtime.h>
#include <hip/hip_bf16.h>
#include <cstdio>
#include <cstdint>
#include <cmath>
namespace pg8 {
#define PG8_LAS __attribute__((address_space(3)))
typedef unsigned short bf16_t;
typedef short bf16x8 __attribute__((ext_vector_type(8)));
typedef float f32x4 __attribute__((ext_vector_type(4)));
typedef unsigned u32x4 __attribute__((ext_vector_type(4)));
constexpr int BM = 256, BK = 64, HALF = 128, HTB = HALF * BK * 2  , STAGE_BYTES = 8 * HTB, NXCD = 8, WGM = 8;

__host__ __device__ __forceinline__ int lds_byte(int r, int c) { const int st = (r >> 4) * 2 + (c >> 5), rr = r & 15, cc = c & 31, ob = rr * 64 + cc * 2; return st * 1024 + (ob ^ (((ob >> 9) & 1) << 5)); }
__host__ __device__ __forceinline__ void stage_rc(int b, int& R, int& C) { const int st = b / 1024, sb = b % 1024, swz = sb ^ (((sb >> 9) & 1) << 5); R = (st >> 1) * 16 + swz / 64; C = (st & 1) * 32 + (swz % 64) / 2; }
__host__ __device__ __forceinline__ int perm32(int rho) { const int n = rho >> 4, i = rho & 15; return 8 * (i >> 2) + 4 * n + (i & 3); }

struct Unit { int pm, pn, e, ui; };
struct Gemm { const bf16_t* A; const bf16_t* Bt; int M, N, K; size_t estride; };

template <bool GATHER> struct OrderT {
    int nM, nN, nwg, G, c; const PG8_LAS int* texp; const PG8_LAS int* rowtab;
    __device__ __forceinline__ void init(int nM_, int nN_, int G_, int c_, const PG8_LAS int* texp_, const PG8_LAS int* rowtab_) { nM = nM_; nN = nN_; nwg = nM * nN; G = G_; c = c_; texp = texp_; rowtab = rowtab_; }
    __device__ __forceinline__ bool next(int i, Unit& u) const {
        const long L = (long)i * G + c; if (L >= nwg) return false;
        int wgid = (int)L; { const int q = nwg / NXCD, r = nwg % NXCD, xcd = wgid % NXCD, off = wgid / NXCD; wgid = (xcd < r ? xcd * (q + 1) : r * (q + 1) + (xcd - r) * q) + off; }
        const int nig = WGM * nN, gid = wgid / nig, fm = gid * WGM, gsz = (nM - fm) < WGM ? (nM - fm) : WGM;
        u.pm = fm + ((wgid % nig) % gsz); u.pn = (wgid % nig) / gsz; u.e = texp ? texp[u.pm] : 0; u.ui = i; return true;
    }
    __device__ __forceinline__ int arow(const Unit& u, int r) const { if constexpr (GATHER) return rowtab[u.ui * 256 + r]; else return u.pm * 256 + r; }
};
typedef OrderT<false> Order;

__device__ __forceinline__ unsigned cvt_pk_bf16(float lo, float hi) { unsigned r; asm volatile("v_cvt_pk_bf16_f32 %0, %1, %2" : "=v"(r) : "v"(lo), "v"(hi)); return r; }
__device__ __forceinline__ unsigned pk4_fp8(float a, float b, float c, float d) { unsigned u = (unsigned)__builtin_amdgcn_cvt_pk_fp8_f32(a, b, 0, false); return (unsigned)__builtin_amdgcn_cvt_pk_fp8_f32(c, d, (int)u, true); }
__device__ __forceinline__ f32x4 shfl16(f32x4 v) { f32x4 o; o[0] = __shfl_xor(v[0], 16); o[1] = __shfl_xor(v[1], 16); o[2] = __shfl_xor(v[2], 16); o[3] = __shfl_xor(v[3], 16); return o; }

struct EpiRope {
    static constexpr bool PERM = true, AFTER_DRAIN = false;
    bf16_t* O; int ldc; int split_cols; size_t split_stride; int rope_cols, scale_cols; float qscale; const float* cosT; const float* sinT;
    int headmajor;
    __device__ __forceinline__ void operator()(const f32x4 (&acc)[2][2][4][2], const Unit& u, int wr, int wc, int fr, int fq) const {
        const int row0 = u.pm * BM + wr * 64 + fr; int colt = u.pn * BM; bf16_t* base = O;
        const bool do_rope = (colt < rope_cols) && ((wc & 1) == 0); const float sc = (colt < scale_cols) ? qscale : 1.f;
        if (split_cols) { const int t = colt / split_cols; base += (size_t)t * split_stride; colt -= t * split_cols; }
        const int col0 = colt + wc * 32 + 8 * fq;
#pragma unroll
        for (int ai = 0; ai < 2; ++ai)
#pragma unroll
            for (int m = 0; m < 4; ++m) { const int row = row0 + ai * HALF + m * 16; bf16_t* rowp = base + (size_t)row * ldc + col0;
                if (headmajor) { const int cc = col0; rowp = base + ((size_t)((((cc >> 10) * 16 + (row >> 11)) * 16 + ((cc >> 6) & 15))) * 2048 + (row & 2047)) * 64 + (cc & 63); }
                f32x4 c0 = (f32x4){1.f, 1.f, 1.f, 1.f}, c1 = c0, s0 = (f32x4){0.f, 0.f, 0.f, 0.f}, s1 = s0;
                if (do_rope) { const int t = row & 2047; c0 = *(const f32x4*)(cosT + t * 8); c1 = *(const f32x4*)(cosT + t * 8 + 4); s0 = *(const f32x4*)(sinT + t * 8); s1 = *(const f32x4*)(sinT + t * 8 + 4);
                    if (fq == 0) { s0 = -s0; s1 = -s1; } else if (fq >= 2) { c0 = (f32x4){1.f, 1.f, 1.f, 1.f}; c1 = c0; s0 = (f32x4){0.f, 0.f, 0.f, 0.f}; s1 = s0; } }
#pragma unroll
                for (int bj = 0; bj < 2; ++bj) { f32x4 v0 = acc[ai][bj][m][0], v1 = acc[ai][bj][m][1];
                    if (do_rope) { const f32x4 o0 = shfl16(v0), o1 = shfl16(v1); v0 = v0 * c0 + o0 * s0; v1 = v1 * c1 + o1 * s1; }
                    v0 = v0 * sc; v1 = v1 * sc; u32x4 w; w.x = cvt_pk_bf16(v0[0], v0[1]); w.y = cvt_pk_bf16(v0[2], v0[3]); w.z = cvt_pk_bf16(v1[0], v1[1]); w.w = cvt_pk_bf16(v1[2], v1[3]);
                    *(u32x4*)(rowp + (headmajor ? bj * (2 * 2048 * 64) : bj * HALF)) = w; } }
    }
};
struct EpiResid {
    static constexpr bool PERM = false, AFTER_DRAIN = false;
    const float* xin; float* xout; const float* gate; int gstride; float* ssp;
    __device__ __forceinline__ void operator()(const f32x4 (&acc)[2][2][4][2], const Unit& u, int wr, int wc, int fr, int fq) const {
        const int row0 = u.pm * BM + wr * 64 + fr, col0 = u.pn * BM + wc * 32 + 4 * fq; const float* gp = gate + (size_t)(u.pm >> 3) * gstride + col0;
        f32x4 gv[2][2];
#pragma unroll
        for (int bj = 0; bj < 2; ++bj)
#pragma unroll
            for (int n = 0; n < 2; ++n) gv[bj][n] = *(const f32x4*)(gp + bj * HALF + n * 16);
#pragma unroll
        for (int ai = 0; ai < 2; ++ai)
#pragma unroll
            for (int m = 0; m < 4; ++m) { const int row = row0 + ai * HALF + m * 16; const size_t off = (size_t)row * 1024 + col0; float ss = 0.f;
#pragma unroll
                for (int bj = 0; bj < 2; ++bj)
#pragma unroll
                    for (int n = 0; n < 2; ++n) { const f32x4 xi = *(const f32x4*)(xin + off + bj * HALF + n * 16); const f32x4 xo = xi + gv[bj][n] * acc[ai][bj][m][n]; *(f32x4*)(xout + off + bj * HALF + n * 16) = xo;
                        ss += (xo[0] * xo[0] + xo[1] * xo[1]) + (xo[2] * xo[2] + xo[3] * xo[3]); }
                ss += __shfl_xor(ss, 16); ss += __shfl_xor(ss, 32);
                if (fq == 0) ssp[(size_t)row * 16 + u.pn * 4 + wc] = ss;
                if (m & 1) asm volatile("" ::: "memory"); }
    }
};
template <bool F8> struct EpiSwiglu {
    static constexpr bool PERM = true, AFTER_DRAIN = false;
    bf16_t* act; const float* bgu;
    __device__ __forceinline__ void operator()(const f32x4 (&acc)[2][2][4][2], const Unit& u, int wr, int wc, int fr, int fq) const {
        const int row0 = u.pm * BM + wr * 64 + fr, acol0 = u.pn * HALF + wc * 32 + 8 * fq; const float* bp = bgu + (size_t)u.e * 2048 + acol0;
        const f32x4 bg0 = *(const f32x4*)(bp), bg1 = *(const f32x4*)(bp + 4), bu0 = *(const f32x4*)(bp + 1024), bu1 = *(const f32x4*)(bp + 1028);
#pragma unroll
        for (int ai = 0; ai < 2; ++ai)
#pragma unroll
            for (int m = 0; m < 4; ++m) { const size_t eoff_ = (size_t)(row0 + ai * HALF + m * 16) * 1024 + acol0;
                f32x4 g0 = acc[ai][0][m][0] + bg0, g1 = acc[ai][0][m][1] + bg1, u0 = acc[ai][1][m][0] + bu0, u1 = acc[ai][1][m][1] + bu1; f32x4 r0, r1;
#pragma unroll
                for (int j = 0; j < 4; ++j) { const float ga = fminf(g0[j], 7.0f), gb = fminf(g1[j], 7.0f), ua = fminf(fmaxf(u0[j], -7.0f), 7.0f), ub = fminf(fmaxf(u1[j], -7.0f), 7.0f);
                    const float sa = __builtin_amdgcn_rcpf(1.0f + __builtin_amdgcn_exp2f(ga * (-1.702f * 1.4426950408889634f))), sb = __builtin_amdgcn_rcpf(1.0f + __builtin_amdgcn_exp2f(gb * (-1.702f * 1.4426950408889634f)));
                    r0[j] = (ua + 1.0f) * (ga * sa); r1[j] = (ub + 1.0f) * (gb * sb); }
                if constexpr (F8) { typedef unsigned u32x2_ __attribute__((ext_vector_type(2))); u32x2_ w; w.x = pk4_fp8(r0[0], r0[1], r0[2], r0[3]); w.y = pk4_fp8(r1[0], r1[1], r1[2], r1[3]); *(u32x2_*)((unsigned char*)act + eoff_) = w; }
                else { u32x4 w; w.x = cvt_pk_bf16(r0[0], r0[1]); w.y = cvt_pk_bf16(r0[2], r0[3]); w.z = cvt_pk_bf16(r1[0], r1[1]); w.w = cvt_pk_bf16(r1[2], r1[3]); *(u32x4*)(act + eoff_) = w; } }
    }
};
struct EpiDown {
    static constexpr bool PERM = true, AFTER_DRAIN = false;
    bf16_t* Y; const float* bd;
    __device__ __forceinline__ void operator()(const f32x4 (&acc)[2][2][4][2], const Unit& u, int wr, int wc, int fr, int fq) const {
        const int row0 = u.pm * BM + wr * 64 + fr, col0 = u.pn * BM + wc * 32 + 8 * fq; const float* bp = bd + (size_t)u.e * 1024 + col0;
        f32x4 bv[2][2];
#pragma unroll
        for (int bj = 0; bj < 2; ++bj)
#pragma unroll
            for (int n = 0; n < 2; ++n) bv[bj][n] = *(const f32x4*)(bp + bj * HALF + 4 * n);
#pragma unroll
        for (int ai = 0; ai < 2; ++ai)
#pragma unroll
            for (int m = 0; m < 4; ++m) { bf16_t* rowp = Y + (size_t)(row0 + ai * HALF + m * 16) * 1024 + col0;
#pragma unroll
                for (int bj = 0; bj < 2; ++bj) { const f32x4 v0 = acc[ai][bj][m][0] + bv[bj][0], v1 = acc[ai][bj][m][1] + bv[bj][1];
                    u32x4 w; w.x = cvt_pk_bf16(v0[0], v0[1]); w.y = cvt_pk_bf16(v0[2], v0[3]); w.z = cvt_pk_bf16(v1[0], v1[1]); w.w = cvt_pk_bf16(v1[2], v1[3]);
                    *(u32x4*)(rowp + bj * HALF) = w; } }
    }
};

typedef int v8i_t __attribute__((ext_vector_type(8)));
typedef int v4i_t __attribute__((ext_vector_type(4)));
template <class Epi, class Sched, bool F8>
__device__ __forceinline__ void gemm_phase(PG8_LAS unsigned char* lds, const Gemm g, const Sched& S, const Epi& E) {
    int tid_ = threadIdx.x; asm volatile("" : "+v"(tid_));
    const int tid = tid_, wid = __builtin_amdgcn_readfirstlane(tid >> 6), lane = tid & 63, wr = wid >> 2, wc = wid & 3, fr = lane & 15, fq = lane >> 4;
    constexpr int ROWB = F8 ? 1024 : 2048, nt = ROWB / 128;
    unsigned voffB[2], cvA0[2], cvA1[2];
#pragma unroll
    for (int i = 0; i < 2; ++i) { int R, C; stage_rc(tid * 16 + i * 8192, R, C); const int Rb = Epi::PERM ? ((R & ~31) + perm32(R & 31)) : R; voffB[i] = (unsigned)(Rb * ROWB) + (unsigned)C * 2u; }
    constexpr size_t kstep = 128;
    constexpr size_t hstep = (size_t)HALF * ROWB;
    constexpr size_t tstep = 2 * hstep;
    const unsigned ldsm0 = (unsigned)__builtin_amdgcn_readfirstlane((int)((unsigned)(uintptr_t)lds + (unsigned)wid * 1024u));
    unsigned abase_ = (unsigned)(uintptr_t)(lds + lds_byte(wr * 64 + fr, fq * 8)), bbase_ = (unsigned)(uintptr_t)(lds + 4 * HTB + lds_byte(wc * 32 + fr, fq * 8));
    asm volatile("" : "+v"(abase_), "+v"(bbase_));
    const PG8_LAS unsigned char* const abase = (const PG8_LAS unsigned char*)(uintptr_t)abase_; const PG8_LAS unsigned char* const bbase = (const PG8_LAS unsigned char*)(uintptr_t)bbase_;
#define PG8_SA(b, h) (((b) * 2 + (h)) * HTB)
#define PG8_SB(b, h) ((4 + (b) * 2 + (h)) * HTB)
#define PG8_STAGE(bufoff, gbase, voff) do { _Pragma("unroll") for (int _i = 0; _i < 2; ++_i) { unsigned keep_; \
        asm volatile("s_mov_b32 %0, m0\n\ts_mov_b32 m0, %3\n\ts_nop 0\n\tglobal_load_lds_dwordx4 %1, %2\n\ts_mov_b32 m0, %0" : "=&s"(keep_) : "v"((voff)[_i]), "s"((const char*)(gbase)), "s"(ldsm0 + (unsigned)((bufoff) + _i * 8192)) : "memory"); } } while (0)
#define PG8_RD(p) __builtin_bit_cast(v4i_t, *(const PG8_LAS bf16x8*)(p))
#define PG8_LDA(dst, b, h) do { _Pragma("unroll") for (int m = 0; m < 4; ++m) dst[m] = __builtin_shufflevector(PG8_RD(abase + PG8_SA(b, h) + m * 2048), PG8_RD(abase + PG8_SA(b, h) + m * 2048 + 1024), 0, 1, 2, 3, 4, 5, 6, 7); } while (0)
#define PG8_LDB(dst, b, h) do { _Pragma("unroll") for (int n = 0; n < 2; ++n) dst[n] = __builtin_shufflevector(PG8_RD(bbase + (PG8_SB(b, h) - 4 * HTB) + n * 2048), PG8_RD(bbase + (PG8_SB(b, h) - 4 * HTB) + n * 2048 + 1024), 0, 1, 2, 3, 4, 5, 6, 7); } while (0)
#define PG8_LO(x) __builtin_bit_cast(bf16x8, __builtin_shufflevector((x), (x), 0, 1, 2, 3))
#define PG8_HI(x) __builtin_bit_cast(bf16x8, __builtin_shufflevector((x), (x), 4, 5, 6, 7))
#define PG8_MMA(ai, bj, At, Bt) do { __builtin_amdgcn_s_setprio(1); \
        if constexpr (F8) { _Pragma("unroll") for (int m = 0; m < 4; ++m) _Pragma("unroll") for (int n = 0; n < 2; ++n) \
            acc[ai][bj][m][n] = __builtin_amdgcn_mfma_scale_f32_16x16x128_f8f6f4(Bt[n], At[m], acc[ai][bj][m][n], 0, 0, 0, 0x7b7b7b7b, 0, 0x7b7b7b7b);     } \
        else { _Pragma("unroll") for (int m = 0; m < 4; ++m) _Pragma("unroll") for (int n = 0; n < 2; ++n) { \
            acc[ai][bj][m][n] = __builtin_amdgcn_mfma_f32_16x16x32_bf16(PG8_LO(Bt[n]), PG8_LO(At[m]), acc[ai][bj][m][n], 0, 0, 0); \
            acc[ai][bj][m][n] = __builtin_amdgcn_mfma_f32_16x16x32_bf16(PG8_HI(Bt[n]), PG8_HI(At[m]), acc[ai][bj][m][n], 0, 0, 0); } } \
        __builtin_amdgcn_s_setprio(0); } while (0)
#define PG8_WAIT_V(n) asm volatile("s_waitcnt vmcnt(" #n ")" ::: "memory")
#define PG8_WAIT_L(n) asm volatile("s_waitcnt lgkmcnt(" #n ")" ::: "memory")
#define PG8_BAR __builtin_amdgcn_s_barrier()
#define PG8_SCHED __builtin_amdgcn_sched_barrier(0)
    Unit cur, nxt; int ui = 0;
    if (!S.next(0, cur)) return;
    f32x4 acc[2][2][4][2];
#pragma unroll
    for (int a = 0; a < 2; ++a)
#pragma unroll
        for (int b = 0; b < 2; ++b)
#pragma unroll
            for (int m = 0; m < 4; ++m)
#pragma unroll
                for (int n = 0; n < 2; ++n) acc[a][b][m][n] = (f32x4){0.f, 0.f, 0.f, 0.f};
    v8i_t At[4], B0[2], B1[2];
    const char* const Ab = (const char*)g.A;
#pragma unroll
    for (int i = 0; i < 2; ++i) { int R, C; stage_rc(tid * 16 + i * 8192, R, C); cvA0[i] = (unsigned)S.arow(cur, R) * (unsigned)ROWB + (unsigned)C * 2u; cvA1[i] = (unsigned)S.arow(cur, HALF + R) * (unsigned)ROWB + (unsigned)C * 2u; }
    const char* cB = (const char*)g.Bt + (size_t)cur.pn * tstep + (size_t)cur.e * g.estride;
    PG8_STAGE(PG8_SB(0, 0), cB, voffB); PG8_STAGE(PG8_SB(0, 1), cB + hstep, voffB); PG8_STAGE(PG8_SA(0, 0), Ab, cvA0); PG8_STAGE(PG8_SA(0, 1), Ab, cvA1);
    if (wr == 1) PG8_BAR;
    PG8_WAIT_V(2); PG8_BAR;
    PG8_STAGE(PG8_SB(1, 0), cB + kstep, voffB); PG8_STAGE(PG8_SA(1, 0), Ab + kstep, cvA0); PG8_STAGE(PG8_SB(1, 1), cB + hstep + kstep, voffB);
    PG8_WAIT_V(6); PG8_BAR;
    for (;;) {
        const bool has_next = S.next(ui + 1, nxt);
        const char* nB = has_next ? (const char*)g.Bt + (size_t)nxt.pn * tstep + (size_t)nxt.e * g.estride : cB;
#pragma clang loop unroll(disable)
        for (int t = 0; t < nt; t += 2) {
            const bool last = (t == nt - 2);
            const char* a1 = Ab + (size_t)(t + 1) * kstep;
            const char* a2 = last ? Ab : Ab + (size_t)(t + 2) * kstep; const char* b2 = last ? nB : cB + (size_t)(t + 2) * kstep;
            const char* a3 = a2 + kstep; const char* b3 = b2 + kstep;
            PG8_LDB(B0, 0, 0); PG8_LDB(B1, 0, 1); PG8_SCHED; PG8_LDA(At, 0, 0); PG8_STAGE(PG8_SA(1, 1), a1, cvA1);
            if (last && has_next) {
                int t2_ = tid; asm volatile("" : "+v"(t2_));
#pragma unroll
                for (int i = 0; i < 2; ++i) { int R, C; stage_rc(t2_ * 16 + i * 8192, R, C); cvA0[i] = (unsigned)S.arow(nxt, R) * (unsigned)ROWB + (unsigned)C * 2u; cvA1[i] = (unsigned)S.arow(nxt, HALF + R) * (unsigned)ROWB + (unsigned)C * 2u; }
            }
            PG8_WAIT_V(8); PG8_WAIT_L(0); PG8_BAR; PG8_MMA(0, 0, At, B0); PG8_MMA(0, 1, At, B1); PG8_BAR; PG8_SCHED;
            PG8_LDA(At, 0, 1); PG8_STAGE(PG8_SB(0, 0), b2, voffB); PG8_STAGE(PG8_SB(0, 1), b2 + hstep, voffB); PG8_STAGE(PG8_SA(0, 0), a2, cvA0);
            PG8_WAIT_V(8); PG8_WAIT_L(0); PG8_BAR; PG8_MMA(1, 0, At, B0); PG8_MMA(1, 1, At, B1); PG8_BAR; PG8_SCHED;
            PG8_LDB(B0, 1, 0); PG8_LDB(B1, 1, 1); PG8_SCHED; PG8_LDA(At, 1, 0); PG8_STAGE(PG8_SA(0, 1), a2, cvA1);
            PG8_WAIT_V(8); PG8_WAIT_L(0); PG8_BAR; PG8_MMA(0, 0, At, B0); PG8_MMA(0, 1, At, B1); PG8_BAR; PG8_SCHED;
            PG8_LDA(At, 1, 1); PG8_STAGE(PG8_SB(1, 0), b3, voffB); PG8_STAGE(PG8_SB(1, 1), b3 + hstep, voffB); PG8_STAGE(PG8_SA(1, 0), a3, cvA0);
            PG8_WAIT_V(8); PG8_WAIT_L(0); PG8_BAR; PG8_MMA(1, 0, At, B0); PG8_MMA(1, 1, At, B1); PG8_BAR; PG8_SCHED;
        }
        if (wr == 0) PG8_BAR;
        E(acc, cur, wr, wc, fr, fq);
        if (!has_next) break;
#pragma unroll
        for (int a = 0; a < 2; ++a)
#pragma unroll
            for (int b = 0; b < 2; ++b)
#pragma unroll
                for (int m = 0; m < 4; ++m)
#pragma unroll
                    for (int n = 0; n < 2; ++n) acc[a][b][m][n] = (f32x4){0.f, 0.f, 0.f, 0.f};
        cur = nxt; cB = nB; ++ui;
        if (wr == 1) PG8_BAR;
    }
    PG8_WAIT_V(0);
    PG8_BAR;
#undef PG8_SA
#undef PG8_SB
#undef PG8_STAGE
#undef PG8_LDA
#undef PG8_LDB
#undef PG8_RD
#undef PG8_LO
#undef PG8_HI
#undef PG8_MMA
#undef PG8_WAIT_V
#undef PG8_WAIT_L
#undef PG8_BAR
#undef PG8_SCHED
}
}
namespace attn_body {
using bf16=__hip_bfloat16;
using bf16x8=__attribute__((ext_vector_type(8)))short;
using s16x4=__attribute__((ext_vector_type(4)))short;
using f32x16=__attribute__((ext_vector_type(16)))float;
using u32x4=__attribute__((ext_vector_type(4)))unsigned;
constexpr int BATCH=16,NHEAD=16,SEQ=2048,D=64,DM=NHEAD*D;
constexpr int NW=8,QBLK=32,QB=QBLK*NW,KVBLK=64,NQB=SEQ/QB;
constexpr int ATTN_PITCH=DM, ATTN_UNIT_ROWS=QB;
__device__ __forceinline__ int crow(int r,int hi){return (r&3)+8*(r>>2)+4*hi;}
#define SBAR() __builtin_amdgcn_sched_barrier(0)
__device__ __forceinline__ void cmask(f32x16&p0,f32x16&p1,int jb,int qrel,int hi){
  const float NEG=-INFINITY; int kb=64*jb+4*hi;
  #pragma unroll
  for(int r=0;r<16;++r){int kv=kb+(r&3)+8*(r>>2); if(kv>qrel)p0[r]=NEG; if(kv+32>qrel)p1[r]=NEG;}
}

constexpr int NSLOT=3, SLOTB=8192;
constexpr int LDS_K=0, LDS_V=NSLOT*SLOTB, LDS_WS=2*NSLOT*SLOTB, LDS_OST=LDS_WS+NW*64*4, LDS_BYTES=LDS_OST+NW*4096;
constexpr float C2=0.125f*1.4426950408889634f;
__device__ __forceinline__ void glds16(const void*gsrc,unsigned lds_dst){unsigned keep;
  asm volatile("s_mov_b32 %0, m0\n\ts_mov_b32 m0, %2\n\ts_nop 0\n\tglobal_load_lds_dwordx4 %1, off\n\ts_mov_b32 m0, %0":"=&s"(keep):"v"(gsrc),"s"(lds_dst):"memory");}
__device__ __forceinline__ float max3f(float a,float b,float c){float r;asm("v_max3_f32 %0, %1, %2, %3":"=v"(r):"v"(a),"v"(b),"v"(c));return r;}
__device__ __forceinline__ float max2f(float a,float b){float r;asm("v_max_f32_e32 %0, %1, %2":"=v"(r):"v"(a),"v"(b));return r;}
__device__ __forceinline__ float fadd_s(float a,float b){float r;asm("v_add_f32_e32 %0, %1, %2":"=v"(r):"v"(a),"v"(b));return r;}
__device__ __forceinline__ float fsub_s(float a,float b){float r;asm("v_sub_f32_e32 %0, %1, %2":"=v"(r):"v"(a),"v"(b));return r;}
typedef float f32x2_t __attribute__((ext_vector_type(2))); typedef __bf16 bf16x2_t __attribute__((ext_vector_type(2)));
__device__ __forceinline__ unsigned cvtpk_s(float lo,float hi){f32x2_t v={lo,hi};bf16x2_t b=__builtin_convertvector(v,bf16x2_t);return __builtin_bit_cast(unsigned,b);}
#define WAIT_BAR(N) asm volatile("s_waitcnt vmcnt(" #N ") lgkmcnt(0)\n\ts_barrier":::"memory")

__device__ __forceinline__ void qkt(f32x16&p0,f32x16&p1,const char*Kslot,const bf16x8*qr,const f32x16&negm,int r32,int hi){
  const char*kb=Kslot+hi*1024+r32*16;
  #pragma unroll
  for(int d0=0;d0<4;++d0){
    const bf16x8 b0=*reinterpret_cast<const bf16x8*>(kb+d0*2048);
    const bf16x8 b1=*reinterpret_cast<const bf16x8*>(kb+d0*2048+512);
    if(d0==0){p0=__builtin_amdgcn_mfma_f32_32x32x16_bf16(b0,qr[0],negm,0,0,0);p1=__builtin_amdgcn_mfma_f32_32x32x16_bf16(b1,qr[0],negm,0,0,0);}
    else{p0=__builtin_amdgcn_mfma_f32_32x32x16_bf16(b0,qr[d0],p0,0,0,0);p1=__builtin_amdgcn_mfma_f32_32x32x16_bf16(b1,qr[d0],p1,0,0,0);}}
}
typedef __attribute__((address_space(3))) const char* lds_cptr;
typedef short v4i16_t __attribute__((ext_vector_type(4)));
__device__ __forceinline__ void kload8(bf16x8*kf,lds_cptr kp){
  kf[0]=*(const __attribute__((address_space(3))) bf16x8*)(kp);      kf[1]=*(const __attribute__((address_space(3))) bf16x8*)(kp+512);
  kf[2]=*(const __attribute__((address_space(3))) bf16x8*)(kp+2048); kf[3]=*(const __attribute__((address_space(3))) bf16x8*)(kp+2560);
  kf[4]=*(const __attribute__((address_space(3))) bf16x8*)(kp+4096); kf[5]=*(const __attribute__((address_space(3))) bf16x8*)(kp+4608);
  kf[6]=*(const __attribute__((address_space(3))) bf16x8*)(kp+6144); kf[7]=*(const __attribute__((address_space(3))) bf16x8*)(kp+6656);
}
__device__ __forceinline__ void kload2(bf16x8*kf,lds_cptr kp,int j){ kf[2*j]=*(const __attribute__((address_space(3))) bf16x8*)(kp+j*2048); kf[2*j+1]=*(const __attribute__((address_space(3))) bf16x8*)(kp+j*2048+512); }
__device__ __forceinline__ s16x4 vtr(lds_cptr p){ return __builtin_bit_cast(s16x4,__builtin_amdgcn_ds_read_tr16_b64_v4i16((__attribute__((address_space(3))) v4i16_t*)p)); }
__device__ __forceinline__ float rowmax(const f32x16&p0,const f32x16&p1){
  float a=max3f(p0[0],p0[1],p1[0]),b=max3f(p0[2],p0[3],p1[1]);a=max3f(a,p1[2],p1[3]);
  #pragma unroll
  for(int r=4;r<16;r+=4){a=max3f(a,p0[r],p0[r+1]);b=max3f(b,p0[r+2],p0[r+3]);a=max3f(a,p1[r],p1[r+1]);b=max3f(b,p1[r+2],p1[r+3]);}
  const float m=max2f(a,b);
  auto rr=__builtin_amdgcn_permlane32_swap(__float_as_uint(m),__float_as_uint(m),false,false);
  return max2f(__uint_as_float(rr[0]),__uint_as_float(rr[1]));
}
__device__ __forceinline__ void pv(f32x16*o,int vb,bf16x8 pa0,bf16x8 pa1,bf16x8 pa2,bf16x8 pa3){
  #pragma unroll
  for(int d0=0;d0<2;++d0){s16x4 lo[4],hi[4];
    #pragma unroll
    for(int ks=0;ks<4;++ks){
      asm volatile("ds_read_b64_tr_b16 %0,%1 offset:%c2":"=&v"(lo[ks]):"v"(vb),"i"(d0*4096+ks*1024):"memory");
      asm volatile("ds_read_b64_tr_b16 %0,%1 offset:%c2":"=&v"(hi[ks]):"v"(vb),"i"(d0*4096+ks*1024+512):"memory");}
    asm volatile("s_waitcnt lgkmcnt(0)":::"memory");SBAR();
    #define PK(k) (bf16x8){lo[k][0],lo[k][1],lo[k][2],lo[k][3],hi[k][0],hi[k][1],hi[k][2],hi[k][3]}
    o[d0]=__builtin_amdgcn_mfma_f32_32x32x16_bf16(pa0,PK(0),o[d0],0,0,0);
    o[d0]=__builtin_amdgcn_mfma_f32_32x32x16_bf16(pa1,PK(1),o[d0],0,0,0);
    o[d0]=__builtin_amdgcn_mfma_f32_32x32x16_bf16(pa2,PK(2),o[d0],0,0,0);
    o[d0]=__builtin_amdgcn_mfma_f32_32x32x16_bf16(pa3,PK(3),o[d0],0,0,0);
    #undef PK
  }
}

#ifndef ATTN_STORE16
#define ATTN_STORE16(p,v) (*(u32x4*)(p)=(v))
#endif
template<int THRL> __device__ __forceinline__ void attn_unit(int b,int qb,const bf16*Q,const bf16*__restrict__ K,const bf16*__restrict__ V,bf16*O,char*shm){
  int tid_=threadIdx.x; asm volatile("":"+v"(tid_)); const int tid=tid_,lane=tid&63,r32=lane&31,hi=lane>>5; const int wid=__builtin_amdgcn_readfirstlane(tid>>6);
  const long rowbase=(long)b*SEQ; const int q0=qb*QB;
  const bf16*Qw=Q+(rowbase+q0+wid*QBLK)*DM;
  const bf16*Kh=K+rowbase*DM,*Vh=V+rowbase*DM;
  const unsigned lds0=(unsigned)(uintptr_t)shm;
  float*wsf=(float*)(shm+LDS_WS)+wid*64;
  const bf16*ksrc=Kh+(long)lane*DM+wid*8;
  const bf16*vsrc=Vh+(long)(16*(wid&3)+(lane>>2))*DM+(wid>>2)*32+(lane&3)*8;
  const unsigned kdst=lds0+LDS_K+wid*1024, vdst=lds0+LDS_V+wid*1024;
  #define DMA_K(t,slot) glds16(ksrc+(long)(t)*KVBLK*DM,(unsigned)__builtin_amdgcn_readfirstlane(kdst+(slot)))
  #define DMA_V(t,slot) glds16(vsrc+(long)(t)*KVBLK*DM,(unsigned)__builtin_amdgcn_readfirstlane(vdst+(slot)))
  const int vb0=(int)(lds0+LDS_V)+((lane>>4)&1)*32+(lane&3)*8+(4*hi+((lane&15)>>2))*64;
  const char*Kbase=shm+LDS_K; bf16x8 kf[8];
  const lds_cptr shm3=(lds_cptr)shm; const lds_cptr kp0=shm3+LDS_K+hi*1024+r32*16; const lds_cptr vp0=shm3+LDS_V+((lane>>4)&1)*32+(lane&3)*8+(4*hi+((lane&15)>>2))*64;
  const int NT=(q0+QB)/KVBLK;
  DMA_K(0,0);DMA_V(0,0);DMA_K(1,SLOTB);
  bf16x8 qr[4];
  #pragma unroll
  for(int d0=0;d0<4;++d0)qr[d0]=*reinterpret_cast<const bf16x8*>(&Qw[(long)r32*DM+d0*16+hi*8]);
  float mhat=0.f,l_reg=0.f;f32x16 o[2];o[0]=f32x16{};o[1]=f32x16{};f32x16 negm=f32x16{};asm volatile("":"+v"(negm));
  const int qrel=wid*QBLK+r32;
  #define CMASK(P0,P1,t) do{int jb_=(t)-(NT-4); if(jb_>=0)cmask(P0,P1,jb_,qrel,hi);}while(0)
  bool resc=false;
  #define START(P0,P1) do{ const float rm=rowmax(P0,P1); resc=false; \
    { const float dl=rm; mhat=fadd_s(mhat,dl); \
      _Pragma("unroll") for(int r=0;r<16;++r){P0[r]=fsub_s(P0[r],dl);P1[r]=fsub_s(P1[r],dl);} \
      _Pragma("unroll") for(int r=0;r<16;++r)negm[r]=-mhat; asm volatile("":"+v"(negm)); } \
    _Pragma("unroll") for(int r=0;r<16;++r)P0[r]=__builtin_amdgcn_exp2f(P0[r]); }while(0)
  #define RESC() do{ if(resc){ asm volatile("s_waitcnt lgkmcnt(0)":::"memory"); \
      _Pragma("unroll") for(int d_=0;d_<2;++d_) _Pragma("unroll") for(int r=0;r<16;++r)o[d_][r]*=wsf[crow(r,hi)]; } }while(0)
  f32x16 pA0,pA1,pB0,pB1;
  int sl_prev=0,sl_cur=0,sl_next=SLOTB;
  #define ROT() do{sl_prev=sl_cur;sl_cur=sl_next;sl_next=(sl_next==(NSLOT-1)*SLOTB)?0:sl_next+SLOTB;}while(0)
  DMA_K(2,2*SLOTB);
  WAIT_BAR(3);
  qkt(pA0,pA1,Kbase,qr,negm,r32,hi);asm volatile("s_nop 15\n\ts_nop 7":"+v"(pA0),"+v"(pA1));CMASK(pA0,pA1,0);
  START(pA0,pA1);
  _Pragma("unroll") for(int r=0;r<16;++r)pA1[r]=__builtin_amdgcn_exp2f(pA1[r]);
  WAIT_BAR(0);
  DMA_K(3,0);DMA_V(1,SLOTB);
  ROT();
  kload8(kf,kp0+sl_cur);
  WAIT_BAR(2);
  s16x4 vlo[8],vhi[8]; u32x4 pw0,pw1,pw2,pw3;
  #define PKW(P,B) cvtpk_s(P[B],P[B+1])
  #define PAF(k) __builtin_bit_cast(bf16x8,pw##k)
  #define VFR(i) (bf16x8){vlo[i][0],vlo[i][1],vlo[i][2],vlo[i][3],vhi[i][0],vhi[i][1],vhi[i][2],vhi[i][3]}
  #define PIN(x) asm volatile("":"+v"(x))
  #define MX3(a,b,c) __builtin_fmaxf(__builtin_fmaxf((a),(b)),(c))
  #define GAPA(MF,A0,A1,A2,A3,W0,W1,PW) do{ MF; sacc+=A0; sacc+=A1; sacc+=A2; sacc+=A3; PIN(sacc); W0; W1; PIN(PW); SBAR(); }while(0)
  #define EX(v) __builtin_amdgcn_exp2f(v)
  #define GAPB(MF,X,B) do{ MF; X[B]=EX(X[B]); X[B+1]=EX(X[B+1]); X[B+2]=EX(X[B+2]); X[B+3]=EX(X[B+3]); PIN(X); SBAR(); }while(0)
  #define VRD(i) do{ vlo[i]=vtr(vp_+(((i)>>2)*4096+((i)&3)*1024)); vhi[i]=vtr(vp_+(((i)>>2)*4096+((i)&3)*1024+512)); }while(0)
  #define KRD(G,j) do{ if(G){ kload2(kf,kp0+sl_next,j); SBAR(); } }while(0)
  #define STEP(C0,C1,P0,P1,t,GK,GV,GL) do{ SBAR(); \
    const lds_cptr vp_=vp0+sl_prev; \
    VRD(0); SBAR(); float sacc=(P0[0]+P0[1]); \
    GAPA(C0=__builtin_amdgcn_mfma_f32_32x32x16_bf16(kf[0],qr[0],negm,0,0,0), P0[2],P0[3],P0[4],P0[5],     pw0[0]=PKW(P0,0), pw0[1]=PKW(P0,2), pw0); \
    VRD(4); SBAR(); GAPA(C1=__builtin_amdgcn_mfma_f32_32x32x16_bf16(kf[1],qr[0],negm,0,0,0), P0[6],P0[7],P0[8],P0[9],     pw0[2]=PKW(P0,4), pw0[3]=PKW(P0,6), pw0); \
    VRD(1); SBAR(); GAPA(C0=__builtin_amdgcn_mfma_f32_32x32x16_bf16(kf[2],qr[1],C0,0,0,0),   P0[10],P0[11],P0[12],P0[13], pw1[0]=PKW(P0,8), pw1[1]=PKW(P0,10), pw1); \
    VRD(5); SBAR(); GAPA(C1=__builtin_amdgcn_mfma_f32_32x32x16_bf16(kf[3],qr[1],C1,0,0,0),   P0[14],P0[15],P1[0],P1[1],   pw1[2]=PKW(P0,12),pw1[3]=PKW(P0,14), pw1); \
    VRD(2); SBAR(); GAPA(C0=__builtin_amdgcn_mfma_f32_32x32x16_bf16(kf[4],qr[2],C0,0,0,0),   P1[2],P1[3],P1[4],P1[5],     pw2[0]=PKW(P1,0), pw2[1]=PKW(P1,2), pw2); \
    VRD(6); SBAR(); GAPA(C1=__builtin_amdgcn_mfma_f32_32x32x16_bf16(kf[5],qr[2],C1,0,0,0),   P1[6],P1[7],P1[8],P1[9],     pw2[2]=PKW(P1,4), pw2[3]=PKW(P1,6), pw2); \
    VRD(3); SBAR(); GAPA(C0=__builtin_amdgcn_mfma_f32_32x32x16_bf16(kf[6],qr[3],C0,0,0,0),   P1[10],P1[11],P1[12],P1[13], pw3[0]=PKW(P1,8), pw3[1]=PKW(P1,10), pw3); \
    VRD(7); SBAR(); GAPA(C1=__builtin_amdgcn_mfma_f32_32x32x16_bf16(kf[7],qr[3],C1,0,0,0),   P1[14],P1[15],0.f,0.f,       pw3[2]=PKW(P1,12),pw3[3]=PKW(P1,14), pw3); \
    l_reg+=sacc; \
    if(GK){DMA_K((t)+3,sl_cur);} if(GV){DMA_V((t)+1,sl_next);} \
    CMASK(C0,C1,t); \
    { float a=MX3(C0[0],C0[1],C1[0]),b=MX3(C0[2],C0[3],C1[1]); a=MX3(a,C1[2],C1[3]); \
      _Pragma("unroll") for(int r=4;r<16;r+=4){a=MX3(a,C0[r],C0[r+1]);b=MX3(b,C0[r+2],C0[r+3]);a=MX3(a,C1[r],C1[r+1]);b=MX3(b,C1[r+2],C1[r+3]);} \
      float rm=__builtin_fmaxf(a,b); { auto rr=__builtin_amdgcn_permlane32_swap(__float_as_uint(rm),__float_as_uint(rm),false,false); rm=__builtin_fmaxf(__uint_as_float(rr[0]),__uint_as_float(rr[1])); } \
      resc=false; \
      if(__builtin_expect(__any(rm>(float)THRL),0)){ const float dl=__builtin_fmaxf(rm,0.f); mhat+=dl; \
        _Pragma("unroll") for(int r=0;r<16;++r){C0[r]-=dl;C1[r]-=dl;} \
        _Pragma("unroll") for(int r=0;r<16;++r)negm[r]=-mhat; asm volatile("":"+v"(negm)); \
        const float f=__builtin_amdgcn_exp2f(-dl); l_reg*=f; if(hi==0)wsf[r32]=f; resc=true; } } \
    SBAR(); \
    GAPB(o[0]=__builtin_amdgcn_mfma_f32_32x32x16_bf16(PAF(0),VFR(0),o[0],0,0,0), C0,0); \
    GAPB(o[1]=__builtin_amdgcn_mfma_f32_32x32x16_bf16(PAF(0),VFR(4),o[1],0,0,0), C0,4); \
    KRD(GL,0); GAPB(o[0]=__builtin_amdgcn_mfma_f32_32x32x16_bf16(PAF(1),VFR(1),o[0],0,0,0), C0,8); \
    KRD(GL,1); GAPB(o[1]=__builtin_amdgcn_mfma_f32_32x32x16_bf16(PAF(1),VFR(5),o[1],0,0,0), C0,12); \
    KRD(GL,2); GAPB(o[0]=__builtin_amdgcn_mfma_f32_32x32x16_bf16(PAF(2),VFR(2),o[0],0,0,0), C1,0); \
    KRD(GL,3); GAPB(o[1]=__builtin_amdgcn_mfma_f32_32x32x16_bf16(PAF(2),VFR(6),o[1],0,0,0), C1,4); \
    GAPB(o[0]=__builtin_amdgcn_mfma_f32_32x32x16_bf16(PAF(3),VFR(3),o[0],0,0,0), C1,8); \
    GAPB(o[1]=__builtin_amdgcn_mfma_f32_32x32x16_bf16(PAF(3),VFR(7),o[1],0,0,0), C1,12); \
    }while(0)
  int t=1;
  #undef CMASK
  #define CMASK(P0,P1,t) do{}while(0)
  for(;t+5<NT;t+=2){
    STEP(pB0,pB1,pA0,pA1,t,true,true,true);     WAIT_BAR(2); RESC(); ROT();
    STEP(pA0,pA1,pB0,pB1,t+1,true,true,true);   WAIT_BAR(2); RESC(); ROT();
  }
  #undef CMASK
  #define CMASK(P0,P1,t) do{int jb_=(t)-(NT-4); if(jb_>=0)cmask(P0,P1,jb_,qrel,hi);}while(0)
  #define ENDW(tt) do{ if((tt)+3<NT){WAIT_BAR(2);} else if((tt)+2<NT){WAIT_BAR(1);} else {WAIT_BAR(0);} }while(0)
  for(;t+1<NT;t+=2){
    STEP(pB0,pB1,pA0,pA1,t,(t+3<NT),(t+1<NT),(t+1<NT));       ENDW(t);   RESC(); ROT();
    STEP(pA0,pA1,pB0,pB1,t+1,(t+4<NT),(t+2<NT),(t+2<NT));     ENDW(t+1); RESC(); ROT();
  }
  STEP(pB0,pB1,pA0,pA1,NT-1,false,false,false); RESC();
  { float sacc=pB0[0]+pB0[1]; _Pragma("unroll") for(int r=2;r<16;++r)sacc+=pB0[r]; _Pragma("unroll") for(int r=0;r<16;++r)sacc+=pB1[r]; l_reg+=sacc;
    pw0=(u32x4){PKW(pB0,0),PKW(pB0,2),PKW(pB0,4),PKW(pB0,6)};pw1=(u32x4){PKW(pB0,8),PKW(pB0,10),PKW(pB0,12),PKW(pB0,14)};pw2=(u32x4){PKW(pB1,0),PKW(pB1,2),PKW(pB1,4),PKW(pB1,6)};pw3=(u32x4){PKW(pB1,8),PKW(pB1,10),PKW(pB1,12),PKW(pB1,14)};
    SBAR(); pv(o,vb0+sl_cur,PAF(0),PAF(1),PAF(2),PAF(3)); }
  #undef PKW
  #undef PAF
  #undef VFR
  #undef PIN
  #undef MX3
  #undef GAPA
  #undef GAPB
  #undef EX
  #undef VRD
  #undef KRD
  #undef STEP
  #undef ENDW
  {auto rr=__builtin_amdgcn_permlane32_swap(__float_as_uint(l_reg),__float_as_uint(l_reg),false,false);l_reg=__uint_as_float(rr[0])+__uint_as_float(rr[1]);}
  if(hi==0)wsf[32+r32]=l_reg;asm volatile("s_waitcnt lgkmcnt(0)":::"memory");
  float rli[16];
  #pragma unroll
  for(int r=0;r<16;++r)rli[r]=__builtin_amdgcn_rcpf(wsf[32+crow(r,hi)]);
  bf16*Ow=O+(rowbase+q0+wid*QBLK)*DM;
  { bf16*stg=(bf16*)(shm+LDS_OST)+wid*2048;
    #pragma unroll
    for(int r=0;r<16;++r){const int orow=crow(r,hi);
      #pragma unroll
      for(int d0=0;d0<2;++d0)stg[orow*64+d0*32+r32]=__float2bfloat16(o[d0][r]*rli[r]);}
    asm volatile("s_waitcnt lgkmcnt(0)":::"memory");
    #pragma unroll
    for(int i=0;i<4;++i){const int row=i*8+(lane>>3),ch=lane&7; const u32x4 v=*(const u32x4*)(stg+row*64+ch*8); ATTN_STORE16(Ow+(long)row*DM+ch*8,v);} }
  asm volatile("s_waitcnt lgkmcnt(0)\n\ts_barrier":::"memory");
  #undef DMA_K
  #undef DMA_V
  #undef CMASK
  #undef START
  #undef RESC
  #undef ROT
}
constexpr int ATTN_LDS_BYTES=LDS_BYTES;
#undef SBAR
#undef WAIT_BAR
}


#ifndef MOE_F8
#define MOE_F8 1
#endif
constexpr int NWAVES = 8;
constexpr int NB = 16, S = 2048, D = 1024, T = NB * S;
constexpr int NL = 4, NE = 32, TOPK = 4;
constexpr int SLOT_ROWS = T * TOPK + NE * 256;
constexpr int MODC = 6 * D * NL + 2 * D + 2 * D;
constexpr int MOD_KV = 6 * D * NL, MOD_FIN = MOD_KV + 2 * D;
constexpr float EPS = 1e-5f;
constexpr float QSCALE = 0.125f * 1.4426950408889634f;
constexpr size_t MiB = 1u << 20;
constexpr size_t WS_CTL = 0, CTL_ZERO_BYTES = 1 * MiB;
constexpr size_t WS_MOD = 4 * MiB;
constexpr size_t WS_ROPE = 6 * MiB;
constexpr size_t WS_RFRAG = 7 * MiB;
constexpr size_t WS_TKE = 8 * MiB, WS_TKW = WS_TKE + 512 * 1024, WS_TKL = WS_TKW + 512 * 1024, WS_SLOT = WS_TKL + 512 * 1024;
constexpr size_t WS_WGCNT = 10 * MiB, WS_TEXP = WS_WGCNT + 64 * 1024, WS_NT = WS_TEXP + 64 * 1024;
constexpr size_t WS_ROWTOK = 11 * MiB;
constexpr size_t WS_SSP = 12 * MiB;
constexpr size_t WS_WQKV = 16 * MiB, WS_AWO = 28 * MiB, WS_KVW = 32 * MiB, WS_BWQ = 36 * MiB, WS_BWO = 48 * MiB;
constexpr size_t WS_WGU = 64 * MiB, WS_WDN = 576 * MiB;
constexpr size_t WS_X = 832 * MiB, WS_H = 960 * MiB, WS_Q = 1024 * MiB, WS_KVSH = 1216 * MiB, WS_O = 1344 * MiB, WS_OP = 1408 * MiB, WS_LSE = 1600 * MiB, WS_HKV = 1608 * MiB;
constexpr size_t WS_HS = 1672 * MiB, WS_ACT = 1944 * MiB, WS_Y = 2216 * MiB, WS_END = 2488 * MiB;
constexpr int CW_BAR = 4096;
constexpr int RING_BYTES = 131072;
constexpr int MISC_OFF = RING_BYTES;
constexpr int HIST_OFF = MISC_OFF + 256, TEXP_OFF = MISC_OFF + 1024, ROWTAB_OFF = MISC_OFF + 5120;
constexpr int LDS_BYTES = 163840;

#define GAS __attribute__((address_space(1)))
#define LAS __attribute__((address_space(3)))
typedef unsigned short bf16;
typedef unsigned v4u __attribute__((ext_vector_type(4)));
typedef unsigned v2u __attribute__((ext_vector_type(2)));
typedef float f32x4 __attribute__((ext_vector_type(4)));
typedef float f32x16 __attribute__((ext_vector_type(16)));
typedef short bf16x8 __attribute__((ext_vector_type(8)));
typedef short s16x4 __attribute__((ext_vector_type(4)));
#define RLX_AGENT __ATOMIC_RELAXED, __HIP_MEMORY_SCOPE_AGENT
#define LDS_WAIT() asm volatile("s_waitcnt lgkmcnt(0)" ::: "memory")
#define VM_WAIT() asm volatile("s_waitcnt vmcnt(0)" ::: "memory")
__device__ __forceinline__ unsigned f2bf(float f) { unsigned u = __builtin_bit_cast(unsigned, f); return (u + 0x7fffu + ((u >> 16) & 1u)) >> 16; }
__device__ __forceinline__ float bf2f(unsigned b) { return __builtin_bit_cast(float, b << 16); }
__device__ __forceinline__ unsigned pk2(float lo, float hi) { return pg8::cvt_pk_bf16(lo, hi); }
__device__ __forceinline__ f32x4 unpack4(v2u r) { return (f32x4){bf2f(r.x & 0xffffu), bf2f(r.x >> 16), bf2f(r.y & 0xffffu), bf2f(r.y >> 16)}; }
__device__ __forceinline__ float wave_sum(float v) {
#pragma unroll
    for (int o = 1; o < 64; o <<= 1) v += __shfl_xor(v, o);
    return v;
}
__device__ __forceinline__ float dot4(f32x4 a) { return (a.x * a.x + a.y * a.y) + (a.z * a.z + a.w * a.w); }
#define XB_TMO      128
#define XB_XCNT(j)  (256  + 64 * (j))
#define XB_XSUB(j)  (1280 + 64 * (j))
#define XB_XGEN(j)  (2304 + 64 * (j))
#define XB_TOP      3328
#define XB_TOPGEN   3392
#define XCD_BAR_WORDS 3456
#define XB_SPIN_CAP (1u << 22)

__device__ __forceinline__ unsigned xb_ld(unsigned* p)              { return __hip_atomic_load(p, __ATOMIC_RELAXED, __HIP_MEMORY_SCOPE_AGENT); }
__device__ __forceinline__ unsigned xb_add(unsigned* p, unsigned v) { return __hip_atomic_fetch_add(p, v, __ATOMIC_RELAXED, __HIP_MEMORY_SCOPE_AGENT); }
__device__ __forceinline__ unsigned xb_xcc_id() { return (unsigned)__builtin_amdgcn_s_getreg((3 << 11) | 20) & 0xFu; }
#define XB_SPIN(cond, bar) do { unsigned _sp = 0; while (cond) { __builtin_amdgcn_s_sleep(1); \
    if ((++_sp & 255u) == 0u) { if (xb_ld(&(bar)[XB_TMO])) break; if (_sp > XB_SPIN_CAP) { atomicAdd(&(bar)[XB_TMO], 1u); break; } } } } while (0)

struct XcdBarrier {
    unsigned* bar; unsigned x;
    volatile LAS unsigned* st;
};

__device__ __forceinline__ XcdBarrier xcd_barrier_post(unsigned* bar, volatile LAS unsigned* st) {
    XcdBarrier b; b.bar = bar; b.x = xb_xcc_id(); b.st = st;
    if (threadIdx.x == 0) (void)xb_add(&bar[XB_XCNT(b.x)], 1u);
    return b;
}
__device__ __forceinline__ void xcd_barrier_complete(unsigned* bar, unsigned x, unsigned& nloc, unsigned& nx) {
    const unsigned G = gridDim.x * gridDim.y * gridDim.z;
    unsigned sum, cnt, mine, sp = 0u;
    for (;;) {
        sum = 0u; cnt = 0u; mine = 0u;
#pragma unroll
        for (unsigned j = 0; j < 16; ++j) { const unsigned c = xb_ld(&bar[XB_XCNT(j)]); sum += c; cnt += (c > 0u) ? 1u : 0u; mine = (j == x) ? c : mine; }
        if (sum == G) break;
        __builtin_amdgcn_s_sleep(1);
        if ((++sp & 255u) == 0u) { if (xb_ld(&bar[XB_TMO])) break; if (sp > XB_SPIN_CAP) { atomicAdd(&bar[XB_TMO], 1u); break; } }
    }
    nloc = mine > 0u ? mine : 1u; nx = cnt > 0u ? cnt : 1u;
}

__device__ __forceinline__ void xcd_barrier(const XcdBarrier& b) {
    asm volatile("s_waitcnt vmcnt(0)" ::: "memory");
    __syncthreads();
    if (threadIdx.x == 0) {
        unsigned* bar = b.bar;
        __builtin_amdgcn_s_waitcnt(0);
        unsigned nloc = b.st[0], nx = b.st[1];
        if (nloc == 0u) { xcd_barrier_complete(bar, b.x, nloc, nx); b.st[0] = nloc; b.st[1] = nx; }
        const unsigned old = xb_add(&bar[XB_XSUB(b.x)], 1u);
        const unsigned gen = old / nloc;
        if (old + 1u == (gen + 1u) * nloc) {
            __builtin_amdgcn_fence(__ATOMIC_RELEASE, "agent");
            asm volatile("s_waitcnt vmcnt(0)" ::: "memory");
            const unsigned og = xb_add(&bar[XB_TOP], 1u);
            const unsigned tg = og / nx;
            if (og + 1u == (tg + 1u) * nx) xb_add(&bar[XB_TOPGEN], 1u);
            else XB_SPIN(xb_ld(&bar[XB_TOPGEN]) == tg, bar);
            __builtin_amdgcn_fence(__ATOMIC_ACQUIRE, "agent");
            xb_add(&bar[XB_XGEN(b.x)], 1u);
            asm volatile("s_waitcnt vmcnt(0)" ::: "memory");
        } else {
            XB_SPIN(xb_ld(&bar[XB_XGEN(b.x)]) == gen, bar);
            __builtin_amdgcn_fence(__ATOMIC_ACQUIRE, "agent");
            asm volatile("s_waitcnt vmcnt(0)" ::: "memory");
        }
    }
    __syncthreads();
}

struct Args { const float* in[25]; float* out; unsigned char* ws; float invf[8]; float lam_init[2]; int ph_lo, ph_hi, use_bar, pad; };
enum { I_X = 0, I_C, I_MODW, I_MODB, I_MIXN, I_FFNN, I_AWQKV, I_AWO, I_ALAM, I_ASUBLN, I_KVN, I_KVMODW, I_KVMODB, I_KVW, I_BWQ, I_BWO, I_RW, I_RB, I_WGU, I_BGU, I_WDN, I_BDN, I_FINN, I_FINMODW, I_FINMODB };
struct Frame { LAS unsigned char* lds; int tid, lane, wave, G, gw, NGW, bid; };
typedef const __attribute__((address_space(4))) Args* ArgsP;

__device__ __forceinline__ void p0_transpose_item(const float* W, int N, int K, bf16* WT, int dst_row0, LAS float* scr, int k0, int n0, int lane) {
    float v_[32];
#pragma unroll
    for (int i = 0; i < 32; ++i) v_[i] = W[(size_t)(k0 + 2 * i + (lane >> 5)) * N + n0 + (lane & 31)];
#pragma unroll
    for (int i = 0; i < 32; ++i) scr[(2 * i + (lane >> 5)) * 33 + (lane & 31)] = v_[i];
    LDS_WAIT(); asm volatile("" ::: "memory");
    const int c = lane & 7;
#pragma unroll
    for (int j = 0; j < 4; ++j) { const int n = (lane >> 3) + 8 * j; const LAS float* s = scr + (8 * c) * 33 + n;
        v4u o; o.x = pk2(s[0 * 33], s[1 * 33]); o.y = pk2(s[2 * 33], s[3 * 33]); o.z = pk2(s[4 * 33], s[5 * 33]); o.w = pk2(s[6 * 33], s[7 * 33]);
        *(GAS v4u*)(WT + (size_t)(dst_row0 + n) * K + k0 + 8 * c) = o; }
    LDS_WAIT(); asm volatile("" ::: "memory");
}
__device__ __forceinline__ void p0_transpose_item_f8(const float* W, int N, int K, unsigned char* WT, int dst_row0, LAS float* scr, int k0, int n0, int lane) {
    float v_[32];
#pragma unroll
    for (int i = 0; i < 32; ++i) v_[i] = W[(size_t)(k0 + 2 * i + (lane >> 5)) * N + n0 + (lane & 31)];
#pragma unroll
    for (int i = 0; i < 32; ++i) scr[(2 * i + (lane >> 5)) * 33 + (lane & 31)] = v_[i];
    LDS_WAIT(); asm volatile("" ::: "memory");
    const int c = lane & 3;
#pragma unroll
    for (int j = 0; j < 2; ++j) { const int n = (lane >> 2) + 16 * j; const LAS float* s = scr + (16 * c) * 33 + n; v4u o;
        o.x = pg8::pk4_fp8(s[0 * 33] * 256.f, s[1 * 33] * 256.f, s[2 * 33] * 256.f, s[3 * 33] * 256.f); o.y = pg8::pk4_fp8(s[4 * 33] * 256.f, s[5 * 33] * 256.f, s[6 * 33] * 256.f, s[7 * 33] * 256.f);
        o.z = pg8::pk4_fp8(s[8 * 33] * 256.f, s[9 * 33] * 256.f, s[10 * 33] * 256.f, s[11 * 33] * 256.f); o.w = pg8::pk4_fp8(s[12 * 33] * 256.f, s[13 * 33] * 256.f, s[14 * 33] * 256.f, s[15 * 33] * 256.f);
        *(GAS v4u*)(WT + (size_t)(dst_row0 + n) * K + k0 + 16 * c) = o; }
    LDS_WAIT(); asm volatile("" ::: "memory");
}
__device__ __forceinline__ void p0_prologue(const Frame& F, ArgsP ap) {
    unsigned char* ws = ap->ws;
    {
        LAS float* cT = (LAS float*)F.lds;
        LAS float* red = (LAS float*)(F.lds + 65536);
        const float* c = ap->in[I_C];
        for (int idx = F.tid; idx < NB * D; idx += NWAVES * 64) { const int b = idx >> 10, k = idx & 1023; const float v = c[idx]; cT[k * 16 + b] = v / (1.0f + __expf(-v)); }
        __syncthreads();
        float* modall = (float*)(ws + WS_MOD);
        for (int g = F.bid; g < MODC / 64; g += F.G) {
            const int cg0 = g * 64; const float* W; const float* bias; int N, col0;
            if (cg0 < MOD_KV) { const int l = cg0 / (6 * D); col0 = cg0 % (6 * D); W = ap->in[I_MODW] + (size_t)l * D * 6 * D; N = 6 * D; bias = ap->in[I_MODB] + l * 6 * D + col0; }
            else if (cg0 < MOD_FIN) { col0 = cg0 - MOD_KV; W = ap->in[I_KVMODW]; N = 2 * D; bias = ap->in[I_KVMODB] + col0; }
            else { col0 = cg0 - MOD_FIN; W = ap->in[I_FINMODW]; N = 2 * D; bias = ap->in[I_FINMODB] + col0; }
            float acc[16];
#pragma unroll
            for (int b = 0; b < 16; ++b) acc[b] = 0.f;
            const float* wp = W + (size_t)(F.wave * 128) * N + col0 + F.lane;
#pragma unroll 8
            for (int kk = 0; kk < 128; ++kk) { const float w = wp[(size_t)kk * N]; const LAS f32x4* cv = (const LAS f32x4*)(cT + (F.wave * 128 + kk) * 16);
                const f32x4 c0 = cv[0], c1 = cv[1], c2 = cv[2], c3 = cv[3];
                acc[0] += w * c0.x; acc[1] += w * c0.y; acc[2] += w * c0.z; acc[3] += w * c0.w; acc[4] += w * c1.x; acc[5] += w * c1.y; acc[6] += w * c1.z; acc[7] += w * c1.w;
                acc[8] += w * c2.x; acc[9] += w * c2.y; acc[10] += w * c2.z; acc[11] += w * c2.w; acc[12] += w * c3.x; acc[13] += w * c3.y; acc[14] += w * c3.z; acc[15] += w * c3.w; }
#pragma unroll
            for (int b = 0; b < 16; ++b) red[(F.wave * 16 + b) * 64 + F.lane] = acc[b];
            __syncthreads();
            for (int o = F.tid; o < 1024; o += NWAVES * 64) { const int b = o >> 6, ln = o & 63; float s = bias[ln];
#pragma unroll
                for (int w = 0; w < 8; ++w) s += red[(w * 16 + b) * 64 + ln];
                modall[(size_t)b * MODC + cg0 + ln] = s; }
            __syncthreads();
        }
        __syncthreads();
    }
    {
        const int gt = F.bid * (NWAVES * 64) + F.tid, NT_ = F.G * NWAVES * 64;
        float* cosT = (float*)(ws + WS_ROPE); float* sinT = cosT + S * 8;
        for (int idx = gt; idx < S * 8; idx += NT_) { const int pos = idx >> 3, i = idx & 7; float inv = ap->invf[0];
#pragma unroll
            for (int q = 1; q < 8; ++q) inv = (i == q) ? ap->invf[q] : inv;
            const float angf = (float)pos * inv; const double x = (double)angf; const double n = __builtin_rint(x * 0.15915494309189533577); const double r = x - n * 6.283185307179586476925; const double r2 = r * r;
            double sn = 1.0, cs = 1.0;
#pragma unroll
            for (int q = 14; q >= 1; --q) { sn = 1.0 - sn * r2 / (double)((2 * q) * (2 * q + 1)); cs = 1.0 - cs * r2 / (double)((2 * q - 1) * (2 * q)); }
            sn *= r; cosT[idx] = (float)cs; sinT[idx] = (float)sn; }
        bf16* rfrag = (bf16*)(ws + WS_RFRAG); const float* rw = ap->in[I_RW];
        for (int idx = gt; idx < NL * 32 * 2 * 64 * 8; idx += NT_) { const int j = idx & 7, lane = (idx >> 3) & 63, nb = (idx >> 9) & 1, s = (idx >> 10) & 31, l = idx >> 15;
            const float w = rw[((size_t)l * D + 32 * s + 8 * (lane >> 4) + j) * NE + 16 * nb + (lane & 15)]; const unsigned hi = f2bf(w), lo = f2bf(w - bf2f(hi));
            const size_t base = ((((size_t)l * 32 + s) * 2 + nb) * 2) * 512 + lane * 8 + j; rfrag[base] = (bf16)hi; rfrag[base + 512] = (bf16)lo; }
    }
    {
        LAS float* scr = (LAS float*)(F.lds + F.wave * 16384);
        constexpr int I_QKV = 16 * 96, I_SQ = 16 * 32, I_KV = 16 * 64;
        constexpr int E0 = 2 * I_QKV, E1 = E0 + 2 * I_SQ, E2 = E1 + I_KV, E3 = E2 + 2 * I_QKV, E4 = E3 + 2 * I_SQ;
        for (int it = F.gw; it < E4; it += F.NGW) {
            const float* W; bf16* WT; int N, r, per;
            if (it < E0) { r = it; per = I_QKV; N = 3 * D; W = ap->in[I_AWQKV]; WT = (bf16*)(ws + WS_WQKV); }
            else if (it < E1) { r = it - E0; per = I_SQ; N = D; W = ap->in[I_AWO]; WT = (bf16*)(ws + WS_AWO); }
            else if (it < E2) { r = it - E1; per = I_KV; N = 2 * D; W = ap->in[I_KVW]; WT = (bf16*)(ws + WS_KVW); }
            else if (it < E3) { r = it - E2; per = I_QKV; N = 3 * D; W = ap->in[I_BWQ]; WT = (bf16*)(ws + WS_BWQ); }
            else { r = it - E3; per = I_SQ; N = D; W = ap->in[I_BWO]; WT = (bf16*)(ws + WS_BWO); }
            const int mat = r / per, item = r % per, nblk = N / 32, kb = item / nblk, nb = item % nblk, n0 = 32 * nb;
            p0_transpose_item(W + (size_t)mat * D * N, N, D, WT + (size_t)mat * N * D, n0, scr, 64 * kb, n0, F.lane);
        }
    }
}
__device__ __forceinline__ void convert_experts(const Frame& F, ArgsP ap, int l0, LAS float* scr) {
    unsigned char* ws = ap->ws;
    constexpr int I_GU = 16 * 64, I_DN = 16 * 32, PER_L = NE * (I_GU + I_DN);
    constexpr size_t ESZ = MOE_F8 ? 1 : 2;
    for (int it = F.gw; it < 2 * PER_L; it += F.NGW) {
        const int l = l0 + it / PER_L; int r = it % PER_L; const bool gu = r < NE * I_GU; if (!gu) r -= NE * I_GU;
        const int per = gu ? I_GU : I_DN, N = gu ? 2 * D : D, e = r / per, item = r % per, nblk = N / 32, kb = item / nblk, nb = item % nblk, n0 = 32 * nb;
        int drow = n0; if (gu) { const int half = n0 >> 10, rem = n0 & 1023; drow = (rem >> 7) * 256 + half * 128 + (rem & 127); }
        const float* W = (gu ? ap->in[I_WGU] : ap->in[I_WDN]) + ((size_t)l * NE + e) * D * N;
        unsigned char* WT = ws + (gu ? WS_WGU : WS_WDN) + ((size_t)l * NE + e) * N * D * ESZ;
        if (MOE_F8) p0_transpose_item_f8(W, N, D, WT, drow, scr, 64 * kb, n0, F.lane); else p0_transpose_item(W, N, D, (bf16*)WT, drow, scr, 64 * kb, n0, F.lane);
    }
}

struct ModVec { f32x4 a[4], b[4]; };
__device__ __forceinline__ void load_modvec(ModVec& mv, const float* gain, const float* scale, const float* shift, int lane) {
#pragma unroll
    for (int j = 0; j < 4; ++j) { const int c = 4 * lane + 256 * j; const f32x4 g = *(const f32x4*)(gain + c), sc = *(const f32x4*)(scale + c); mv.a[j] = g * (sc + 1.0f); mv.b[j] = *(const f32x4*)(shift + c); }
}
__device__ __forceinline__ void store_bf16_row(bf16* orow, const f32x4 (&v)[4], int lane) {
#pragma unroll
    for (int j = 0; j < 4; ++j) { v2u w; w.x = pk2(v[j].x, v[j].y); w.y = pk2(v[j].z, v[j].w); *(v2u*)(orow + 4 * lane + 256 * j) = w; }
}
__device__ __forceinline__ void phase_modulate0(const Frame& F, const float* x, const float* gain, const float* modall, int sh_col, int sc_col, bf16* h) {
    for (int task = F.gw; task < T / 16; task += F.NGW) {
        const int r0 = task * 16, b = r0 >> 11; ModVec mv; load_modvec(mv, gain, modall + (size_t)b * MODC + sc_col, modall + (size_t)b * MODC + sh_col, F.lane);
        f32x4 nx[4];
#pragma unroll
        for (int j = 0; j < 4; ++j) nx[j] = *(const f32x4*)(x + (size_t)r0 * D + 4 * F.lane + 256 * j);
        for (int i = 0; i < 16; ++i) { f32x4 v[4]; float ss = 0.f;
#pragma unroll
            for (int j = 0; j < 4; ++j) { v[j] = nx[j]; ss += dot4(v[j]); }
            if (i + 1 < 16) {
#pragma unroll
                for (int j = 0; j < 4; ++j) nx[j] = *(const f32x4*)(x + (size_t)(r0 + i + 1) * D + 4 * F.lane + 256 * j); }
            const float rstd = 1.0f / sqrtf(wave_sum(ss) * (1.0f / D) + EPS);
#pragma unroll
            for (int j = 0; j < 4; ++j) v[j] = v[j] * rstd * mv.a[j] + mv.b[j];
            store_bf16_row(h + (size_t)(r0 + i) * D, v, F.lane); }
    }
}
__device__ __forceinline__ void phase_subln(const Frame& F, const bf16* OP, const float* lamv  , const float* subln  , float lam_init, bf16* O) {
    float lam; { const float p1 = wave_sum(lamv[F.lane] * lamv[64 + F.lane]), p2 = wave_sum(lamv[128 + F.lane] * lamv[192 + F.lane]); lam = __expf(p1) - __expf(p2) + lam_init; }
    const f32x4 gsub = *(const f32x4*)(subln + ((4 * F.lane) & 127)) * (1.0f - lam_init);
    for (int task = F.gw; task < T / 16; task += F.NGW) {
        v2u n0[4], n1[4];
#pragma unroll
        for (int j = 0; j < 4; ++j) { const size_t o_ = (size_t)(task * 16) * D + 4 * F.lane + 256 * j; n0[j] = *(const v2u*)(OP + o_); n1[j] = *(const v2u*)(OP + (size_t)T * D + o_); }
        for (int i = 0; i < 16; ++i) { const size_t ro = (size_t)(task * 16 + i) * D; f32x4 v[4]; v2u c0[4], c1[4];
#pragma unroll
            for (int j = 0; j < 4; ++j) { c0[j] = n0[j]; c1[j] = n1[j]; }
            if (i + 1 < 16) {
#pragma unroll
                for (int j = 0; j < 4; ++j) { const size_t o_ = ro + D + 4 * F.lane + 256 * j; n0[j] = *(const v2u*)(OP + o_); n1[j] = *(const v2u*)(OP + (size_t)T * D + o_); } }
#pragma unroll
            for (int j = 0; j < 4; ++j) { v[j] = unpack4(c0[j]) - unpack4(c1[j]) * lam; float ss = dot4(v[j]);
#pragma unroll
                for (int o = 1; o < 32; o <<= 1) ss += __shfl_xor(ss, o);
                v[j] = v[j] * (1.0f / sqrtf(ss * (1.0f / 128.0f) + EPS)) * gsub; }
            store_bf16_row(O + ro, v, F.lane); }
    }
}
__device__ __forceinline__ void phase_merge(const Frame& F, const bf16* OG, const float* LSE, bf16* O) {
    for (int task = F.gw; task < T / 16; task += F.NGW) {
        v2u n0[4], n1[4], n2[4]; float nl0[4], nl1[4], nl2[4];
#define MRG_LOAD(row_) do { _Pragma("unroll") for (int j = 0; j < 4; ++j) { const int c = 4 * F.lane + 256 * j, head = c >> 6; const size_t o_ = (size_t)(row_) * D + c, l_ = (size_t)(row_) * 16 + head; \
            n0[j] = *(const v2u*)(OG + o_); n1[j] = *(const v2u*)(OG + (size_t)T * D + o_); n2[j] = *(const v2u*)(OG + (size_t)2 * T * D + o_); nl0[j] = LSE[l_]; nl1[j] = LSE[(size_t)T * 16 + l_]; nl2[j] = LSE[(size_t)2 * T * 16 + l_]; } } while (0)
        MRG_LOAD(task * 16);
        for (int i = 0; i < 16; ++i) { const int row = task * 16 + i; f32x4 v[4]; v2u c0[4], c1[4], c2[4]; float l0[4], l1[4], l2[4];
#pragma unroll
            for (int j = 0; j < 4; ++j) { c0[j] = n0[j]; c1[j] = n1[j]; c2[j] = n2[j]; l0[j] = nl0[j]; l1[j] = nl1[j]; l2[j] = nl2[j]; }
            if (i + 1 < 16) MRG_LOAD(row + 1);
#pragma unroll
            for (int j = 0; j < 4; ++j) {
                const float mx = fmaxf(l0[j], fmaxf(l1[j], l2[j])); const float a0 = __builtin_amdgcn_exp2f(l0[j] - mx), a1 = __builtin_amdgcn_exp2f(l1[j] - mx), a2 = __builtin_amdgcn_exp2f(l2[j] - mx); const float inv = 1.0f / (a0 + a1 + a2);
                v[j] = (unpack4(c0[j]) * a0 + unpack4(c1[j]) * a1 + unpack4(c2[j]) * a2) * inv; }
            store_bf16_row(O + (size_t)row * D, v, F.lane); }
#undef MRG_LOAD
    }
}
__device__ __forceinline__ void phase_mod2_router(const Frame& F, const float* x, const float* ssp, const float* gain, const float* modall, int sh_col, int sc_col, const bf16* rfrag, const float* rb,
                                                  bf16* h2, int* tk_e, float* tk_w, int* tk_l, int* wgcnt) {
    LAS int* hist = (LAS int*)(F.lds + HIST_OFF);
    if (F.tid < NE) hist[F.tid] = 0;
    __syncthreads();
    const int r = F.lane & 15, kq = F.lane >> 4;
    for (int task = F.gw; task < T / 16; task += F.NGW) {
        const int r0 = task * 16, b = r0 >> 11; const float* xr = x + (size_t)(r0 + r) * D + 8 * kq;
        float ss; { const f32x4 p4 = *(const f32x4*)(ssp + (size_t)(r0 + r) * 16 + 4 * kq); ss = (p4[0] + p4[1]) + (p4[2] + p4[3]); }
        ss += __shfl_xor(ss, 16); ss += __shfl_xor(ss, 32);
        const float rstd = 1.0f / sqrtf(ss * (1.0f / D) + EPS);
        const float* gp = gain + 8 * kq; const float* scp = modall + (size_t)b * MODC + sc_col + 8 * kq; const float* shp = modall + (size_t)b * MODC + sh_col + 8 * kq;
        bf16* hr = h2 + (size_t)(r0 + r) * D + 8 * kq;
        f32x4 acc0 = (f32x4){0.f, 0.f, 0.f, 0.f}, acc1 = acc0;
#pragma unroll 8
        for (int s = 0; s < 32; ++s) {
            const f32x4 xa = *(const f32x4*)(xr + 32 * s), xb = *(const f32x4*)(xr + 32 * s + 4);
            const f32x4 ga = *(const f32x4*)(gp + 32 * s), gb = *(const f32x4*)(gp + 32 * s + 4), sa = *(const f32x4*)(scp + 32 * s), sb = *(const f32x4*)(scp + 32 * s + 4), ha = *(const f32x4*)(shp + 32 * s), hb = *(const f32x4*)(shp + 32 * s + 4);
            const f32x4 va = xa * rstd * ga * (sa + 1.0f) + ha, vb = xb * rstd * gb * (sb + 1.0f) + hb;
            bf16x8 Ahi, Alo;
#pragma unroll
            for (int j = 0; j < 4; ++j) { const unsigned h0 = f2bf(va[j]), h1 = f2bf(vb[j]); Ahi[j] = (short)h0; Ahi[4 + j] = (short)h1; Alo[j] = (short)f2bf(va[j] - bf2f(h0)); Alo[4 + j] = (short)f2bf(vb[j] - bf2f(h1)); }
            if (MOE_F8) { v2u w8; w8.x = pg8::pk4_fp8(va[0], va[1], va[2], va[3]); w8.y = pg8::pk4_fp8(vb[0], vb[1], vb[2], vb[3]); *(v2u*)((unsigned char*)h2 + (size_t)(r0 + r) * D + 8 * kq + 32 * s) = w8; }
            else *(bf16x8*)(hr + 32 * s) = Ahi;
            const bf16* fp = rfrag + (size_t)s * 2048 + F.lane * 8;
            const bf16x8 Bh0 = *(const bf16x8*)(fp), Bl0 = *(const bf16x8*)(fp + 512), Bh1 = *(const bf16x8*)(fp + 1024), Bl1 = *(const bf16x8*)(fp + 1536);
            acc0 = __builtin_amdgcn_mfma_f32_16x16x32_bf16(Ahi, Bh0, acc0, 0, 0, 0); acc0 = __builtin_amdgcn_mfma_f32_16x16x32_bf16(Alo, Bh0, acc0, 0, 0, 0); acc0 = __builtin_amdgcn_mfma_f32_16x16x32_bf16(Ahi, Bl0, acc0, 0, 0, 0);
            acc1 = __builtin_amdgcn_mfma_f32_16x16x32_bf16(Ahi, Bh1, acc1, 0, 0, 0); acc1 = __builtin_amdgcn_mfma_f32_16x16x32_bf16(Alo, Bh1, acc1, 0, 0, 0); acc1 = __builtin_amdgcn_mfma_f32_16x16x32_bf16(Ahi, Bl1, acc1, 0, 0, 0);
        }
        const float b0 = rb[r], b1 = rb[16 + r];
#pragma unroll
        for (int reg = 0; reg < 4; ++reg) {
            float v0 = acc0[reg] + b0, v1 = acc1[reg] + b1; float tv[4]; int te[4];
#pragma unroll
            for (int k = 0; k < 4; ++k) {
                float bv = (v0 >= v1) ? v0 : v1; int be = (v0 >= v1) ? r : 16 + r;
#pragma unroll
                for (int o = 1; o < 16; o <<= 1) { const float ov = __shfl_xor(bv, o); const int oe = __shfl_xor(be, o); if (ov > bv || (ov == bv && oe < be)) { bv = ov; be = oe; } }
                tv[k] = bv; te[k] = be; if (be == r) v0 = -INFINITY; if (be == 16 + r) v1 = -INFINITY;
            }
            const float p1 = __expf(tv[1] - tv[0]), p2 = __expf(tv[2] - tv[0]), p3 = __expf(tv[3] - tv[0]); const float inv = 1.0f / (1.0f + p1 + p2 + p3);
            if (r == 0) { const int row = r0 + 4 * kq + reg; const float pw[4] = {inv, p1 * inv, p2 * inv, p3 * inv};
#pragma unroll
                for (int k = 0; k < 4; ++k) { tk_e[row * 4 + k] = te[k]; tk_w[row * 4 + k] = pw[k]; tk_l[row * 4 + k] = __hip_atomic_fetch_add(hist + te[k], 1, __ATOMIC_RELAXED, __HIP_MEMORY_SCOPE_WORKGROUP); } }
        }
    }
    __syncthreads();
    if (F.tid < NE) wgcnt[F.bid * NE + F.tid] = hist[F.tid];
}
__device__ __forceinline__ void phase_scatter(const Frame& F, const int* wgcnt, const int* tk_e, const int* tk_l, int* slot_of, int* rowtok, int* texp, unsigned* ntiles) {
    LAS int* cnt = (LAS int*)F.lds; LAS int* tot = (LAS int*)(F.lds + 65536); LAS int* bas = tot + 32; LAS int* eoff = tot + 64;
    for (int i = F.tid; i < F.G * NE; i += NWAVES * 64) cnt[i] = wgcnt[i];
    __syncthreads();
    if (F.tid < NE) { int t = 0, bs = 0; for (int w = 0; w < F.G; ++w) { const int c = cnt[w * NE + F.tid]; bs += (w < F.bid) ? c : 0; t += c; } tot[F.tid] = t; bas[F.tid] = bs; }
    __syncthreads();
    if (F.tid == 0) { int off = 0; for (int e = 0; e < NE; ++e) { eoff[e] = off; off += (tot[e] + 255) & ~255; } eoff[NE] = off; }
    __syncthreads();
    if (F.bid == 0) { if (F.tid < NE) { for (int pm = eoff[F.tid] >> 8; pm < (eoff[F.tid + 1] >> 8); ++pm) texp[pm] = F.tid; } if (F.tid == 0) __hip_atomic_store(ntiles, (unsigned)(eoff[NE] >> 8), RLX_AGENT);
        for (int e = 0; e < NE; ++e) for (int sl = eoff[e] + tot[e] + F.tid; sl < eoff[e + 1]; sl += NWAVES * 64) rowtok[sl] = 0; }
    for (int task = F.gw; task < T / 16; task += F.NGW) {
        const int r0 = task * 16, row = r0 + (F.lane >> 2); const int idx = row * 4 + (F.lane & 3);
        const int e = tk_e[idx], slot = eoff[e] + bas[e] + tk_l[idx]; slot_of[idx] = slot; rowtok[slot] = row;
    }
}
__device__ __forceinline__ void phase_combine(const Frame& F, float* x, const bf16* Y, const int* slot_of, const float* tk_w, const float* g2base  , int mode,
                                              const float* gainA, const float* modall, int shA, int scA, bf16* h, const float* gainB, int shB, int scB, bf16* hkv, float* out) {
    for (int task = F.gw; task < T / 16; task += F.NGW) {
        const int r0 = task * 16, b = r0 >> 11; ModVec mv, mk; f32x4 g2[4];
        load_modvec(mv, gainA, modall + (size_t)b * MODC + scA, modall + (size_t)b * MODC + shA, F.lane);
        if (mode == 1) load_modvec(mk, gainB, modall + (size_t)b * MODC + scB, modall + (size_t)b * MODC + shB, F.lane);
#pragma unroll
        for (int j = 0; j < 4; ++j) g2[j] = *(const f32x4*)(g2base + (size_t)b * MODC + 4 * F.lane + 256 * j);
        const int myslot = slot_of[r0 * 4 + F.lane]; const float myw = tk_w[r0 * 4 + F.lane];
        v2u ny[4][4]; f32x4 nx[4];
#define CMB_LOAD(i_) do { _Pragma("unroll") for (int k = 0; k < 4; ++k) { const bf16* yr = Y + (size_t)__shfl(myslot, (i_) * 4 + k) * D; _Pragma("unroll") for (int j = 0; j < 4; ++j) ny[k][j] = *(const v2u*)(yr + 4 * F.lane + 256 * j); } \
            _Pragma("unroll") for (int j = 0; j < 4; ++j) nx[j] = *(const f32x4*)(x + (size_t)(r0 + (i_)) * D + 4 * F.lane + 256 * j); } while (0)
        CMB_LOAD(0);
        for (int i = 0; i < 16; ++i) { const size_t ro = (size_t)(r0 + i) * D; f32x4 acc[4]; v2u cy[4][4]; f32x4 cx[4];
#pragma unroll
            for (int j = 0; j < 4; ++j) { acc[j] = (f32x4){0.f, 0.f, 0.f, 0.f}; cx[j] = nx[j];
#pragma unroll
                for (int k = 0; k < 4; ++k) cy[k][j] = ny[k][j]; }
            if (i + 1 < 16) CMB_LOAD(i + 1);
#pragma unroll
            for (int k = 0; k < 4; ++k) { const float w = __shfl(myw, i * 4 + k);
#pragma unroll
                for (int j = 0; j < 4; ++j) acc[j] += unpack4(cy[k][j]) * w; }
            f32x4 v[4]; float ss = 0.f;
#pragma unroll
            for (int j = 0; j < 4; ++j) { v[j] = cx[j] + g2[j] * acc[j]; ss += dot4(v[j]); }
            if (mode != 2) {
#pragma unroll
                for (int j = 0; j < 4; ++j) *(f32x4*)(x + ro + 4 * F.lane + 256 * j) = v[j]; }
            const float rstd = 1.0f / sqrtf(wave_sum(ss) * (1.0f / D) + EPS);
            if (mode == 2) {
#pragma unroll
                for (int j = 0; j < 4; ++j) *(f32x4*)(out + ro + 4 * F.lane + 256 * j) = v[j] * rstd * mv.a[j] + mv.b[j];
            } else {
                f32x4 o[4];
#pragma unroll
                for (int j = 0; j < 4; ++j) o[j] = v[j] * rstd * mv.a[j] + mv.b[j];
                store_bf16_row(h + ro, o, F.lane);
                if (mode == 1) {
#pragma unroll
                    for (int j = 0; j < 4; ++j) o[j] = v[j] * rstd * mk.a[j] + mk.b[j];
                    store_bf16_row(hkv + ro, o, F.lane); }
            }
        }
#undef CMB_LOAD
    }
}

__device__ __forceinline__ int crow16(int i, int h) { return (i & 3) + 8 * (i >> 2) + 4 * h; }
constexpr int DIL_KIMG = 0, DIL_VIMG = 384 * 128, DIL_NKEY = 384;
struct DilUnit { int p, g, res_u, V0, dsh; };
__device__ __forceinline__ bool dil_unit(int n, int vcu, int G, DilUnit& U) {
    const int pi = n / 24, u = n - pi * 24; U.p = vcu + pi * G; if (U.p >= NB * 16) return false;
    const int g = u >> 3, uu = u & 7; U.g = g; U.dsh = 2 * g;
    if (g == 0) { U.res_u = 0; U.V0 = uu * 256; } else if (g == 1) { U.res_u = uu >> 1; U.V0 = (uu & 1) * 256; } else { U.res_u = 2 * uu; U.V0 = 0; }
    return true;
}
__device__ __forceinline__ void dil_glds(const void* gsrc, unsigned lds_dst) { unsigned keep;
    asm volatile("s_mov_b32 %0, m0\n\ts_mov_b32 m0, %2\n\ts_nop 0\n\tglobal_load_lds_dwordx4 %1, off\n\ts_mov_b32 m0, %0" : "=&s"(keep) : "v"(gsrc), "s"(lds_dst) : "memory"); }
__device__ __forceinline__ int dil_keyrow(const DilUnit& U, int slot) { int rs, vk; if (U.g == 2) { rs = U.res_u + ((slot >> 7) & 1); vk = slot & 127; } else { rs = U.res_u; vk = U.V0 - 128 + slot; vk = vk < 0 ? 0 : vk; } return rs + (vk << U.dsh); }
__device__ __forceinline__ void dil_stage_k(const DilUnit& U, const bf16* KV, unsigned ldsb, int wave, int lane) {
    const bf16* Kg = KV + (size_t)U.p * S * 64;
#pragma unroll
    for (int it = 0; it < 6; ++it) { const int wi = it * 8 + wave, slot = wi * 8 + (lane >> 3), ch = (lane & 7) ^ ((slot >> 1) & 7);
        dil_glds(Kg + (size_t)dil_keyrow(U, slot) * 64 + ch * 8, (unsigned)__builtin_amdgcn_readfirstlane((int)(ldsb + DIL_KIMG + wi * 1024))); }
}
__device__ __forceinline__ void dil_stage_v(const DilUnit& U, const bf16* KV, unsigned ldsb, int wave, int lane) {
    const bf16* Vg = KV + (size_t)T * D + (size_t)U.p * S * 64;
#pragma unroll
    for (int it = 0; it < 6; ++it) { const int w2 = it * 8 + wave, dh = w2 / 24, blk16 = w2 - dh * 24, slot = blk16 * 16 + (lane >> 2);
        dil_glds(Vg + (size_t)dil_keyrow(U, slot) * 64 + dh * 32 + (lane & 3) * 8, (unsigned)__builtin_amdgcn_readfirstlane((int)(ldsb + DIL_VIMG + dh * (DIL_NKEY * 64) + blk16 * 1024))); }
}
__device__ __forceinline__ void phase_dilated(const Frame& F, const bf16* Q3, const bf16* KV, bf16* OG, float* LSE) {
    const int lane = F.lane, r = lane & 31, h = lane >> 5, wave = F.wave;
    const int vcu = (F.G % 8 == 0) ? (F.bid % 8) * (F.G / 8) + F.bid / 8 : F.bid;
    const unsigned ldsb = (unsigned)(uintptr_t)F.lds;
    DilUnit U, Un;
    if (!dil_unit(0, vcu, F.G, U)) return;
    dil_stage_k(U, KV, ldsb, wave, lane); dil_stage_v(U, KV, ldsb, wave, lane);
    bf16x8 qf[4], qn[4];
    { const int resw = (U.g == 2) ? U.res_u + (wave >> 2) : U.res_u, v0 = (U.g == 2) ? (wave & 3) * 32 : U.V0 + wave * 32; const int qrow = (U.p >> 4) * S + resw + ((v0 + r) << U.dsh);
      const bf16* qp = Q3 + (size_t)qrow * (3 * D) + U.g * D + (U.p & 15) * 64 + 8 * h;
#pragma unroll
      for (int ds = 0; ds < 4; ++ds) qf[ds] = *(const bf16x8*)(qp + 16 * ds); }
    asm volatile("s_waitcnt vmcnt(0)" ::: "memory"); __builtin_amdgcn_s_barrier(); asm volatile("" ::: "memory");
    for (int n = 0;; ++n) {
        const bool has_next = dil_unit(n + 1, vcu, F.G, Un);
        const int g = U.g, dsh = U.dsh, head = U.p & 15, rowbase = (U.p >> 4) * S;
        const int resw = (g == 2) ? U.res_u + (wave >> 2) : U.res_u, v0 = (g == 2) ? (wave & 3) * 32 : U.V0 + wave * 32, kbase = (g == 2) ? (wave >> 2) * 128 : 128 - U.V0;
        const int qrow = rowbase + resw + ((v0 + r) << dsh);
        const int jstart = (v0 >= 128) ? 0 : ((128 - v0) >> 5);
        f32x16 sc[5]; float m = -INFINITY;
#pragma unroll
        for (int j = 0; j < 5; ++j) {
#pragma unroll
            for (int i = 0; i < 16; ++i) sc[j][i] = -INFINITY;
            if (j >= jstart) {
                const int kr = kbase + v0 - 128 + 32 * j + r; const LAS unsigned char* krow = F.lds + DIL_KIMG + kr * 128; const int sw = (kr >> 1) & 7;
                f32x16 pacc;
#pragma unroll
                for (int i = 0; i < 16; ++i) pacc[i] = 0.f;
#pragma unroll
                for (int ds = 0; ds < 4; ++ds) { const bf16x8 kf = *(const LAS bf16x8*)(krow + (((2 * ds + h) ^ sw) << 4)); pacc = __builtin_amdgcn_mfma_f32_32x32x16_bf16(kf, qf[ds], pacc, 0, 0, 0); }
                if (j == 0) {
#pragma unroll
                    for (int i = 0; i < 16; ++i) if (crow16(i, h) < r) pacc[i] = -INFINITY;
                }
                if (j == 4) {
#pragma unroll
                    for (int i = 0; i < 16; ++i) if (crow16(i, h) > r) pacc[i] = -INFINITY;
                }
                sc[j] = pacc;
#pragma unroll
                for (int i = 0; i < 16; i += 2) m = fmaxf(m, fmaxf(pacc[i], pacc[i + 1]));
            }
        }
        m = fmaxf(m, __shfl_xor(m, 32));
        asm volatile("s_waitcnt lgkmcnt(0)" ::: "memory"); __builtin_amdgcn_s_barrier(); asm volatile("" ::: "memory");
        if (has_next) {
            const int resn = (Un.g == 2) ? Un.res_u + (wave >> 2) : Un.res_u, v0n = (Un.g == 2) ? (wave & 3) * 32 : Un.V0 + wave * 32; const int qrn = (Un.p >> 4) * S + resn + ((v0n + r) << Un.dsh);
            const bf16* qp = Q3 + (size_t)qrn * (3 * D) + Un.g * D + (Un.p & 15) * 64 + 8 * h;
#pragma unroll
            for (int ds = 0; ds < 4; ++ds) qn[ds] = *(const bf16x8*)(qp + 16 * ds);
            asm volatile("" ::: "memory");
            dil_stage_k(Un, KV, ldsb, wave, lane);
        }
        float l = 0.f; bf16x8 pf[5][2];
#pragma unroll
        for (int j = 0; j < 5; ++j) {
            float rs = 0.f;
#pragma unroll
            for (int i = 0; i < 16; ++i) { sc[j][i] = __builtin_amdgcn_exp2f(sc[j][i] - m); rs += sc[j][i]; }
            l += rs;
#pragma unroll
            for (int s2 = 0; s2 < 2; ++s2) { v4u w; w.x = pg8::cvt_pk_bf16(sc[j][8 * s2], sc[j][8 * s2 + 1]); w.y = pg8::cvt_pk_bf16(sc[j][8 * s2 + 2], sc[j][8 * s2 + 3]); w.z = pg8::cvt_pk_bf16(sc[j][8 * s2 + 4], sc[j][8 * s2 + 5]); w.w = pg8::cvt_pk_bf16(sc[j][8 * s2 + 6], sc[j][8 * s2 + 7]); pf[j][s2] = __builtin_bit_cast(bf16x8, w); }
        }
        if (has_next) asm volatile("s_waitcnt vmcnt(6)" ::: "memory"); else asm volatile("s_waitcnt vmcnt(0)" ::: "memory");
        __builtin_amdgcn_s_barrier(); asm volatile("" ::: "memory");
        f32x16 o0, o1;
#pragma unroll
        for (int i = 0; i < 16; ++i) { o0[i] = 0.f; o1[i] = 0.f; }
        const int i16 = lane & 15, q4 = i16 >> 2, p4 = i16 & 3, blk = (lane >> 4) & 1;
#pragma unroll
        for (int j = 0; j < 5; ++j) {
            if (j >= jstart) {
                const int ks0 = kbase + v0 - 128 + 32 * j;
#pragma unroll
                for (int s2 = 0; s2 < 2; ++s2) {
#pragma unroll
                    for (int db = 0; db < 2; ++db) {
                        const LAS unsigned char* a0 = F.lds + DIL_VIMG + db * (DIL_NKEY * 64) + (ks0 + 16 * s2 + 4 * h + q4) * 64 + blk * 32 + p4 * 8;
                        const s16x4 lo = __builtin_bit_cast(s16x4, __builtin_amdgcn_ds_read_tr16_b64_v4i16((LAS s16x4*)a0));
                        const s16x4 hi = __builtin_bit_cast(s16x4, __builtin_amdgcn_ds_read_tr16_b64_v4i16((LAS s16x4*)(a0 + 8 * 64)));
                        const bf16x8 vf = (bf16x8){lo[0], lo[1], lo[2], lo[3], hi[0], hi[1], hi[2], hi[3]};
                        if (db == 0) o0 = __builtin_amdgcn_mfma_f32_32x32x16_bf16(vf, pf[j][s2], o0, 0, 0, 0); else o1 = __builtin_amdgcn_mfma_f32_32x32x16_bf16(vf, pf[j][s2], o1, 0, 0, 0);
                    }
                }
            }
        }
        asm volatile("s_waitcnt vmcnt(0) lgkmcnt(0)" ::: "memory"); __builtin_amdgcn_s_barrier(); asm volatile("" ::: "memory");
        const float lt = l + __shfl_xor(l, 32), inv = 1.0f / lt;
        bf16* op = OG + (size_t)g * T * D + (size_t)qrow * D + head * 64 + 4 * h;
#pragma unroll
        for (int ig = 0; ig < 4; ++ig) { v2u w0, w1; w0.x = pg8::cvt_pk_bf16(o0[4 * ig] * inv, o0[4 * ig + 1] * inv); w0.y = pg8::cvt_pk_bf16(o0[4 * ig + 2] * inv, o0[4 * ig + 3] * inv); w1.x = pg8::cvt_pk_bf16(o1[4 * ig] * inv, o1[4 * ig + 1] * inv); w1.y = pg8::cvt_pk_bf16(o1[4 * ig + 2] * inv, o1[4 * ig + 3] * inv);
            *(v2u*)(op + 8 * ig) = w0; *(v2u*)(op + 32 + 8 * ig) = w1; }
        if (h == 0) LSE[(size_t)g * T * 16 + (size_t)qrow * 16 + head] = m + __builtin_amdgcn_logf(lt);
        if (!has_next) break;
        asm volatile("" ::: "memory");
        dil_stage_v(Un, KV, ldsb, wave, lane);
        U = Un;
#pragma unroll
        for (int ds = 0; ds < 4; ++ds) qf[ds] = qn[ds];
    }
    asm volatile("s_waitcnt vmcnt(0)" ::: "memory");
}

#ifndef REP_P0
#define REP_P0 1
#endif
#ifndef REP_QKV
#define REP_QKV 1
#endif
#ifndef REP_ATTN
#define REP_ATTN 1
#endif
#ifndef REP_SUBLN
#define REP_SUBLN 1
#endif
#ifndef REP_DIL
#define REP_DIL 1
#endif
#ifndef REP_MERGE
#define REP_MERGE 1
#endif
#ifndef REP_M2R
#define REP_M2R 1
#endif
#ifndef REP_SCAT
#define REP_SCAT 1
#endif
#ifndef REP_GU
#define REP_GU 1
#endif
#ifndef REP_DN
#define REP_DN 1
#endif
__global__ void __launch_bounds__(NWAVES * 64, 2) yoco_fwd(Args a_unused) {
    extern __shared__ __attribute__((aligned(16))) unsigned char lds_raw[];
    int ph_lo, ph_hi; unsigned barx = 0;
    {
        ArgsP ap = (ArgsP)__builtin_amdgcn_kernarg_segment_ptr(); ph_lo = ap->ph_lo; ph_hi = ap->ph_hi;
        LAS unsigned char* l0 = (LAS unsigned char*)lds_raw;
        for (int u = threadIdx.x; u < (LDS_BYTES - MISC_OFF) / 4; u += NWAVES * 64) ((LAS unsigned*)(l0 + MISC_OFF))[u] = 0u;
        __syncthreads();
        if (ap->use_bar) { XcdBarrier b0 = xcd_barrier_post((unsigned*)(ap->ws + WS_CTL) + CW_BAR, (volatile LAS unsigned*)(l0 + MISC_OFF)); barx = b0.x; }
    }
    int ph = 0;
#define PH_BEGIN PH_BEGIN_R(1)
#define PH_BEGIN_R(R) if (ph_lo <= ph && ph < ph_hi) { ArgsP ap = (ArgsP)__builtin_amdgcn_kernarg_segment_ptr(); asm volatile("" : "+s"(ap)); unsigned char* ws = ap->ws; Frame F; { int t_ = threadIdx.x; asm volatile("" : "+v"(t_)); \
        unsigned lb_ = 0; asm volatile("" : "+s"(lb_)); F.lds = (LAS unsigned char*)lds_raw + lb_; F.tid = t_; F.lane = t_ & 63; F.wave = __builtin_amdgcn_readfirstlane(t_ >> 6); int g_ = gridDim.x, b_ = blockIdx.x; asm volatile("" : "+s"(g_), "+s"(b_)); F.G = g_; F.bid = b_; F.gw = b_ * NWAVES + F.wave; F.NGW = g_ * NWAVES; } \
        for (int rep_ = 0; rep_ < (R); ++rep_) { if (rep_ > 0) MK_BARRIER();
#define MK_BARRIER() do { XcdBarrier b_; b_.bar = (unsigned*)(ws + WS_CTL) + CW_BAR; b_.x = barx; b_.st = (volatile LAS unsigned*)(F.lds + MISC_OFF); xcd_barrier(b_); } while (0)
#define PH_END } if (ph + 1 < ph_hi) MK_BARRIER(); } ++ph;
#define P_MODALL ((float*)(ws + WS_MOD))
#define P_XRES ((float*)(ws + WS_X))
#define P_HBUF ((bf16*)(ws + WS_H))
#define P_HKV ((bf16*)(ws + WS_HKV))
#define P_QBUF ((bf16*)(ws + WS_Q))
#define P_KVSH ((bf16*)(ws + WS_KVSH))
#define P_OBUF ((bf16*)(ws + WS_O))
#define P_OPBUF ((bf16*)(ws + WS_OP))
#define P_LSE ((float*)(ws + WS_LSE))
#define P_HS ((bf16*)(ws + WS_HS))
#define P_ACT ((bf16*)(ws + WS_ACT))
#define P_Y ((bf16*)(ws + WS_Y))
#define P_TKE ((int*)(ws + WS_TKE))
#define P_TKW ((float*)(ws + WS_TKW))
#define P_TKL ((int*)(ws + WS_TKL))
#define P_SLOT ((int*)(ws + WS_SLOT))
#define P_WGCNT ((int*)(ws + WS_WGCNT))
#define P_TEXP ((int*)(ws + WS_TEXP))
#define P_NTW ((unsigned*)(ws + WS_NT))
#define P_ROWTOK ((int*)(ws + WS_ROWTOK))
#define P_SSP ((float*)(ws + WS_SSP))
#define P_COS ((const float*)(ws + WS_ROPE))
#define P_SIN ((const float*)(ws + WS_ROPE) + S * 8)

    PH_BEGIN_R(REP_P0) p0_prologue(F, ap); PH_END
    PH_BEGIN phase_modulate0(F, ap->in[I_X], ap->in[I_MIXN], P_MODALL, 0, D, P_HBUF); PH_END

    for (int st = 0; st < 5; ++st) {
        const int kind = (st < 2) ? 0 : (st == 2 ? 1 : 2);
        const int l = (st < 2) ? st : st - 1;
        const int j = l - 2;
        PH_BEGIN_R(REP_QKV) {
            pg8::Gemm g; pg8::EpiRope E; int nN;
            if (kind == 0) { g = pg8::Gemm{P_HBUF, (const bf16*)(ws + WS_WQKV) + (size_t)l * 3 * D * D, T, 3 * D, D, 0}; nN = 12; E = pg8::EpiRope{P_QBUF, D, D, (size_t)T * D, 2 * D, D, QSCALE, P_COS, P_SIN, 0}; }
            else if (kind == 1) { g = pg8::Gemm{P_HKV, (const bf16*)(ws + WS_KVW), T, 2 * D, D, 0}; nN = 8; E = pg8::EpiRope{P_KVSH, 2 * D, 0, 0, D, 0, 1.0f, P_COS, P_SIN, 1}; }
            else { g = pg8::Gemm{P_HBUF, (const bf16*)(ws + WS_BWQ) + (size_t)j * 3 * D * D, T, 3 * D, D, 0}; nN = 12; E = pg8::EpiRope{P_QBUF, 3 * D, 0, 0, 3 * D, 3 * D, QSCALE, P_COS, P_SIN, 0}; }
            pg8::Order O; O.init(T / 256, nN, F.G, F.bid, nullptr, nullptr);
            pg8::gemm_phase<pg8::EpiRope, pg8::Order, false>(F.lds, g, O, E);
        } PH_END
        if (kind == 1) continue;
        if (kind == 0) {
            PH_BEGIN_R(REP_ATTN) {
                const attn_body::bf16* Qp = (const attn_body::bf16*)P_QBUF; const attn_body::bf16* Kp = Qp + (size_t)T * D; const attn_body::bf16* Vp = Kp + (size_t)T * D; attn_body::bf16* Op = (attn_body::bf16*)P_OPBUF;
                const int vcu = (F.G % 8 == 0) ? (F.bid % 8) * (F.G / 8) + F.bid / 8 : F.bid;
                LAS float* cscr = (LAS float*)(F.wave < 5 ? F.lds + attn_body::ATTN_LDS_BYTES + F.wave * 8448 : F.lds + ROWTAB_OFF + (F.wave - 5) * 8448);
                const int myslot = vcu & 15;
                const float* lamv = ap->in[I_ALAM] + l * 256; const float lam_init = ap->lam_init[l & 1];
                float lam; { const float p1 = wave_sum(lamv[F.lane] * lamv[64 + F.lane]), p2 = wave_sum(lamv[128 + F.lane] * lamv[192 + F.lane]); lam = __expf(p1) - __expf(p2) + lam_init; }
                const f32x4 gsub = *(const f32x4*)(ap->in[I_ASUBLN] + l * 128 + 4 * (F.lane & 31)) * (1.0f - lam_init);
                for (int p = vcu; p < NB * 16; p += F.G) { const int b = p >> 4, hq = (p >> 1) & 7, par = p & 1;
                    for (int qi = 0; qi < 4; ++qi) { const int qb = par ? ((qi == 0) ? 1 : (qi == 1) ? 6 : (qi == 2) ? 3 : 4) : ((qi == 0) ? 0 : (qi == 1) ? 7 : (qi == 2) ? 2 : 5);
                        for (int ps = 0; ps < 4; ++ps) { const int mm = ps >> 1, half = ps & 1, hh = 2 * hq + mm;
                            attn_body::attn_unit<8>(b, qb, Qp + hh * 64, Kp + hh * 64, Vp + hq * 128 + half * 64, Op + (size_t)mm * T * D + hq * 128 + half * 64, (char*)F.lds);
                            if (p == vcu && rep_ == 0 && qi * 4 + ps == myslot) convert_experts(F, ap, 2 * l, cscr); }
                        asm volatile("s_waitcnt vmcnt(0)" ::: "memory");
                        const bf16* o0p = P_OPBUF + (size_t)(b * S + qb * 256 + F.wave * 32 + (F.lane >> 5)) * D + hq * 128 + 4 * (F.lane & 31); bf16* dst = P_OBUF + (size_t)(b * S + qb * 256 + F.wave * 32 + (F.lane >> 5)) * D + hq * 128 + 4 * (F.lane & 31);
#pragma unroll 4
                        for (int rr = 0; rr < 16; ++rr) { const v2u a0 = *(const v2u*)(o0p + (size_t)rr * 2 * D), a1 = *(const v2u*)(o0p + (size_t)T * D + (size_t)rr * 2 * D);
                            f32x4 v = unpack4(a0) - unpack4(a1) * lam; float ss = dot4(v);
#pragma unroll
                            for (int o = 1; o < 32; o <<= 1) ss += __shfl_xor(ss, o);
                            v = v * (1.0f / sqrtf(ss * (1.0f / 128.0f) + EPS)) * gsub; v2u w; w.x = pk2(v.x, v.y); w.y = pk2(v.z, v.w); *(v2u*)(dst + (size_t)rr * 2 * D) = w; } } }
            } PH_END
        } else {
            PH_BEGIN_R(REP_DIL) phase_dilated(F, P_QBUF, P_KVSH, P_OPBUF, P_LSE); PH_END
            PH_BEGIN_R(REP_MERGE) phase_merge(F, P_OPBUF, P_LSE, P_OBUF); PH_END
        }
        PH_BEGIN {
            const bf16* wo = (kind == 0) ? (const bf16*)(ws + WS_AWO) + (size_t)l * D * D : (const bf16*)(ws + WS_BWO) + (size_t)j * D * D;
            pg8::Gemm g{P_OBUF, wo, T, D, D, 0}; pg8::Order O; O.init(T / 256, 4, F.G, F.bid, nullptr, nullptr);
            pg8::EpiResid E{(l == 0) ? ap->in[I_X] : P_XRES, P_XRES, P_MODALL + l * 6 * D + 2 * D, MODC, P_SSP};
            pg8::gemm_phase<pg8::EpiResid, pg8::Order, false>(F.lds, g, O, E);
        } PH_END
        PH_BEGIN_R(REP_M2R) phase_mod2_router(F, P_XRES, P_SSP, ap->in[I_FFNN] + l * D, P_MODALL, l * 6 * D + 3 * D, l * 6 * D + 4 * D, (const bf16*)(ws + WS_RFRAG) + (size_t)l * 65536, ap->in[I_RB] + l * NE, P_HBUF, P_TKE, P_TKW, P_TKL, P_WGCNT); PH_END
        PH_BEGIN_R(REP_SCAT) phase_scatter(F, P_WGCNT, P_TKE, P_TKL, P_SLOT, P_ROWTOK, P_TEXP, P_NTW); PH_END
        PH_BEGIN_R(REP_GU) {
            const int nt = (int)__hip_atomic_load(P_NTW, RLX_AGENT); LAS int* tl = (LAS int*)(F.lds + TEXP_OFF); LAS int* rt = (LAS int*)(F.lds + ROWTAB_OFF);
            for (int i = F.tid; i < nt; i += NWAVES * 64) tl[i] = P_TEXP[i];
            __syncthreads();
            constexpr size_t ESZ = MOE_F8 ? 1 : 2;
            pg8::Gemm g{(const bf16*)P_HBUF, (const bf16*)(ws + WS_WGU + (size_t)l * NE * 2 * D * D * ESZ), nt * 256, 2 * D, D, (size_t)2 * D * D * ESZ}; pg8::OrderT<true> O; O.init(nt, 8, F.G, F.bid, tl, rt);
            { pg8::Unit u_; const int* rtk = P_ROWTOK; for (int i = 0; O.next(i, u_); ++i) if (F.tid < 256) rt[i * 256 + F.tid] = rtk[u_.pm * 256 + F.tid]; }
            __syncthreads();
            pg8::EpiSwiglu<MOE_F8 != 0> E{P_ACT, ap->in[I_BGU] + (size_t)l * NE * 2 * D};
            pg8::gemm_phase<pg8::EpiSwiglu<MOE_F8 != 0>, pg8::OrderT<true>, MOE_F8 != 0>(F.lds, g, O, E);
        } PH_END
        PH_BEGIN_R(REP_DN) {
            const int nt = (int)__hip_atomic_load(P_NTW, RLX_AGENT); LAS int* tl = (LAS int*)(F.lds + TEXP_OFF);
            for (int i = F.tid; i < nt; i += NWAVES * 64) tl[i] = P_TEXP[i];
            __syncthreads();
            constexpr size_t ESZ = MOE_F8 ? 1 : 2;
            pg8::Gemm g{P_ACT, (const bf16*)(ws + WS_WDN + (size_t)l * NE * D * D * ESZ), nt * 256, D, D, (size_t)D * D * ESZ}; pg8::Order O; O.init(nt, 4, F.G, F.bid, tl, nullptr);
            pg8::EpiDown E{P_Y, ap->in[I_BDN] + (size_t)l * NE * D};
            pg8::gemm_phase<pg8::EpiDown, pg8::Order, MOE_F8 != 0>(F.lds, g, O, E);
        } PH_END
        PH_BEGIN {
            const int mode = (l == 3) ? 2 : (l == 1 ? 1 : 0);
            const float* gainA = (l == 3) ? ap->in[I_FINN] : ap->in[I_MIXN] + (l + 1) * D; const int shA = (l == 3) ? MOD_FIN : (l + 1) * 6 * D, scA = shA + D;
            phase_combine(F, P_XRES, P_Y, P_SLOT, P_TKW, P_MODALL + l * 6 * D + 5 * D, mode, gainA, P_MODALL, shA, scA, P_HBUF, ap->in[I_KVN], MOD_KV, MOD_KV + D, P_HKV, ap->out);
        } PH_END
    }
#undef PH_BEGIN
#undef PH_END
}
constexpr int N_PHASES = 2 + 8 + 8 + 1 + 9 + 9;

#ifndef MK_PER_PHASE
#define MK_PER_PHASE 0
#endif
extern "C" void kernel_launch(void* const* d_in, const int* in_sizes, int n_in, void* d_out, int out_size, void* d_ws, size_t ws_size, hipStream_t stream) {
    static int grid = 0;
    if (grid == 0) {
        if (n_in != 25 || in_sizes[0] != T * D || out_size != T * D || ws_size < WS_END) { fprintf(stderr, "kernel_launch: unexpected shapes / workspace (n_in %d, ws %zu)\n", n_in, ws_size); grid = -1; return; }
        int dev = 0, cus = 0, per_cu = 0;
        if (hipGetDevice(&dev) != hipSuccess || hipDeviceGetAttribute(&cus, hipDeviceAttributeMultiprocessorCount, dev) != hipSuccess) { grid = -1; return; }
        if (hipFuncSetAttribute((const void*)yoco_fwd, hipFuncAttributeMaxDynamicSharedMemorySize, LDS_BYTES) != hipSuccess) { fprintf(stderr, "kernel_launch: hipFuncSetAttribute failed\n"); grid = -1; return; }
        if (hipOccupancyMaxActiveBlocksPerMultiprocessor(&per_cu, (const void*)yoco_fwd, NWAVES * 64, LDS_BYTES) != hipSuccess || per_cu < 1) fprintf(stderr, "kernel_launch: occupancy query reports %d\n", per_cu);
        (void)hipGetLastError();
        grid = cus;
    }
    if (grid < 0) return;
    if (hipMemsetAsync((char*)d_ws + WS_CTL, 0, CTL_ZERO_BYTES, stream) != hipSuccess) return;
    Args a{};
    for (int i = 0; i < 25; ++i) a.in[i] = (const float*)d_in[i];
    a.out = (float*)d_out; a.ws = (unsigned char*)d_ws;
    for (int i = 0; i < 8; ++i) a.invf[i] = (float)pow(500000.0, -(double)(2 * i) / 16.0);
    a.lam_init[0] = (float)(0.8 - 0.6 * exp(-0.3 * 0.0)); a.lam_init[1] = (float)(0.8 - 0.6 * exp(-0.3 * 1.0));
#if MK_PER_PHASE
    for (int p = 0; p < N_PHASES; ++p) { a.ph_lo = p; a.ph_hi = p + 1; a.use_bar = 0; hipLaunchKernelGGL(yoco_fwd, dim3(grid), dim3(NWAVES * 64), LDS_BYTES, stream, a); }
#else
    a.ph_lo = 0; a.ph_hi = N_PHASES; a.use_bar = 1; hipLaunchKernelGGL(yoco_fwd, dim3(grid), dim3(NWAVES * 64), LDS_BYTES, stream, a);
#endif
}
```
